# Optimizing an MI355X kernel written in HIP

```python
import jax, jax.numpy as jnp
from jax import lax
import numpy as np

D_MODEL = 1024
BATCH = 4
SEQ = 8192
DEPTH = 2

N_A = DEPTH // 2
N_B = DEPTH - N_A
MEM_LEN = 256
MEM_HEADS = 4
MEM_DH = D_MODEL // (2 * MEM_HEADS)
MEM_WIDTH = MEM_HEADS * MEM_DH
GLA_HEADS = 4
GLA_DV = D_MODEL // (2 * GLA_HEADS)
GLA_DK = GLA_DV // 2
GLA_QK = GLA_HEADS * GLA_DK
GLA_V = GLA_HEADS * GLA_DV
GLA_RANK = 16
GLA_TAU = 16.0
GLA_CHUNK = 64
NSA_HEADS = 8
NSA_GROUPS = 2
NSA_HPG = NSA_HEADS // NSA_GROUPS
NSA_DH = D_MODEL // (2 * NSA_HEADS)
NSA_WIDTH = NSA_HEADS * NSA_DH
KV_WIDTH = NSA_GROUPS * NSA_DH
CMP_BLOCK = 32
CMP_STRIDE = 16
CMP_HIDDEN = 256
SEL_BLOCK = 64
SEL_TOPN = 16
WINDOW = 512
Q_BLOCK = 128
FFN_DIM = ((8 * D_MODEL // 3 + 127) // 128) * 128
CONV_WIDTH = 3
EPS = 1e-6
A_PROJ = 2 * GLA_QK + 2 * GLA_V + GLA_RANK + MEM_WIDTH
B_PROJ = NSA_WIDTH + 3 * NSA_HEADS + MEM_WIDTH
SHARED_KV_PROJ = 6 * KV_WIDTH

kernel_name = 'yoco_gla_nsa_hybrid'

F32 = jnp.float32


def rmsnorm(x, g):
    xf = x.astype(F32)
    y = xf * lax.rsqrt(jnp.mean(xf * xf, axis=-1, keepdims=True) + EPS)
    return y.astype(x.dtype) * g


def split_cols(z, widths):
    idx = [int(i) for i in np.cumsum(widths)[:-1]]
    return jnp.split(z, idx, axis=-1)


def masked_softmax(s, mask):
    s = jnp.where(mask, s.astype(F32), -jnp.inf)
    m = jnp.max(s, axis=-1, keepdims=True)
    m = jnp.where(jnp.isfinite(m), m, 0.0)
    e = jnp.exp(s - m)
    return e / jnp.maximum(jnp.sum(e, axis=-1, keepdims=True), 1e-30)


def alibi_slopes(n):
    return jnp.exp2(-8.0 * jnp.arange(1, n + 1, dtype=F32) / n)


def mem_attend(mq, mem_k, mem_v):
    B, T, _ = mq.shape
    qh = mq.reshape(B, T, MEM_HEADS, MEM_DH) * (MEM_DH ** -0.5)
    s = jnp.einsum('bthd,bmhd->bhtm', qh, mem_k)
    p = jax.nn.softmax(s.astype(F32), axis=-1).astype(mem_v.dtype)
    return jnp.einsum('bhtm,bmhd->bthd', p, mem_v).reshape(B, T, MEM_WIDTH)


def gla_chunked(q, k, v, log_a):
    B, T, H, DK = q.shape
    DV = v.shape[-1]
    C = GLA_CHUNK
    NC = T // C

    def chunks(a):
        return a.astype(F32).reshape(B, NC, C, H, a.shape[-1]).transpose(1, 0, 3, 2, 4)

    causal = jnp.tril(jnp.ones((C, C), dtype=bool))[:, :, None]

    def step(S, inp):
        qc, kc, vc, gc = inp
        b = jnp.cumsum(gc, axis=2)
        b_last = b[:, :, -1:, :]
        o_inter = jnp.einsum('bhtd,bhde->bhte', qc * jnp.exp(b), S)
        decay = jnp.exp(jnp.where(causal, b[:, :, :, None, :] - b[:, :, None, :, :], -jnp.inf))
        attn = jnp.einsum('bhtd,bhsd,bhtsd->bhts', qc, kc, decay)
        o = o_inter + jnp.einsum('bhts,bhse->bhte', attn, vc)
        S = jnp.exp(b_last[:, :, 0, :])[..., None] * S + jnp.einsum('bhsd,bhse->bhde', kc * jnp.exp(b_last - b), vc)
        return S, o

    S0 = jnp.zeros((B, H, DK, DV), F32)
    _, o = lax.scan(step, S0, (chunks(q), chunks(k), chunks(v), chunks(log_a)))
    return o.transpose(1, 0, 3, 2, 4).reshape(B, T, H, DV)


def gla_layer_mix(h, mem_k, mem_v, w_in, w_alpha, b_alpha, g_head, w_out):
    B, T, _ = h.shape
    q, k, v, r, alr, mq = split_cols(h @ w_in, [GLA_QK, GLA_QK, GLA_V, GLA_V, GLA_RANK, MEM_WIDTH])
    q = q.reshape(B, T, GLA_HEADS, GLA_DK) * (GLA_DK ** -0.5)
    k = k.reshape(B, T, GLA_HEADS, GLA_DK)
    v = v.reshape(B, T, GLA_HEADS, GLA_DV)
    log_a = jax.nn.log_sigmoid((alr @ w_alpha + b_alpha).astype(F32)) / GLA_TAU
    log_a = log_a.reshape(B, T, GLA_HEADS, GLA_DK)
    o = gla_chunked(q, k, v, log_a).astype(h.dtype)
    o = rmsnorm(o, g_head).reshape(B, T, GLA_V) * jax.nn.silu(r)
    m = mem_attend(mq, mem_k, mem_v)
    return jnp.concatenate([o, m], axis=-1) @ w_out


def compress_blocks(a, pe, w1, w2):
    B, T, G, DH = a.shape
    n_sub = CMP_BLOCK // CMP_STRIDE
    sub = a.reshape(B, T // CMP_STRIDE, CMP_STRIDE, G, DH)
    ncmp = T // CMP_STRIDE - n_sub + 1
    blocks = jnp.concatenate([sub[:, i:i + ncmp] for i in range(n_sub)], axis=2)
    blocks = blocks + pe[:, None, :]
    flat = blocks.transpose(0, 1, 3, 2, 4).reshape(B, ncmp, G, CMP_BLOCK * DH)
    return jax.nn.gelu(flat @ w1) @ w2


def nsa_shared_kv(x, g_kv, w_kv, pe_k, pe_v, w_ck1, w_ck2, w_cv1, w_cv2):
    B, T, _ = x.shape
    kv = (rmsnorm(x, g_kv) @ w_kv).reshape(B, T, 6, NSA_GROUPS, NSA_DH)
    k_c, v_c, k_s, v_s, k_w, v_w = [kv[:, :, i] for i in range(6)]
    return (compress_blocks(k_c, pe_k, w_ck1, w_ck2), compress_blocks(v_c, pe_v, w_cv1, w_cv2),
            k_s, v_s, k_w, v_w)


def selection_overlap(ncmp, ns):
    cs = jnp.arange(ncmp) * CMP_STRIDE
    ss = jnp.arange(ns) * SEL_BLOCK
    ov = jnp.minimum(cs[:, None] + CMP_BLOCK, ss[None, :] + SEL_BLOCK) - jnp.maximum(cs[:, None], ss[None, :])
    return jnp.clip(ov, 0, None).astype(F32) / CMP_BLOCK


def nsa_attend(q, gates, k_cmp, v_cmp, k_slc, v_slc, k_win, v_win):
    B, T, H, DH = q.shape
    G, HPG = NSA_GROUPS, NSA_HPG
    nqb = T // Q_BLOCK
    ncmp = k_cmp.shape[1]
    ns = T // SEL_BLOCK
    n_sel = min(SEL_TOPN, ns)
    slope = alibi_slopes(H).reshape(G, HPG)[None, None, :, :, None]
    cmp_end = jnp.arange(ncmp) * CMP_STRIDE + CMP_BLOCK - 1
    overlap = selection_overlap(ncmp, ns)

    def to_blocks(a):
        return a.reshape(B, ns, SEL_BLOCK, G, DH).transpose(0, 3, 1, 2, 4)

    ks_b, vs_b = to_blocks(k_slc), to_blocks(v_slc)
    pad = ((0, 0), (WINDOW, 0), (0, 0), (0, 0))
    kw_pad, vw_pad = jnp.pad(k_win, pad), jnp.pad(v_win, pad)
    gather = jax.vmap(jax.vmap(lambda blocks, ix: blocks[ix]))
    sel_off = jnp.arange(SEL_BLOCK)
    win_off = jnp.arange(Q_BLOCK + WINDOW)
    blk = jnp.arange(ns)

    def one_block(inp):
        qi, gi, bi = inp
        t = bi * Q_BLOCK + jnp.arange(Q_BLOCK)
        dist_c = (t[:, None] - cmp_end[None, :])
        s = jnp.einsum('bqghd,bngd->bqghn', qi, k_cmp).astype(F32) - slope * dist_c.astype(F32)[None, :, None, None, :]
        p_c = masked_softmax(s, (dist_c >= 0)[None, :, None, None, :])
        o_c = jnp.einsum('bqghn,bngd->bqghd', p_c.astype(v_cmp.dtype), v_cmp)
        cur = t // SEL_BLOCK
        imp = jnp.einsum('bqghn,nj->bqgj', p_c, overlap)
        valid = (blk[None, :] <= cur[:, None])[None, :, None, :]
        forced = ((blk[None, :] == 0) | (blk[None, :] == cur[:, None]) | (blk[None, :] == cur[:, None] - 1))[None, :, None, :]
        imp = jnp.where(forced, jnp.inf, jnp.where(valid, imp, -jnp.inf))
        _, idx = lax.top_k(imp, n_sel)
        idx = idx.transpose(0, 2, 1, 3)
        kg = gather(ks_b, idx).reshape(B, G, Q_BLOCK, n_sel * SEL_BLOCK, DH)
        vg = gather(vs_b, idx).reshape(B, G, Q_BLOCK, n_sel * SEL_BLOCK, DH)
        pos = (idx[..., None] * SEL_BLOCK + sel_off).reshape(B, G, Q_BLOCK, n_sel * SEL_BLOCK)
        dist_s = (t[None, None, :, None] - pos).transpose(0, 2, 1, 3)[:, :, :, None, :]
        s = jnp.einsum('bqghd,bgqsd->bqghs', qi, kg).astype(F32) - slope * dist_s.astype(F32)
        p_s = masked_softmax(s, dist_s >= 0)
        o_s = jnp.einsum('bqghs,bgqsd->bqghd', p_s.astype(vg.dtype), vg)
        start = bi * Q_BLOCK
        kw = lax.dynamic_slice_in_dim(kw_pad, start, Q_BLOCK + WINDOW, axis=1)
        vw = lax.dynamic_slice_in_dim(vw_pad, start, Q_BLOCK + WINDOW, axis=1)
        kpos = start - WINDOW + win_off
        dist_w = t[:, None] - kpos[None, :]
        mask_w = ((dist_w >= 0) & (dist_w < WINDOW) & (kpos >= 0)[None, :])[None, :, None, None, :]
        s = jnp.einsum('bqghd,bkgd->bqghk', qi, kw).astype(F32) - slope * dist_w.astype(F32)[None, :, None, None, :]
        p_w = masked_softmax(s, mask_w)
        o_w = jnp.einsum('bqghk,bkgd->bqghd', p_w.astype(vw.dtype), vw)
        return gi[..., 0:1] * o_c + gi[..., 1:2] * o_s + gi[..., 2:3] * o_w

    qb = q.reshape(B, nqb, Q_BLOCK, G, HPG, DH).transpose(1, 0, 2, 3, 4, 5)
    gb = gates.reshape(B, nqb, Q_BLOCK, G, HPG, 3).transpose(1, 0, 2, 3, 4, 5).astype(q.dtype)
    out = lax.map(one_block, (qb, gb, jnp.arange(nqb)))
    return out.transpose(1, 0, 2, 3, 4, 5).reshape(B, T, H * DH)


def nsa_layer_mix(h, shared, mem_k, mem_v, w_in, w_out):
    B, T, _ = h.shape
    q, gl, mq = split_cols(h @ w_in, [NSA_WIDTH, 3 * NSA_HEADS, MEM_WIDTH])
    q = q.reshape(B, T, NSA_HEADS, NSA_DH) * (NSA_DH ** -0.5)
    gates = jax.nn.sigmoid(gl.reshape(B, T, NSA_HEADS, 3))
    o = nsa_attend(q, gates, *shared)
    m = mem_attend(mq, mem_k, mem_v)
    return jnp.concatenate([o, m], axis=-1) @ w_out


def conv_ffn(h, w_up, conv_w, conv_b, w_down):
    T = h.shape[1]
    a, b = jnp.split(h @ w_up, 2, axis=-1)
    a_pad = jnp.pad(a, ((0, 0), (CONV_WIDTH - 1, 0), (0, 0)))
    a = sum(a_pad[:, j:j + T] * conv_w[j] for j in range(CONV_WIDTH)) + conv_b
    return (jax.nn.silu(a) * b) @ w_down


def setup_inputs(seed: int = 0) -> dict:
    key = jax.random.key(seed)
    ks = jax.random.split(key, 26)

    def nrm(k, shape, scale):
        return jax.random.normal(k, shape, F32) * scale

    def gain(k, shape):
        return 1.0 + 0.02 * jax.random.normal(k, shape, F32)

    D = D_MODEL
    return {
        'x': nrm(ks[0], (BATCH, SEQ, D), 1.0),
        'mem': nrm(ks[1], (BATCH, MEM_LEN, D), 1.0),
        'g_mix': gain(ks[2], (DEPTH, D)),
        'g_ffn': gain(ks[3], (DEPTH, D)),
        'g_mem': gain(ks[4], (DEPTH, D)),
        'w_mem_kv': nrm(ks[5], (DEPTH, D, 2 * MEM_WIDTH), D ** -0.5),
        'w_up': nrm(ks[6], (DEPTH, D, 2 * FFN_DIM), D ** -0.5),
        'conv_w': nrm(ks[7], (DEPTH, CONV_WIDTH, FFN_DIM), CONV_WIDTH ** -0.5),
        'conv_b': nrm(ks[8], (DEPTH, FFN_DIM), 0.01),
        'w_down': nrm(ks[9], (DEPTH, FFN_DIM, D), FFN_DIM ** -0.5),
        'a_w_in': nrm(ks[10], (N_A, D, A_PROJ), D ** -0.5),
        'a_w_alpha': nrm(ks[11], (N_A, GLA_RANK, GLA_QK), GLA_RANK ** -0.5),
        'a_b_alpha': nrm(ks[12], (N_A, GLA_QK), 0.01),
        'a_g_head': gain(ks[13], (N_A, GLA_DV)),
        'a_w_out': nrm(ks[14], (N_A, GLA_V + MEM_WIDTH, D), (GLA_V + MEM_WIDTH) ** -0.5),
        'g_kv': gain(ks[15], (D,)),
        'w_kv': nrm(ks[16], (D, SHARED_KV_PROJ), D ** -0.5),
        'pe_k': nrm(ks[17], (CMP_BLOCK, NSA_DH), 0.1),
        'pe_v': nrm(ks[18], (CMP_BLOCK, NSA_DH), 0.1),
        'w_ck1': nrm(ks[19], (CMP_BLOCK * NSA_DH, CMP_HIDDEN), (CMP_BLOCK * NSA_DH) ** -0.5),
        'w_ck2': nrm(ks[20], (CMP_HIDDEN, NSA_DH), CMP_HIDDEN ** -0.5),
        'w_cv1': nrm(ks[21], (CMP_BLOCK * NSA_DH, CMP_HIDDEN), (CMP_BLOCK * NSA_DH) ** -0.5),
        'w_cv2': nrm(ks[22], (CMP_HIDDEN, NSA_DH), CMP_HIDDEN ** -0.5),
        'b_w_in': nrm(ks[23], (N_B, D, B_PROJ), D ** -0.5),
        'b_w_out': nrm(ks[24], (N_B, NSA_WIDTH + MEM_WIDTH, D), (NSA_WIDTH + MEM_WIDTH) ** -0.5),
        'g_final': gain(ks[25], (D,)),
    }


def reference(x, mem, g_mix, g_ffn, g_mem, w_mem_kv, w_up, conv_w, conv_b, w_down,
              a_w_in, a_w_alpha, a_b_alpha, a_g_head, a_w_out,
              g_kv, w_kv, pe_k, pe_v, w_ck1, w_ck2, w_cv1, w_cv2,
              b_w_in, b_w_out, g_final):
    B, M, _ = mem.shape
    shared = None
    for l in range(DEPTH):
        if l == N_A:
            shared = nsa_shared_kv(x, g_kv, w_kv, pe_k, pe_v, w_ck1, w_ck2, w_cv1, w_cv2)
        mkv = (rmsnorm(mem, g_mem[l]) @ w_mem_kv[l]).reshape(B, M, 2, MEM_HEADS, MEM_DH)
        mem_k, mem_v = mkv[:, :, 0], mkv[:, :, 1]
        h = rmsnorm(x, g_mix[l])
        if l < N_A:
            x = x + gla_layer_mix(h, mem_k, mem_v, a_w_in[l], a_w_alpha[l], a_b_alpha[l], a_g_head[l], a_w_out[l])
        else:
            j = l - N_A
            x = x + nsa_layer_mix(h, shared, mem_k, mem_v, b_w_in[j], b_w_out[j])
        x = x + conv_ffn(rmsnorm(x, g_ffn[l]), w_up[l], conv_w[l], conv_b[l], w_down[l])
    return rmsnorm(x, g_final)
```

```cpp
#include <hip/hip_runtime.h>
#include <cstdio>
#include <cstdint>
namespace pg8 {
#define PG8_LAS __attribute__((address_space(3)))
typedef unsigned short bf16_t;
typedef short bf16x8 __attribute__((ext_vector_type(8)));
typedef float f32x4 __attribute__((ext_vector_type(4)));
typedef unsigned u32x4 __attribute__((ext_vector_type(4)));
typedef unsigned u32x2 __attribute__((ext_vector_type(2)));
constexpr int BM = 256, BK = 64, HALF = 128, HTB = HALF * BK * 2  , STAGE_BYTES = 8 * HTB, NXCD = 8, WGM = 8;

__host__ __device__ __forceinline__ int lds_byte(int r, int c) { const int st = (r >> 4) * 2 + (c >> 5), rr = r & 15, cc = c & 31, ob = rr * 64 + cc * 2; return st * 1024 + (ob ^ (((ob >> 9) & 1) << 5)); }
__host__ __device__ __forceinline__ void stage_rc(int b, int& R, int& C) { const int st = b / 1024, sb = b % 1024, swz = sb ^ (((sb >> 9) & 1) << 5); R = (st >> 1) * 16 + swz / 64; C = (st & 1) * 32 + (swz % 64) / 2; }
__host__ __device__ __forceinline__ int perm32(int rho) { const int n = rho >> 4, i = rho & 15; return 8 * (i >> 2) + 4 * n + (i & 3); }

struct Unit { int pm, pn; };
struct Gemm { const bf16_t* A; const bf16_t* Bt; int M, N, K, lda; };

struct StaticOrder {
    int nM, nN, nwg, G, c;
    __host__ __device__ void init(int M, int N, int G_, int c_) { nM = M / BM; nN = N / BM; nwg = nM * nN; G = G_; c = c_; }
    __host__ __device__ bool next(int i, Unit& u) const {
        const long L = (long)i * G + c; if (L >= nwg) return false;
        int wgid = (int)L; { const int q = nwg / NXCD, r = nwg % NXCD, xcd = wgid % NXCD, off = wgid / NXCD; wgid = (xcd < r ? xcd * (q + 1) : r * (q + 1) + (xcd - r) * q) + off; }
        const int nig = WGM * nN, gid = wgid / nig, fm = gid * WGM, gsz = (nM - fm) < WGM ? (nM - fm) : WGM;
        u.pm = fm + ((wgid % nig) % gsz); u.pn = (wgid % nig) / gsz; return true;
    }
    __device__ __forceinline__ void a_ready(const Unit&) const {}
    __device__ __forceinline__ void done(const Unit&) const {}
};


typedef float f32x2c __attribute__((ext_vector_type(2))); typedef __bf16 bf16x2c __attribute__((ext_vector_type(2)));
__device__ __forceinline__ unsigned cvt_pk_bf16(float lo, float hi) { const f32x2c v = {lo, hi}; return __builtin_bit_cast(unsigned, __builtin_convertvector(v, bf16x2c)); }
constexpr float RMS_EPS = 1e-6f;
__device__ __forceinline__ float rstd_row(const float* SS, int row) {
    const f32x4* p = (const f32x4*)(SS + (size_t)row * 16); const f32x4 a = p[0], b = p[1], c = p[2], d = p[3];
    const float s = (((a.x + a.y) + (a.z + a.w)) + ((b.x + b.y) + (b.z + b.w))) + (((c.x + c.y) + (c.z + c.w)) + ((d.x + d.y) + (d.z + d.w)));
    return 1.0f / sqrtf(s * (1.0f / 1024.0f) + RMS_EPS);
}
__device__ __forceinline__ float sigmoid_f(float x) { return __builtin_amdgcn_rcpf(1.0f + __expf(-x)); }

__device__ __forceinline__ void rstd8(float (&rs)[2][4], const char* ssb0  , unsigned ls  , int lane) {
    f32x4 a[8];
#pragma unroll
    for (int i = 0; i < 8; ++i) a[i] = *(const f32x4*)(ssb0 + (size_t)((i >> 2) * HALF + (i & 3) * 16) * 64 + ls);
    float sv[8], tv[8];
#pragma unroll
    for (int i = 0; i < 8; ++i) sv[i] = (a[i].x + a[i].y) + (a[i].z + a[i].w);
    const int x16 = (lane ^ 16) * 4, x32 = (lane ^ 32) * 4;
#pragma unroll
    for (int i = 0; i < 8; ++i) tv[i] = __int_as_float(__builtin_amdgcn_ds_bpermute(x16, __float_as_int(sv[i])));
#pragma unroll
    for (int i = 0; i < 8; ++i) sv[i] += tv[i];
#pragma unroll
    for (int i = 0; i < 8; ++i) tv[i] = __int_as_float(__builtin_amdgcn_ds_bpermute(x32, __float_as_int(sv[i])));
#pragma unroll
    for (int i = 0; i < 8; ++i) rs[i >> 2][i & 3] = __builtin_amdgcn_rsqf((sv[i] + tv[i]) * (1.0f / 1024.0f) + RMS_EPS);
}
__device__ __forceinline__ u32x4 pack8(const f32x4 v0, const f32x4 v1) { u32x4 w; w.x = cvt_pk_bf16(v0[0], v0[1]); w.y = cvt_pk_bf16(v0[2], v0[3]); w.z = cvt_pk_bf16(v1[0], v1[1]); w.w = cvt_pk_bf16(v1[2], v1[3]); return w; }

struct EpiScaleBf16 {
    static constexpr bool PERM = true, AFTER_DRAIN = false;
    bf16_t* O; int ldc; const float* SS; int sc_from, sc_to; float sc;
    __device__ __forceinline__ void operator()(f32x4 (&acc)[2][2][4][2], const Unit& u, int wr, int wc, int fr, int fq) const {
        asm volatile("" : "+v"(fr), "+v"(fq));
        const unsigned lrow = wr * 64 + fr; const unsigned lo = lrow * (unsigned)ldc * 2u + (unsigned)(wc * 32 + 8 * fq) * 2u, ls = lrow * 64u + (unsigned)fq * 16u;
        float rs[2][4]; rstd8(rs, (const char*)SS + (size_t)(u.pm * BM) * 64, ls, fr + 16 * fq);
        const float xs = (u.pn >= sc_from && u.pn < sc_to) ? sc : 1.0f;
#pragma unroll
        for (int ai = 0; ai < 2; ++ai)
#pragma unroll
            for (int m = 0; m < 4; ++m) { const int urow = u.pm * BM + ai * HALF + m * 16; char* ob = (char*)O + ((size_t)urow * ldc + u.pn * BM) * 2; const float r_ = rs[ai][m] * xs;
#pragma unroll
                for (int bj = 0; bj < 2; ++bj) *(u32x4*)(ob + lo + bj * HALF * 2) = pack8(acc[ai][bj][m][0] * r_, acc[ai][bj][m][1] * r_); }
    }
};

struct EpiResid {
    static constexpr bool PERM = true, AFTER_DRAIN = false;
    bf16_t* xb; float* SS;
    __device__ __forceinline__ void operator()(f32x4 (&acc)[2][2][4][2], const Unit& u, int wr, int wc, int fr, int fq) const {
        asm volatile("" : "+v"(fr), "+v"(fq));
        const unsigned lrow = wr * 64 + fr; const unsigned lo = lrow * 2048u + (unsigned)(wc * 32 + 8 * fq) * 2u, ls = lrow * 64u + (unsigned)wc * 4u;
        char* const xb0 = (char*)xb + (size_t)(u.pm * BM) * 2048 + (size_t)u.pn * 512;
        u32x4 rw[2][4][2];
#pragma unroll
        for (int ai = 0; ai < 2; ++ai)
#pragma unroll
            for (int m = 0; m < 4; ++m)
#pragma unroll
                for (int bj = 0; bj < 2; ++bj) rw[ai][m][bj] = *(const u32x4*)(xb0 + (size_t)(ai * HALF + m * 16) * 2048 + lo + bj * 256);
#pragma unroll
        for (int ai = 0; ai < 2; ++ai)
#pragma unroll
            for (int m = 0; m < 4; ++m) { const int urow = u.pm * BM + ai * HALF + m * 16; float ssq = 0.f;
#pragma unroll
                for (int bj = 0; bj < 2; ++bj) { const u32x4 r = rw[ai][m][bj];
                    f32x4 o0 = acc[ai][bj][m][0], o1 = acc[ai][bj][m][1];
                    o0[0] += __uint_as_float(r.x << 16); o0[1] += __uint_as_float(r.x & 0xffff0000u); o0[2] += __uint_as_float(r.y << 16); o0[3] += __uint_as_float(r.y & 0xffff0000u);
                    o1[0] += __uint_as_float(r.z << 16); o1[1] += __uint_as_float(r.z & 0xffff0000u); o1[2] += __uint_as_float(r.w << 16); o1[3] += __uint_as_float(r.w & 0xffff0000u);
                    ssq += ((o0[0] * o0[0] + o0[1] * o0[1]) + (o0[2] * o0[2] + o0[3] * o0[3])) + ((o1[0] * o1[0] + o1[1] * o1[1]) + (o1[2] * o1[2] + o1[3] * o1[3]));
                    *(u32x4*)(xb0 + (size_t)(ai * HALF + m * 16) * 2048 + lo + bj * 256) = pack8(o0, o1); }
                ssq += __shfl_xor(ssq, 16); ssq += __shfl_xor(ssq, 32);
                if (fq == 0) *(float*)((char*)SS + (size_t)urow * 64 + u.pn * 16 + ls) = ssq; }
    }
};

struct EpiFinal {
    static constexpr bool PERM = true, AFTER_DRAIN = false;
    const bf16_t* xb; float* SS; float* out; const float* gf; unsigned* cnt;
    __device__ __forceinline__ void operator()(f32x4 (&acc)[2][2][4][2], const Unit& u, int wr, int wc, int fr, int fq) const {
        asm volatile("" : "+v"(fr), "+v"(fq));
        const unsigned lrow = wr * 64 + fr; const unsigned lo = lrow * 2048u + (unsigned)(wc * 32 + 8 * fq) * 2u, ls = lrow * 64u + (unsigned)wc * 4u;
        const char* const xb0 = (const char*)xb + (size_t)(u.pm * BM) * 2048 + (size_t)u.pn * 512;
        u32x4 rw[2][4][2];
#pragma unroll
        for (int ai = 0; ai < 2; ++ai)
#pragma unroll
            for (int m = 0; m < 4; ++m)
#pragma unroll
                for (int bj = 0; bj < 2; ++bj) rw[ai][m][bj] = *(const u32x4*)(xb0 + (size_t)(ai * HALF + m * 16) * 2048 + lo + bj * 256);
#pragma unroll
        for (int ai = 0; ai < 2; ++ai)
#pragma unroll
            for (int m = 0; m < 4; ++m) { const int urow = u.pm * BM + ai * HALF + m * 16; float ssq = 0.f;
#pragma unroll
                for (int bj = 0; bj < 2; ++bj) { const u32x4 r = rw[ai][m][bj];
                    f32x4 o0 = acc[ai][bj][m][0], o1 = acc[ai][bj][m][1];
                    o0[0] += __uint_as_float(r.x << 16); o0[1] += __uint_as_float(r.x & 0xffff0000u); o0[2] += __uint_as_float(r.y << 16); o0[3] += __uint_as_float(r.y & 0xffff0000u);
                    o1[0] += __uint_as_float(r.z << 16); o1[1] += __uint_as_float(r.z & 0xffff0000u); o1[2] += __uint_as_float(r.w << 16); o1[3] += __uint_as_float(r.w & 0xffff0000u);
                    ssq += ((o0[0] * o0[0] + o0[1] * o0[1]) + (o0[2] * o0[2] + o0[3] * o0[3])) + ((o1[0] * o1[0] + o1[1] * o1[1]) + (o1[2] * o1[2] + o1[3] * o1[3]));
                    acc[ai][bj][m][0] = o0; acc[ai][bj][m][1] = o1; }
                ssq += __shfl_xor(ssq, 16); ssq += __shfl_xor(ssq, 32);
                if (fq == 0) __hip_atomic_store((float*)((char*)SS + (size_t)urow * 64 + u.pn * 16 + ls), ssq, __ATOMIC_RELAXED, __HIP_MEMORY_SCOPE_AGENT); }
        asm volatile("s_waitcnt vmcnt(0)" ::: "memory");
        __builtin_amdgcn_s_barrier();
        if ((fr | fq | wr | wc) == 0) { unsigned* c = cnt + u.pm * 16; __hip_atomic_fetch_add(c, 1u, __ATOMIC_RELAXED, __HIP_MEMORY_SCOPE_AGENT);
            for (int spin = 0; spin < (1 << 22) && __hip_atomic_load(c, __ATOMIC_RELAXED, __HIP_MEMORY_SCOPE_AGENT) < 4u; ++spin) __builtin_amdgcn_s_sleep(1); }
        __builtin_amdgcn_s_barrier();
        asm volatile("" ::: "memory");
        const unsigned lq = lrow * 64u + (unsigned)fq * 16u;
        const char* const ssb0 = (const char*)SS + (size_t)(u.pm * BM) * 64;
        unsigned long long pa[8][2];
#pragma unroll
        for (int i = 0; i < 8; ++i) { const unsigned long long* p = (const unsigned long long*)(ssb0 + (size_t)((i >> 2) * HALF + (i & 3) * 16) * 64 + lq);
            pa[i][0] = __hip_atomic_load(p, __ATOMIC_RELAXED, __HIP_MEMORY_SCOPE_AGENT); pa[i][1] = __hip_atomic_load(p + 1, __ATOMIC_RELAXED, __HIP_MEMORY_SCOPE_AGENT); }
        f32x4 gv[2][2];
#pragma unroll
        for (int bj = 0; bj < 2; ++bj) { const char* gp = (const char*)gf + (size_t)u.pn * 1024 + bj * 512 + (unsigned)(wc * 32 + 8 * fq) * 4u; gv[bj][0] = *(const f32x4*)gp; gv[bj][1] = *(const f32x4*)(gp + 16); }
        float sv[8], tv[8];
#pragma unroll
        for (int i = 0; i < 8; ++i) sv[i] = (__uint_as_float((unsigned)pa[i][0]) + __uint_as_float((unsigned)(pa[i][0] >> 32))) + (__uint_as_float((unsigned)pa[i][1]) + __uint_as_float((unsigned)(pa[i][1] >> 32)));
        const int lane = fr + 16 * fq, x16 = (lane ^ 16) * 4, x32 = (lane ^ 32) * 4;
#pragma unroll
        for (int i = 0; i < 8; ++i) tv[i] = __int_as_float(__builtin_amdgcn_ds_bpermute(x16, __float_as_int(sv[i])));
#pragma unroll
        for (int i = 0; i < 8; ++i) sv[i] += tv[i];
#pragma unroll
        for (int i = 0; i < 8; ++i) tv[i] = __int_as_float(__builtin_amdgcn_ds_bpermute(x32, __float_as_int(sv[i])));
        char* const ob0 = (char*)out + (size_t)(u.pm * BM) * 4096 + (size_t)u.pn * 1024;
        const unsigned loo = lrow * 4096u + (unsigned)(wc * 32 + 8 * fq) * 4u;
#pragma unroll
        for (int ai = 0; ai < 2; ++ai)
#pragma unroll
            for (int m = 0; m < 4; ++m) { const float rs = __builtin_amdgcn_rsqf((sv[ai * 4 + m] + tv[ai * 4 + m]) * (1.0f / 1024.0f) + RMS_EPS);
#pragma unroll
                for (int bj = 0; bj < 2; ++bj) { char* op = ob0 + (size_t)(ai * HALF + m * 16) * 4096 + loo + bj * 512;
                    *(f32x4*)op = acc[ai][bj][m][0] * rs * gv[bj][0]; *(f32x4*)(op + 16) = acc[ai][bj][m][1] * rs * gv[bj][1]; } }
    }
};

struct EpiUp {
    static constexpr bool PERM = true, AFTER_DRAIN = false;
    bf16_t* H; const float* SS; const float* cw; const float* cb; float* bndA; float* bndHA; float* bndHB;
    __device__ __forceinline__ static f32x4 ror1(const f32x4 v) { f32x4 r;
#pragma unroll
        for (int e = 0; e < 4; ++e) r[e] = __int_as_float(__builtin_amdgcn_update_dpp(0, __float_as_int(v[e]), 0x121, 0xf, 0xf, false)); return r; }
    __device__ __forceinline__ static f32x4 ror2(const f32x4 v) { f32x4 r;
#pragma unroll
        for (int e = 0; e < 4; ++e) r[e] = __int_as_float(__builtin_amdgcn_update_dpp(0, __float_as_int(v[e]), 0x122, 0xf, 0xf, false)); return r; }
    __device__ __forceinline__ void operator()(f32x4 (&acc)[2][2][4][2], const Unit& u, int wr, int wc, int fr, int fq) const {
        asm volatile("" : "+v"(fr), "+v"(fq));
        constexpr int FF = 2816;
        const unsigned lch = (unsigned)(wc * 32 + 8 * fq);
        const unsigned lrow = wr * 64 + fr, ls = lrow * 64u + (unsigned)fq * 16u, lh = lrow * (unsigned)(FF * 2) + lch * 2u;
        const unsigned lb = (unsigned)(fr & 1) * (unsigned)(FF * 4) + lch * 4u;
        const char* cwb = (const char*)cw + (size_t)u.pn * 512; const char* cbb = (const char*)cb + (size_t)u.pn * 512;
        const bool f1 = fr >= 1, f2 = fr >= 2;
        float rsa[2][4]; f32x4 cwv[2][4];
        rstd8(rsa, (const char*)SS + (size_t)(u.pm * BM) * 64, ls, fr + 16 * fq);
#pragma unroll
        for (int n = 0; n < 2; ++n) { cwv[n][0] = *(const f32x4*)(cwb + lch * 4u + n * 16); cwv[n][1] = *(const f32x4*)(cwb + lch * 4u + FF * 4 + n * 16); cwv[n][2] = *(const f32x4*)(cwb + lch * 4u + 2 * FF * 4 + n * 16); cwv[n][3] = *(const f32x4*)(cbb + lch * 4u + n * 16); }
#pragma unroll
        for (int ai = 0; ai < 2; ++ai) {
            const int urow = u.pm * BM + ai * HALF; const int G = (urow >> 6) + wr;
            float rs[4];
#pragma unroll
            for (int m = 0; m < 4; ++m) rs[m] = rsa[ai][m];
            const size_t ub = ((size_t)G * 2 * FF + (size_t)u.pn * 128) * 4;
            char* const pA = (char*)bndA + ub; char* const pHA = (char*)bndHA + ub; char* const pHB = (char*)bndHB + ub;
            if (fr >= 14) { *(f32x4*)(pA + lb) = acc[ai][0][3][0] * rs[3]; *(f32x4*)(pA + lb + 16) = acc[ai][0][3][1] * rs[3]; }
            if (fr < 2) { *(f32x4*)(pHA + lb) = acc[ai][0][0][0] * rs[0]; *(f32x4*)(pHA + lb + 16) = acc[ai][0][0][1] * rs[0]; *(f32x4*)(pHB + lb) = acc[ai][1][0][0] * rs[0]; *(f32x4*)(pHB + lb + 16) = acc[ai][1][0][1] * rs[0]; }
#pragma unroll
            for (int n = 0; n < 2; ++n) {
                const f32x4 w0 = cwv[n][0], w1 = cwv[n][1], w2 = cwv[n][2], cbv = cwv[n][3];
                f32x4 r1p = (f32x4){0.f, 0.f, 0.f, 0.f}, r2p = r1p;
#pragma unroll
                for (int m = 0; m < 4; ++m) {
                    const f32x4 am = acc[ai][0][m][n] * rs[m], bm = acc[ai][1][m][n] * rs[m];
                    const f32x4 r1 = ror1(am), r2 = ror2(am); f32x4 p1, p2;
#pragma unroll
                    for (int e = 0; e < 4; ++e) { p1[e] = f1 ? r1[e] : r1p[e]; p2[e] = f2 ? r2[e] : r2p[e]; }
                    const f32x4 cv = w0 * p2 + w1 * p1 + w2 * am + cbv; f32x4 hv;
#pragma unroll
                    for (int e = 0; e < 4; ++e) hv[e] = cv[e] * sigmoid_f(cv[e]) * bm[e];
                    acc[ai][0][m][n] = hv; r1p = r1; r2p = r2; }
                asm volatile("" : "+v"(acc[ai][0][0][n]), "+v"(acc[ai][0][1][n]), "+v"(acc[ai][0][2][n]), "+v"(acc[ai][0][3][n]) :: "memory");
            }
            char* const hb = (char*)H + ((size_t)urow * FF + (size_t)u.pn * 128) * 2;
#pragma unroll
            for (int m = 0; m < 4; ++m) { if (m == 0 && fr < 2) continue;
                *(u32x4*)(hb + lh + m * 16 * FF * 2) = pack8(acc[ai][0][m][0], acc[ai][0][m][1]); }
            asm volatile("" ::: "memory");
        }
    }
};

struct EpiProjB {
    static constexpr bool PERM = true, AFTER_DRAIN = false;
    bf16_t* kvc; bf16_t* PB; const float* SS;
    __device__ __forceinline__ void operator()(f32x4 (&acc)[2][2][4][2], const Unit& u, int wr, int wc, int fr, int fq) const {
        asm volatile("" : "+v"(fr), "+v"(fq));
        constexpr size_t KVSTRIDE = (size_t)8 * 8192 * 64;
        const unsigned lrow = wr * 64 + fr, ls = lrow * 64u + (unsigned)fq * 16u;
        const unsigned lkv = lrow * 128u + (unsigned)((wc & 1) * 32 + 8 * fq) * 2u, lpb = lrow * 2560u + (unsigned)(wc * 32 + 8 * fq) * 2u;
        const int g = wc >> 1, b = u.pm >> 5;
        float rsa[2][4]; rstd8(rsa, (const char*)SS + (size_t)(u.pm * BM) * 64, ls, fr + 16 * fq);
        const float xs = (u.pn == 3 || u.pn == 4) ? 0.125f * 1.4426950408889634f : ((u.pn == 5 || u.pn == 6) ? 0.08838834764831845f * 1.4426950408889634f : 1.0f);
#pragma unroll
        for (int ai = 0; ai < 2; ++ai)
#pragma unroll
            for (int m = 0; m < 4; ++m) { const int urow = u.pm * BM + ai * HALF + m * 16; const float rs = rsa[ai][m] * xs;
#pragma unroll
                for (int bj = 0; bj < 2; ++bj) { const u32x4 w = pack8(acc[ai][bj][m][0] * rs, acc[ai][bj][m][1] * rs);
                    if (u.pn < 3) *(u32x4*)((char*)kvc + ((size_t)(u.pn * 2 + bj) * KVSTRIDE + ((size_t)urow + (size_t)(b + g) * 8192) * 64) * 2 + lkv) = w;
                    else *(u32x4*)((char*)PB + ((size_t)urow * 1280 + (size_t)(u.pn - 3) * 256 + bj * HALF) * 2 + lpb) = w; } }
    }
};

struct EpiGelu {
    static constexpr bool PERM = true, AFTER_DRAIN = false;
    bf16_t* O; const float* bias;
    __device__ __forceinline__ static float gelu_t(float x) { const float u2 = 1.5957691216f * (x + 0.044715f * x * x * x); return x * sigmoid_f(u2); }
    __device__ __forceinline__ void operator()(f32x4 (&acc)[2][2][4][2], const Unit& u, int wr, int wc, int fr, int fq) const {
        asm volatile("" : "+v"(fr), "+v"(fq));
        const unsigned lrow = wr * 64 + fr, lc = (unsigned)(wc * 32 + 8 * fq), lo = lrow * 512u + lc * 2u;
        f32x4 bv[2][2];
#pragma unroll
        for (int bj = 0; bj < 2; ++bj) { bv[bj][0] = *(const f32x4*)((const char*)bias + lc * 4u + bj * 512); bv[bj][1] = *(const f32x4*)((const char*)bias + lc * 4u + bj * 512 + 16); }
#pragma unroll
        for (int ai = 0; ai < 2; ++ai)
#pragma unroll
            for (int m = 0; m < 4; ++m) { char* ob = (char*)O + (size_t)(u.pm * BM + ai * HALF + m * 16) * 512;
#pragma unroll
                for (int bj = 0; bj < 2; ++bj) { f32x4 v0 = acc[ai][bj][m][0] + bv[bj][0], v1 = acc[ai][bj][m][1] + bv[bj][1];
#pragma unroll
                    for (int e = 0; e < 4; ++e) { v0[e] = gelu_t(v0[e]); v1[e] = gelu_t(v1[e]); }
                    *(u32x4*)(ob + lo + bj * HALF * 2) = pack8(v0, v1); } }
    }
};

template <class Epi, class Sched, bool ALIGN_EPI = false, bool SP2 = false>
__device__ __forceinline__ void gemm_phase(PG8_LAS unsigned char* lds, const Gemm g, const Sched& S, const Epi& E) {
    int tid_ = threadIdx.x; asm volatile("" : "+v"(tid_));
    const int tid = tid_, wid = __builtin_amdgcn_readfirstlane(tid >> 6), lane = tid & 63, wr = wid >> 2, wc = wid & 3, fr = lane & 15, fq = lane >> 4;
    const int K = g.K, nt = K / BK;
    unsigned voffA[2], voffB[2];
#pragma unroll
    for (int i = 0; i < 2; ++i) { int R, C; stage_rc(tid * 16 + i * 8192, R, C); const int Rb = Epi::PERM ? ((R & ~31) + perm32(R & 31)) : R;
        voffA[i] = (unsigned)(R * g.lda + C) * 2u; voffB[i] = (unsigned)(Rb * K + C) * 2u; }
    const size_t kstep = (size_t)(BK * 2);
    const size_t hsA = (size_t)HALF * g.lda * 2, hsB = (size_t)HALF * K * 2;
    const size_t tsA = 2 * hsA, tsB = 2 * hsB;
    const unsigned ldsw = (unsigned)wid * 1024u;
    const int aoff = lds_byte(wr * 64 + fr, fq * 8), boff = lds_byte(wc * 32 + fr, fq * 8);
#define PG8_SA(b, h) (((b) * 2 + (h)) * HTB)
#define PG8_SB(b, h) ((4 + (b) * 2 + (h)) * HTB)
#define PG8_STAGE(bufoff, gbase, voff) do { _Pragma("unroll") for (int _i = 0; _i < 2; ++_i) \
        __builtin_amdgcn_global_load_lds((const unsigned*)((const char*)(gbase) + (voff)[_i]), (PG8_LAS unsigned*)(lds + (bufoff) + ldsw + _i * 8192), 16, 0, 0); } while (0)
#define PG8_LDA(dst, b, h) do { _Pragma("unroll") for (int m = 0; m < 4; ++m) _Pragma("unroll") for (int k = 0; k < 2; ++k) dst[m][k] = *(const PG8_LAS bf16x8*)(lds + PG8_SA(b, h) + aoff + m * 2048 + k * 1024); } while (0)
#define PG8_LDB(dst, b, h) do { _Pragma("unroll") for (int n = 0; n < 2; ++n) _Pragma("unroll") for (int k = 0; k < 2; ++k) dst[n][k] = *(const PG8_LAS bf16x8*)(lds + PG8_SB(b, h) + boff + n * 2048 + k * 1024); } while (0)
#define PG8_MMA(ai, bj, At, Bt) do { __builtin_amdgcn_s_setprio(1); _Pragma("unroll") for (int m = 0; m < 4; ++m) _Pragma("unroll") for (int n = 0; n < 2; ++n) _Pragma("unroll") for (int k = 0; k < 2; ++k) \
        acc[ai][bj][m][n] = __builtin_amdgcn_mfma_f32_16x16x32_bf16(Bt[n][k], At[m][k], acc[ai][bj][m][n], 0, 0, 0); __builtin_amdgcn_s_setprio(0); } while (0)
#define PG8_WAIT_V(n) asm volatile("s_waitcnt vmcnt(" #n ")" ::: "memory")
#define PG8_WAIT_L(n) asm volatile("s_waitcnt lgkmcnt(" #n ")" ::: "memory")
#define PG8_BAR __builtin_amdgcn_s_barrier()
#define PG8_SCHED __builtin_amdgcn_sched_barrier(0)
    Unit cur, nxt; int ui = 0;
    if (!S.next(0, cur)) return;
    f32x4 acc[2][2][4][2];
#pragma unroll
    for (int a = 0; a < 2; ++a)
#pragma unroll
        for (int b = 0; b < 2; ++b)
#pragma unroll
            for (int m = 0; m < 4; ++m)
#pragma unroll
                for (int n = 0; n < 2; ++n) acc[a][b][m][n] = (f32x4){0.f, 0.f, 0.f, 0.f};
    bf16x8 At[4][2], B0[2][2], B1[2][2];
    const char* cA = (const char*)g.A + (size_t)cur.pm * tsA; const char* cB = (const char*)g.Bt + (size_t)cur.pn * tsB;
    S.a_ready(cur);
    if constexpr (SP2) {
        PG8_STAGE(PG8_SB(0, 0), cB, voffB); PG8_STAGE(PG8_SB(0, 1), cB + hsB, voffB); PG8_STAGE(PG8_SA(0, 0), cA, voffA); PG8_STAGE(PG8_SA(0, 1), cA + hsA, voffA);
        if (wr == 1) PG8_BAR;
        PG8_WAIT_V(2); PG8_BAR;
        PG8_STAGE(PG8_SB(1, 0), cB + kstep, voffB); PG8_STAGE(PG8_SA(1, 0), cA + kstep, voffA); PG8_STAGE(PG8_SB(1, 1), cB + hsB + kstep, voffB);
        PG8_WAIT_V(6); PG8_BAR;
    } else {
        PG8_STAGE(PG8_SB(0, 0), cB, voffB); PG8_STAGE(PG8_SA(0, 0), cA, voffA); PG8_STAGE(PG8_SB(0, 1), cB + hsB, voffB); PG8_STAGE(PG8_SA(0, 1), cA + hsA, voffA);
        if (wr == 1) PG8_BAR;
        PG8_WAIT_V(4); PG8_BAR;
        PG8_STAGE(PG8_SB(1, 0), cB + kstep, voffB); PG8_STAGE(PG8_SA(1, 0), cA + kstep, voffA); PG8_STAGE(PG8_SB(1, 1), cB + hsB + kstep, voffB);
        PG8_WAIT_V(6); PG8_BAR;
    }
    for (;;) {
        const bool has_next = S.next(ui + 1, nxt);
        const char* nA = has_next ? (const char*)g.A + (size_t)nxt.pm * tsA : cA; const char* nB = has_next ? (const char*)g.Bt + (size_t)nxt.pn * tsB : cB;
        for (int t = 0; t < nt; t += 2) {
            const bool last = (t == nt - 2);
            const char* a1 = cA + (size_t)(t + 1) * kstep;
            const char* a2 = last ? nA : cA + (size_t)(t + 2) * kstep; const char* b2 = last ? nB : cB + (size_t)(t + 2) * kstep;
            const char* a3 = a2 + kstep; const char* b3 = b2 + kstep;
            if (last && has_next) S.a_ready(nxt);
            if constexpr (SP2) {
            PG8_LDB(B0, 0, 0); PG8_LDB(B1, 0, 1); PG8_SCHED; PG8_LDA(At, 0, 0); PG8_STAGE(PG8_SA(1, 1), a1 + hsA, voffA);
            PG8_WAIT_V(8); PG8_WAIT_L(0); PG8_BAR; PG8_MMA(0, 0, At, B0); PG8_MMA(0, 1, At, B1); PG8_BAR; PG8_SCHED;
            PG8_LDA(At, 0, 1); PG8_STAGE(PG8_SB(0, 0), b2, voffB); PG8_STAGE(PG8_SB(0, 1), b2 + hsB, voffB); PG8_STAGE(PG8_SA(0, 0), a2, voffA);
            PG8_WAIT_V(8); PG8_WAIT_L(0); PG8_BAR; PG8_MMA(1, 0, At, B0); PG8_MMA(1, 1, At, B1); PG8_BAR; PG8_SCHED;
            PG8_LDB(B0, 1, 0); PG8_LDB(B1, 1, 1); PG8_SCHED; PG8_LDA(At, 1, 0); PG8_STAGE(PG8_SA(0, 1), a2 + hsA, voffA);
            PG8_WAIT_V(8); PG8_WAIT_L(0); PG8_BAR; PG8_MMA(0, 0, At, B0); PG8_MMA(0, 1, At, B1); PG8_BAR; PG8_SCHED;
            PG8_LDA(At, 1, 1); PG8_STAGE(PG8_SB(1, 0), b3, voffB); PG8_STAGE(PG8_SB(1, 1), b3 + hsB, voffB); PG8_STAGE(PG8_SA(1, 0), a3, voffA);
            PG8_WAIT_V(8); PG8_WAIT_L(0); PG8_BAR; PG8_MMA(1, 0, At, B0); PG8_MMA(1, 1, At, B1); PG8_BAR; PG8_SCHED;
            } else {
            PG8_LDB(B0, 0, 0); PG8_SCHED; PG8_LDA(At, 0, 0); PG8_STAGE(PG8_SA(1, 1), a1 + hsA, voffA);
            PG8_WAIT_L(8); PG8_BAR; PG8_WAIT_L(0); PG8_MMA(0, 0, At, B0); PG8_BAR; PG8_SCHED;
            PG8_LDB(B1, 0, 1); PG8_STAGE(PG8_SB(0, 0), b2, voffB);
            PG8_BAR; PG8_WAIT_L(0); PG8_MMA(0, 1, At, B1); PG8_BAR;
            PG8_LDA(At, 0, 1); PG8_STAGE(PG8_SA(0, 0), a2, voffA);
            PG8_BAR; PG8_WAIT_L(0); PG8_MMA(1, 0, At, B0); PG8_BAR; PG8_SCHED;
            PG8_STAGE(PG8_SB(0, 1), b2 + hsB, voffB);
            PG8_WAIT_V(6); PG8_BAR; PG8_MMA(1, 1, At, B1); PG8_BAR;
            PG8_LDB(B0, 1, 0); PG8_SCHED; PG8_LDA(At, 1, 0); PG8_STAGE(PG8_SA(0, 1), a2 + hsA, voffA);
            PG8_WAIT_L(8); PG8_BAR; PG8_WAIT_L(0); PG8_MMA(0, 0, At, B0); PG8_BAR; PG8_SCHED;
            PG8_LDB(B1, 1, 1); PG8_STAGE(PG8_SB(1, 0), b3, voffB);
            PG8_BAR; PG8_WAIT_L(0); PG8_MMA(0, 1, At, B1); PG8_BAR;
            PG8_LDA(At, 1, 1); PG8_STAGE(PG8_SA(1, 0), a3, voffA);
            PG8_BAR; PG8_WAIT_L(0); PG8_MMA(1, 0, At, B0); PG8_BAR; PG8_SCHED;
            PG8_STAGE(PG8_SB(1, 1), b3 + hsB, voffB);
            PG8_WAIT_V(6); PG8_BAR; PG8_MMA(1, 1, At, B1); PG8_BAR;
            }
        }
        if constexpr (ALIGN_EPI) { if (wr == 0) PG8_BAR; }
        if constexpr (!Epi::AFTER_DRAIN) { E(acc, cur, wr, wc, fr, fq); S.done(cur); }
        if (!has_next) break;
#pragma unroll
        for (int a = 0; a < 2; ++a)
#pragma unroll
            for (int b = 0; b < 2; ++b)
#pragma unroll
                for (int m = 0; m < 4; ++m)
#pragma unroll
                    for (int n = 0; n < 2; ++n) acc[a][b][m][n] = (f32x4){0.f, 0.f, 0.f, 0.f};
        cur = nxt; cA = nA; cB = nB; ++ui;
        if constexpr (ALIGN_EPI) { if (wr == 1) PG8_BAR; }
    }
    PG8_WAIT_V(0);
    if constexpr (!ALIGN_EPI) { if (wr == 0) PG8_BAR; }
    PG8_BAR;
    if constexpr (Epi::AFTER_DRAIN) { E.fused(acc, cur, wr, wc, fr, fq, lds, wid, lane); S.done(cur); }
#undef PG8_SA
#undef PG8_SB
#undef PG8_STAGE
#undef PG8_LDA
#undef PG8_LDB
#undef PG8_MMA
#undef PG8_WAIT_V
#undef PG8_WAIT_L
#undef PG8_BAR
#undef PG8_SCHED
}
}

#define LAS __attribute__((address_space(3)))
#define XB_TMO      128
#define XB_XCNT(j)  (256  + 64 * (j))
#define XB_XSUB(j)  (1280 + 64 * (j))
#define XB_XGEN(j)  (2304 + 64 * (j))
#define XB_TOP      3328
#define XB_TOPGEN   3392
#define XCD_BAR_WORDS 3456
#define XB_SPIN_CAP (1u << 18)

__device__ __forceinline__ unsigned xb_ld(unsigned* p)              { return __hip_atomic_load(p, __ATOMIC_RELAXED, __HIP_MEMORY_SCOPE_AGENT); }
__device__ __forceinline__ unsigned xb_add(unsigned* p, unsigned v) { return __hip_atomic_fetch_add(p, v, __ATOMIC_RELAXED, __HIP_MEMORY_SCOPE_AGENT); }
__device__ __forceinline__ unsigned xb_xcc_id() { return (unsigned)__builtin_amdgcn_s_getreg((3 << 11) | 20) & 0xFu; }
#define XB_SPIN(cond, bar) do { unsigned _sp = 0; while (cond) { __builtin_amdgcn_s_sleep(1); \
    if ((++_sp & 255u) == 0u) { if (xb_ld(&(bar)[XB_TMO])) break; if (_sp > XB_SPIN_CAP) { atomicAdd(&(bar)[XB_TMO], 1u); break; } } } } while (0)

struct XcdBarrier {
    unsigned* bar; unsigned x;
    volatile LAS unsigned* st;
};

__device__ __forceinline__ XcdBarrier xcd_barrier_post(unsigned* bar, volatile LAS unsigned* st) {
    XcdBarrier b; b.bar = bar; b.x = xb_xcc_id(); b.st = st;
    if (threadIdx.x == 0) (void)xb_add(&bar[XB_XCNT(b.x)], 1u);
    return b;
}
__device__ __forceinline__ void xcd_barrier_complete(unsigned* bar, unsigned x, unsigned& nloc, unsigned& nx) {
    const unsigned G = gridDim.x * gridDim.y * gridDim.z;
    unsigned sum, cnt, mine, sp = 0u;
    for (;;) {
        sum = 0u; cnt = 0u; mine = 0u;
#pragma unroll
        for (unsigned j = 0; j < 16; ++j) { const unsigned c = xb_ld(&bar[XB_XCNT(j)]); sum += c; cnt += (c > 0u) ? 1u : 0u; mine = (j == x) ? c : mine; }
        if (sum == G) break;
        __builtin_amdgcn_s_sleep(1);
        if ((++sp & 255u) == 0u) { if (xb_ld(&bar[XB_TMO])) break; if (sp > XB_SPIN_CAP) { atomicAdd(&bar[XB_TMO], 1u); break; } }
    }
    nloc = mine > 0u ? mine : 1u; nx = cnt > 0u ? cnt : 1u;
}

__device__ __forceinline__ void xcd_barrier(const XcdBarrier& b) {
    asm volatile("s_waitcnt vmcnt(0)" ::: "memory");
    __syncthreads();
    if (threadIdx.x == 0) {
        unsigned* bar = b.bar;
        __builtin_amdgcn_s_waitcnt(0);
        unsigned nloc = b.st[0], nx = b.st[1];
        if (nloc == 0u) { xcd_barrier_complete(bar, b.x, nloc, nx); b.st[0] = nloc; b.st[1] = nx; }
        const unsigned old = xb_add(&bar[XB_XSUB(b.x)], 1u);
        const unsigned gen = old / nloc;
        if (old + 1u == (gen + 1u) * nloc) {
            __builtin_amdgcn_fence(__ATOMIC_RELEASE, "agent");
            asm volatile("s_waitcnt vmcnt(0)" ::: "memory");
            const unsigned og = xb_add(&bar[XB_TOP], 1u);
            const unsigned tg = og / nx;
            if (og + 1u == (tg + 1u) * nx) xb_add(&bar[XB_TOPGEN], 1u);
            else XB_SPIN(xb_ld(&bar[XB_TOPGEN]) == tg, bar);
            __builtin_amdgcn_fence(__ATOMIC_ACQUIRE, "agent");
            xb_add(&bar[XB_XGEN(b.x)], 1u);
            asm volatile("s_waitcnt vmcnt(0)" ::: "memory");
        } else {
            XB_SPIN(xb_ld(&bar[XB_XGEN(b.x)]) == gen, bar);
            __builtin_amdgcn_fence(__ATOMIC_ACQUIRE, "agent");
            asm volatile("s_waitcnt vmcnt(0)" ::: "memory");
        }
    }
    __syncthreads();
}

constexpr int NWAVES = 8;
constexpr int NB = 4, T = 8192, D = 1024, M = NB * T;
constexpr int MEML = 256, MROWS = NB * MEML;
constexpr int FF = 2816;
constexpr int NPA = 2304;
constexpr int PA_Q = 0, PA_K = 256, PA_V = 512, PA_R = 1024, PA_MQ = 1536, PA_ALR = 2048;
constexpr int NPB = 1280;
constexpr int PB_Q = 0, PB_MQ = 512, PB_GL = 1024;
constexpr int NG5 = 2048;
constexpr float MEM_QSCALE = 0.08838834764831845f * 1.4426950408889634f;
constexpr int NCMP = 511, NCMPP = 512;
constexpr size_t MiB = 1u << 20;
constexpr size_t WS_CTL = 0, CTL_ZERO_BYTES = 1 * MiB;
constexpr size_t WS_SS = 1 * MiB;
constexpr size_t WS_SSM = 3 * MiB;
constexpr size_t WS_BIAS1 = 3 * MiB + 256 * 1024;
constexpr size_t WS_BPART = 3 * MiB + 512 * 1024;
constexpr size_t WS_WA = 4 * MiB;
constexpr size_t WS_WM = 9 * MiB;
constexpr size_t WS_WOA = 13 * MiB, WS_WOB = 15 * MiB;
constexpr size_t WS_WU = 17 * MiB;
constexpr size_t WS_WD = 39 * MiB;
constexpr size_t WS_WB = 50 * MiB;
constexpr size_t WS_WC1 = 54 * MiB;
constexpr size_t WS_WC2 = 56 * MiB;
constexpr size_t WS_XB = 64 * MiB;
constexpr size_t WS_CAT = 128 * MiB;
constexpr size_t WS_R1 = 192 * MiB;
constexpr size_t WS_R2 = 368 * MiB;
constexpr size_t WS_OG = WS_R2;
constexpr size_t WS_LA = WS_R2 + 64 * MiB;
constexpr size_t WS_KVC = WS_R2;
constexpr size_t WS_CH = WS_R2 + 50 * MiB;
constexpr size_t WS_KCMP = WS_R2 + 54 * MiB;
constexpr size_t WS_BND = WS_R2 + 102 * MiB;
constexpr size_t BND_ONE = (size_t)512 * 2 * FF * 4;
constexpr size_t WS_MKV = WS_R2 + 138 * MiB;
constexpr size_t WS_MEMB = WS_R2 + 142 * MiB;
constexpr size_t WS_END = 512 * MiB;
static_assert(WS_BND + 3 * BND_ONE <= WS_MKV && WS_LA + 32 * MiB <= WS_BND && WS_R1 + (size_t)M * FF * 2 <= WS_R2, "ws map");
constexpr size_t KVSTRIDE = (size_t)8 * 8192 * 64;
constexpr int CW_BAR = 4096, CW_PANEL = 1024;
constexpr int RING_BYTES = 131072;
constexpr int WSCR_BYTES = 17408;
constexpr int BLIST_OFF = 8 * WSCR_BYTES;
constexpr int LDSCTL_OFF = BLIST_OFF + 512, MISC_OFF = LDSCTL_OFF + 320;
constexpr int LDS_BYTES = 147456;
static_assert(MISC_OFF + 128 <= LDS_BYTES, "LDS map");

#define GAS __attribute__((address_space(1)))
#define LAS __attribute__((address_space(3)))
typedef unsigned short bf16;
typedef unsigned v4u __attribute__((ext_vector_type(4)));
typedef unsigned v2u __attribute__((ext_vector_type(2)));
typedef float f32x4 __attribute__((ext_vector_type(4)));
typedef GAS unsigned gu32;
#define LDS_WAIT() asm volatile("s_waitcnt lgkmcnt(0)" ::: "memory")
#define VM_WAIT() asm volatile("s_waitcnt vmcnt(0)" ::: "memory")
__device__ __forceinline__ unsigned f2bf(float f) { unsigned u = __builtin_bit_cast(unsigned, f); return (u + 0x7fffu + ((u >> 16) & 1u)) >> 16; }
__device__ __forceinline__ unsigned pk2(float lo, float hi) { return f2bf(lo) | (f2bf(hi) << 16); }
__device__ __forceinline__ float bf2f(unsigned short b) { return __uint_as_float((unsigned)b << 16); }
__device__ __forceinline__ float bflo(unsigned w) { return __uint_as_float(w << 16); }
__device__ __forceinline__ float bfhi(unsigned w) { return __uint_as_float(w & 0xffff0000u); }

struct Frame {
    LAS unsigned char* lds;
    volatile LAS unsigned* MISC;
    gu32* ctl;
    int tid, lane, wave, G;
    float* out; unsigned char* ws;
};
__device__ __forceinline__ const float* in_ptr(int i) { return ((const float* const __attribute__((address_space(4)))*)__builtin_amdgcn_kernarg_segment_ptr())[i]; }
enum { I_X = 0, I_MEM, I_GMIX, I_GFFN, I_GMEM, I_WMEMKV, I_WUP, I_CONVW, I_CONVB, I_WDOWN, I_AWIN, I_AWALPHA, I_ABALPHA, I_AGHEAD, I_AWOUT, I_GKV, I_WKV, I_PEK, I_PEV,
       I_WCK1, I_WCK2, I_WCV1, I_WCV2, I_BWIN, I_BWOUT, I_GFINAL };
#define WSP(T_, off) ((T_*)(F.ws + (off)))

__device__ __forceinline__ float wave_sum(float v) {
#pragma unroll
    for (int o = 1; o < 64; o <<= 1) v += __shfl_xor(v, o);
    return v;
}
__device__ __forceinline__ float wave_max(float v) {
#pragma unroll
    for (int o = 1; o < 64; o <<= 1) v = fmaxf(v, __shfl_xor(v, o));
    return v;
}

template <int MAP> __device__ __forceinline__ int map_row(int n) {
    if (MAP == 1) { return n < 1536 ? n : (n < 1552 ? n + 512 : n - 16); }
    if (MAP == 2) { return 768 + (n < 512 ? n : (n < 536 ? n + 512 : n - 24)); }
    if (MAP == 3) { const int half = n >= FF ? 1 : 0, f = n - half * FF; return 256 * (f >> 7) + 128 * half + (f & 127); }
    return n;
}
struct TrD { const float* W; const float* gain; bf16* WT; int K, N, row_off, map, item; };
__device__ __forceinline__ int map_row_rt(int map, int n) {
    if (map == 1) return map_row<1>(n);
    if (map == 2) return map_row<2>(n);
    if (map == 3) return map_row<3>(n);
    return n;
}
__device__ __forceinline__ void tr_load(float (&vv)[32], f32x4& ga, f32x4& gb, const TrD& d, int lane) {
    const int nblk = (d.N + 31) >> 5, kb = d.item / nblk, nb = d.item - kb * nblk, k0 = 64 * kb, n0 = 32 * nb;
    const int nn = n0 + (lane & 31);
    const float* wp = d.W + (size_t)(k0 + (lane >> 5)) * d.N + (nn < d.N ? nn : 0);
#pragma unroll
    for (int i = 0; i < 32; ++i) vv[i] = wp[(size_t)(2 * i) * d.N];
    ga = (f32x4){1.f, 1.f, 1.f, 1.f}; gb = ga;
    if (d.gain) { const f32x4* gp = (const f32x4*)(d.gain + k0 + 8 * (lane & 7)); ga = gp[0]; gb = gp[1]; }
}
__device__ __forceinline__ void tr_store(const float (&vv)[32], const f32x4 ga, const f32x4 gb, const TrD& d, LAS float* scr, int lane) {
    const int nblk = (d.N + 31) >> 5, kb = d.item / nblk, nb = d.item - kb * nblk, k0 = 64 * kb, n0 = 32 * nb;
#pragma unroll
    for (int i = 0; i < 32; ++i) scr[(2 * i + (lane >> 5)) * 33 + (lane & 31)] = vv[i];
    LDS_WAIT(); asm volatile("" ::: "memory");
    const int c = lane & 7;
#pragma unroll
    for (int j = 0; j < 4; ++j) { const int n = (lane >> 3) + 8 * j; const LAS float* s = scr + (8 * c) * 33 + n;
        v4u o; o.x = pg8::cvt_pk_bf16(s[0 * 33] * ga.x, s[1 * 33] * ga.y); o.y = pg8::cvt_pk_bf16(s[2 * 33] * ga.z, s[3 * 33] * ga.w); o.z = pg8::cvt_pk_bf16(s[4 * 33] * gb.x, s[5 * 33] * gb.y); o.w = pg8::cvt_pk_bf16(s[6 * 33] * gb.z, s[7 * 33] * gb.w);
        if (n0 + n < d.N) *(GAS v4u*)(d.WT + (size_t)(d.row_off + map_row_rt(d.map, n0 + n)) * d.K + k0 + 8 * c) = o; }
    LDS_WAIT(); asm volatile("" ::: "memory");
}
__device__ __forceinline__ void row_to_bf16_ss(const float* xrow, bf16* orow, float* ss, int lane) {
    const GAS f32x4* xr = (const GAS f32x4*)xrow + lane;
    f32x4 v[4]; float s = 0.f;
#pragma unroll
    for (int j = 0; j < 4; ++j) { v[j] = xr[64 * j]; s += (v[j].x * v[j].x + v[j].y * v[j].y) + (v[j].z * v[j].z + v[j].w * v[j].w); }
    s = wave_sum(s);
    GAS unsigned long long* o8 = (GAS unsigned long long*)orow + lane;
#pragma unroll
    for (int j = 0; j < 4; ++j) o8[64 * j] = (unsigned long long)pk2(v[j].x, v[j].y) | ((unsigned long long)pk2(v[j].z, v[j].w) << 32);
    if (lane < 16) ss[lane] = (lane == 0) ? s : 0.f;
}
constexpr int TR_I0 = 16 * 65, TR_I1 = 16 * 32, TR_I4 = 16 * 176, TR_I6 = 44 * 32, TR_I8 = 16 * 24, TR_I9 = 16 * 33, TR_I11 = 32 * 8, TR_I13 = 4 * 2;
constexpr int TR_NP0 = TR_I0 + 4 * TR_I1 + TR_I4 + TR_I6 + TR_I8 + TR_I9 + 2 * TR_I11 + 2 * TR_I13, TR_NITEMS = TR_NP0 + TR_I4 + TR_I6;
__device__ __forceinline__ TrD tr_decode(Frame& F, int r) {
    if (r < TR_I0) return TrD{in_ptr(I_AWIN), in_ptr(I_GMIX), WSP(bf16, WS_WA), 1024, 2064, 0, 1, r}; r -= TR_I0;
    if (r < TR_I1) return TrD{in_ptr(I_WMEMKV), in_ptr(I_GMEM), WSP(bf16, WS_WM), 1024, 1024, 0, 0, r}; r -= TR_I1;
    if (r < TR_I1) return TrD{in_ptr(I_WMEMKV) + 1024 * 1024, in_ptr(I_GMEM) + 1024, WSP(bf16, WS_WM), 1024, 1024, 1024, 0, r}; r -= TR_I1;
    if (r < TR_I1) return TrD{in_ptr(I_AWOUT), nullptr, WSP(bf16, WS_WOA), 1024, 1024, 0, 0, r}; r -= TR_I1;
    if (r < TR_I4) return TrD{in_ptr(I_WUP), in_ptr(I_GFFN), WSP(bf16, WS_WU), 1024, 2 * FF, 0, 3, r}; r -= TR_I4;
    if (r < TR_I6) return TrD{in_ptr(I_WDOWN), nullptr, WSP(bf16, WS_WD), FF, 1024, 0, 0, r}; r -= TR_I6;
    if (r < TR_I8) return TrD{in_ptr(I_WKV), in_ptr(I_GKV), WSP(bf16, WS_WB), 1024, 768, 0, 0, r}; r -= TR_I8;
    if (r < TR_I9) return TrD{in_ptr(I_BWIN), in_ptr(I_GMIX) + 1024, WSP(bf16, WS_WB), 1024, 1048, 0, 2, r}; r -= TR_I9;
    if (r < TR_I11) return TrD{in_ptr(I_WCK1), nullptr, WSP(bf16, WS_WC1), 2048, 256, 0, 0, r}; r -= TR_I11;
    if (r < TR_I11) return TrD{in_ptr(I_WCV1), nullptr, WSP(bf16, WS_WC1) + (size_t)256 * 2048, 2048, 256, 0, 0, r}; r -= TR_I11;
    if (r < TR_I13) return TrD{in_ptr(I_WCK2), nullptr, WSP(bf16, WS_WC2), 256, 64, 0, 0, r}; r -= TR_I13;
    if (r < TR_I13) return TrD{in_ptr(I_WCV2), nullptr, WSP(bf16, WS_WC2) + 64 * 256, 256, 64, 0, 0, r}; r -= TR_I13;
    if (r < TR_I1) return TrD{in_ptr(I_BWOUT), nullptr, WSP(bf16, WS_WOB), 1024, 1024, 0, 0, r}; r -= TR_I1;
    if (r < TR_I4) return TrD{in_ptr(I_WUP) + (size_t)1024 * 2 * FF, in_ptr(I_GFFN) + 1024, WSP(bf16, WS_WU) + (size_t)2 * FF * 1024, 1024, 2 * FF, 0, 3, r}; r -= TR_I4;
    return TrD{in_ptr(I_WDOWN) + (size_t)FF * 1024, nullptr, WSP(bf16, WS_WD) + (size_t)1024 * FF, FF, 1024, 0, 0, r};
}
__device__ __forceinline__ void tr_items(Frame& F, LAS float* scr, int w, int nw, int lo, int hi, int lane) {
    int it = lo + w;
    if (it >= hi) return;
    TrD d0 = tr_decode(F, it); float v0[32]; f32x4 g0a, g0b; tr_load(v0, g0a, g0b, d0, lane);
    TrD d1 = tr_decode(F, (it + nw < hi) ? it + nw : it); float v1[32]; f32x4 g1a, g1b; tr_load(v1, g1a, g1b, d1, lane);
#pragma unroll 1
    for (;;) {
        const int it2 = it + 2 * nw;
        const TrD d2 = tr_decode(F, (it2 < hi) ? it2 : it); float v2[32]; f32x4 g2a, g2b; tr_load(v2, g2a, g2b, d2, lane);
        tr_store(v0, g0a, g0b, d0, scr, lane);
        if (it + nw >= hi) break;
        it += nw; d0 = d1; g0a = g1a; g0b = g1b; d1 = d2; g1a = g2a; g1b = g2b;
#pragma unroll
        for (int i = 0; i < 32; ++i) { v0[i] = v1[i]; v1[i] = v2[i]; }
    }
}
__device__ __forceinline__ void p0_prologue(Frame& F) {
    LAS float* scr = (LAS float*)(F.lds + F.wave * 16384);
    const int gw = blockIdx.x * NWAVES + F.wave, NGW = F.G * NWAVES, lane = F.lane;
    for (int m = gw; m < MROWS; m += NGW) row_to_bf16_ss(in_ptr(I_MEM) + (size_t)m * D, WSP(bf16, WS_MEMB) + (size_t)m * D, WSP(float, WS_SSM) + (size_t)m * 16, lane);
    for (int o = gw; o < 512; o += NGW) { const int task = o >> 2, mlp = task >> 6, gi = task & 63, j = (o & 3) * 64 + lane; const float* pe = in_ptr(mlp ? I_PEV : I_PEK) + 32 * gi; const float* w1 = in_ptr(mlp ? I_WCV1 : I_WCK1) + (size_t)(32 * gi) * 256 + j;
        float wv[32];
#pragma unroll
        for (int kk = 0; kk < 32; ++kk) wv[kk] = w1[kk * 256];
        float s_ = 0.f;
#pragma unroll
        for (int kk = 0; kk < 32; ++kk) s_ += pe[kk] * wv[kk];
        WSP(float, WS_BPART)[(size_t)task * 256 + j] = s_; }
    tr_items(F, scr, gw, NGW, 0, (F.G == 256) ? TR_NP0 : TR_NITEMS, lane);
    { const int gt = blockIdx.x * 512 + F.tid, NT = F.G * 512; const v4u z = {0u, 0u, 0u, 0u};
      for (int i = gt; i < 240 * 128; i += NT) *(GAS v4u*)(WSP(bf16, WS_WA) + (size_t)2064 * 1024 + (size_t)i * 8) = z;
      for (int i = gt; i < 232 * 128; i += NT) *(GAS v4u*)(WSP(bf16, WS_WB) + (size_t)1816 * 1024 + (size_t)i * 8) = z; }
    { const float* xin = in_ptr(I_X); bf16* xbp = WSP(bf16, WS_XB); float* ssp = WSP(float, WS_SS);
      f32x4 v[8][4];
#pragma unroll
      for (int q = 0; q < 8; ++q) { const int mq = gw + q * NGW;
#pragma unroll
          for (int j = 0; j < 4; ++j) v[q][j] = ((const GAS f32x4*)(xin + (size_t)(mq < M ? mq : (M - 1)) * D) + lane)[64 * j]; }
#pragma unroll 1
      for (int m = gw; m < M; m += 8 * NGW) {
#pragma unroll
          for (int q = 0; q < 8; ++q) { const int mm = m + q * NGW; if (mm >= M) break;
              float s_ = 0.f;
#pragma unroll
              for (int j = 0; j < 4; ++j) s_ += (v[q][j].x * v[q][j].x + v[q][j].y * v[q][j].y) + (v[q][j].z * v[q][j].z + v[q][j].w * v[q][j].w);
              s_ += __int_as_float(__builtin_amdgcn_mov_dpp(__float_as_int(s_), 0xB1, 0xf, 0xf, true)); s_ += __int_as_float(__builtin_amdgcn_mov_dpp(__float_as_int(s_), 0x4E, 0xf, 0xf, true));
              GAS v2u* o8 = (GAS v2u*)(xbp + (size_t)mm * D) + lane;
#pragma unroll
              for (int j = 0; j < 4; ++j) { v2u w; w.x = pg8::cvt_pk_bf16(v[q][j].x, v[q][j].y); w.y = pg8::cvt_pk_bf16(v[q][j].z, v[q][j].w); o8[64 * j] = w; }
              if ((lane & 3) == 0) ssp[(size_t)mm * 16 + (lane >> 2)] = s_;
              const int mn = mm + 8 * NGW;
              if (mn < M) {
#pragma unroll
                  for (int j = 0; j < 4; ++j) v[q][j] = ((const GAS f32x4*)(xin + (size_t)mn * D) + lane)[64 * j]; } } } }
}
__device__ __forceinline__ void bias1_reduce(Frame& F) {
    const float* bp = WSP(float, WS_BPART) + (size_t)(F.tid >> 8) * 64 * 256 + (F.tid & 255);
    float v[64];
#pragma unroll
    for (int gi = 0; gi < 64; ++gi) v[gi] = bp[gi * 256];
    float s_ = 0.f;
#pragma unroll
    for (int gi = 0; gi < 64; ++gi) s_ += v[gi];
    WSP(float, WS_BIAS1)[F.tid] = s_;
}


typedef short bf16x8 __attribute__((ext_vector_type(8)));
typedef short s16x4 __attribute__((ext_vector_type(4)));
typedef float f32x16 __attribute__((ext_vector_type(16)));
__device__ __forceinline__ int crow(int r, int hi) { return (r & 3) + 8 * (r >> 2) + 4 * hi; }
typedef float f32x2_t __attribute__((ext_vector_type(2))); typedef __bf16 bf16x2_t __attribute__((ext_vector_type(2)));
__device__ __forceinline__ unsigned cvtpk(float lo, float hi) { const f32x2_t v = {lo, hi}; return __builtin_bit_cast(unsigned, __builtin_convertvector(v, bf16x2_t)); }
__device__ __forceinline__ void st_pair16(bf16* p0, int hi, v2u a, v2u b) {
    const auto r0 = __builtin_amdgcn_permlane32_swap(a.x, b.x, false, false); const auto r1 = __builtin_amdgcn_permlane32_swap(a.y, b.y, false, false);
    v4u w; w.x = r0[0]; w.y = r1[0]; w.z = r0[1]; w.w = r1[1];
    *(v4u*)(p0 + 8 * hi) = w;
}
__device__ __forceinline__ void dma16(const void* gsrc, LAS unsigned char* ldst) { __builtin_amdgcn_global_load_lds((const unsigned*)gsrc, (LAS unsigned*)ldst, 16, 0, 0); }
template <int NK16> __device__ __forceinline__ void qkt(f32x16& p0, f32x16& p1, const LAS unsigned char* Kt, const bf16x8* qr, int r32, int hi) {
    const LAS unsigned char* kb = Kt + hi * 1024 + r32 * 16;
    bf16x8 kf[2 * NK16];
#pragma unroll
    for (int d0 = 0; d0 < NK16; ++d0) { kf[2 * d0] = *(const LAS bf16x8*)(kb + d0 * 2048); kf[2 * d0 + 1] = *(const LAS bf16x8*)(kb + d0 * 2048 + 512); }
    __builtin_amdgcn_sched_barrier(0);
#pragma unroll
    for (int d0 = 0; d0 < NK16; ++d0) { p0 = __builtin_amdgcn_mfma_f32_32x32x16_bf16(kf[2 * d0], qr[d0], p0, 0, 0, 0); p1 = __builtin_amdgcn_mfma_f32_32x32x16_bf16(kf[2 * d0 + 1], qr[d0], p1, 0, 0, 0); }
    __builtin_amdgcn_sched_barrier(0);
}
__device__ __forceinline__ s16x4 vtr(const LAS unsigned char* p) { typedef short v4i16_t __attribute__((ext_vector_type(4))); return __builtin_bit_cast(s16x4, __builtin_amdgcn_ds_read_tr16_b64_v4i16((LAS v4i16_t*)p)); }
__device__ __forceinline__ void pack_p(bf16x8 (&pa)[4], const f32x16& p0, const f32x16& p1) {
    typedef unsigned u32x4_t __attribute__((ext_vector_type(4)));
    const u32x4_t w0 = {cvtpk(p0[0], p0[1]), cvtpk(p0[2], p0[3]), cvtpk(p0[4], p0[5]), cvtpk(p0[6], p0[7])}, w1 = {cvtpk(p0[8], p0[9]), cvtpk(p0[10], p0[11]), cvtpk(p0[12], p0[13]), cvtpk(p0[14], p0[15])};
    const u32x4_t w2 = {cvtpk(p1[0], p1[1]), cvtpk(p1[2], p1[3]), cvtpk(p1[4], p1[5]), cvtpk(p1[6], p1[7])}, w3 = {cvtpk(p1[8], p1[9]), cvtpk(p1[10], p1[11]), cvtpk(p1[12], p1[13]), cvtpk(p1[14], p1[15])};
    pa[0] = __builtin_bit_cast(bf16x8, w0); pa[1] = __builtin_bit_cast(bf16x8, w1); pa[2] = __builtin_bit_cast(bf16x8, w2); pa[3] = __builtin_bit_cast(bf16x8, w3);
}
template <int NDB> __device__ __forceinline__ void vfrag_issue(s16x4 (&vl)[NDB][4], s16x4 (&vh)[NDB][4], const LAS unsigned char* Vt, int lane) {
    const unsigned vb = (unsigned)(uintptr_t)(Vt + ((lane >> 4) & 1) * 32 + (lane & 3) * 8 + (4 * (lane >> 5) + ((lane & 15) >> 2)) * 64);
    asm volatile("s_waitcnt lgkmcnt(0)" ::: "memory");
#pragma unroll
    for (int db = 0; db < NDB; ++db)
#pragma unroll
        for (int ks = 0; ks < 4; ++ks) {
            asm volatile("ds_read_b64_tr_b16 %0, %1 offset:%c2" : "=&v"(vl[db][ks]) : "v"(vb), "i"(db * 4096 + ks * 1024) : "memory");
            asm volatile("ds_read_b64_tr_b16 %0, %1 offset:%c2" : "=&v"(vh[db][ks]) : "v"(vb), "i"(db * 4096 + ks * 1024 + 512) : "memory"); }
}
template <int NDB> __device__ __forceinline__ void pv_frag(f32x16* o, s16x4 (&vl)[NDB][4], s16x4 (&vh)[NDB][4], const bf16x8 (&pa)[4]) {
    asm volatile("s_waitcnt lgkmcnt(0)" ::: "memory");
#pragma unroll
    for (int db = 0; db < NDB; ++db)
#pragma unroll
        for (int ks = 0; ks < 4; ++ks) { asm volatile("" : "+v"(vl[db][ks]), "+v"(vh[db][ks]));
            const bf16x8 vf = {vl[db][ks][0], vl[db][ks][1], vl[db][ks][2], vl[db][ks][3], vh[db][ks][0], vh[db][ks][1], vh[db][ks][2], vh[db][ks][3]};
            o[db] = __builtin_amdgcn_mfma_f32_32x32x16_bf16(vf, pa[ks], o[db], 0, 0, 0); }
}
__device__ __forceinline__ float max3f(float a, float b, float c) { return __builtin_fmaxf(__builtin_fmaxf(a, b), c); }
__device__ __forceinline__ float max32(const f32x16& p0, const f32x16& p1) {
    float a = max3f(p0[0], p0[1], p1[0]), b = max3f(p0[2], p0[3], p1[1]); a = max3f(a, p1[2], p1[3]);
#pragma unroll
    for (int r = 4; r < 16; r += 4) { a = max3f(a, p0[r], p0[r + 1]); b = max3f(b, p0[r + 2], p0[r + 3]); a = max3f(a, p1[r], p1[r + 1]); b = max3f(b, p1[r + 2], p1[r + 3]); }
    const float m = fmaxf(a, b);
    const auto rr = __builtin_amdgcn_permlane32_swap(__float_as_uint(m), __float_as_uint(m), false, false);
    return fmaxf(__uint_as_float(rr[0]), __uint_as_float(rr[1]));
}
template <int NDB> __device__ __forceinline__ void softmax_step(f32x16& p0, f32x16& p1, float& m, float& l, f32x16* o) {
    const float mn = fmaxf(m, max32(p0, p1)); const float mu = (mn == -INFINITY) ? 0.f : mn; const float alpha = __builtin_amdgcn_exp2f(m - mu);
    float s = 0.f;
#pragma unroll
    for (int r = 0; r < 16; ++r) { p0[r] = __builtin_amdgcn_exp2f(p0[r] - mu); p1[r] = __builtin_amdgcn_exp2f(p1[r] - mu); s += p0[r] + p1[r]; }
    l = l * alpha + s; m = mn;
#pragma unroll
    for (int db = 0; db < NDB; ++db)
#pragma unroll
        for (int r = 0; r < 16; ++r) o[db][r] *= alpha;
}

__device__ __forceinline__ void ph_memattn_mfma(Frame& F, const bf16* Qb, int ldq, int qcol0, int layer, int vb, int VG) {
    const bf16* MKV = WSP(bf16, WS_MKV); bf16* CAT = WSP(bf16, WS_CAT);
    const int lane = F.lane, wave = F.wave, r32 = lane & 31, hi = lane >> 5;
    LAS unsigned char* Kl = F.lds; LAS unsigned char* Vl = F.lds + 65536;
    const int vlo = (vb * 512) / VG, vhi = ((vb + 1) * 512) / VG;
    int cur_bh = -1;
#pragma unroll 1
    for (int v = vlo; v < vhi; ++v) {
        const int bh = v >> 5, b = bh >> 2, h = bh & 3, q0 = (v & 31) * 256 + wave * 32;
        const size_t row = (size_t)b * T + q0 + r32;
        bf16x8 qr[8];
#pragma unroll
        for (int d0 = 0; d0 < 8; ++d0) qr[d0] = *(const bf16x8*)(Qb + row * ldq + qcol0 + h * 128 + d0 * 16 + hi * 8);
        if (bh != cur_bh) {
            __syncthreads();
            const char* kg = (const char*)(MKV + (size_t)(b * 256) * 2048 + layer * 1024 + h * 128); const char* vg = kg + 1024;
#pragma unroll
            for (int j = 0; j < 8; ++j) { const int pc = wave * 8 + j;
                dma16(kg + (size_t)((pc >> 4) * 64 + lane) * 4096 + (pc & 15) * 16, Kl + (pc >> 4) * 16384 + (pc & 15) * 1024);
                dma16(vg + (size_t)((pc >> 4) * 64 + (pc & 3) * 16 + (lane >> 2)) * 4096 + ((pc >> 2) & 3) * 64 + (lane & 3) * 16, Vl + (pc >> 4) * 16384 + ((pc >> 2) & 3) * 4096 + (pc & 3) * 1024); }
            cur_bh = bh;
            asm volatile("s_waitcnt vmcnt(0)" ::: "memory");
            __syncthreads();
        }
        f32x16 o[4]; o[0] = (f32x16){}; o[1] = (f32x16){}; o[2] = (f32x16){}; o[3] = (f32x16){};
        float m = -INFINITY, l = 0.f;
#pragma unroll 1
        for (int kt = 0; kt < 4; ++kt) {
            f32x16 p0 = (f32x16){}, p1 = (f32x16){}; qkt<8>(p0, p1, Kl + kt * 16384, qr, r32, hi);
            s16x4 vl[2][4], vh[2][4]; vfrag_issue<2>(vl, vh, Vl + kt * 16384, lane);
            softmax_step<4>(p0, p1, m, l, o);
            bf16x8 pa[4]; pack_p(pa, p0, p1);
            pv_frag<2>(o, vl, vh, pa);
            s16x4 vl2[2][4], vh2[2][4]; vfrag_issue<2>(vl2, vh2, Vl + kt * 16384 + 8192, lane);
            pv_frag<2>(o + 2, vl2, vh2, pa);
        }
        l += __shfl_xor(l, 32); const float inv = 1.0f / l;
        bf16* op = CAT + row * 1024 + 512 + h * 128;
#pragma unroll
        for (int db = 0; db < 4; ++db)
#pragma unroll
            for (int rg = 0; rg < 4; rg += 2) { v2u w, w2; w.x = cvtpk(o[db][4 * rg] * inv, o[db][4 * rg + 1] * inv); w.y = cvtpk(o[db][4 * rg + 2] * inv, o[db][4 * rg + 3] * inv);
                w2.x = cvtpk(o[db][4 * rg + 4] * inv, o[db][4 * rg + 5] * inv); w2.y = cvtpk(o[db][4 * rg + 6] * inv, o[db][4 * rg + 7] * inv);
                st_pair16(op + 32 * db + 8 * rg, hi, w, w2); }
    }
    __syncthreads();
}

constexpr int NS_K = 0, NS_V = 32768, NS_MAIN = 65536, NS_PITCH = 129, NS_SPILL = NS_MAIN + 64 * NS_PITCH * 4, NS_MASK = NS_SPILL + 64 * NS_PITCH * 4, NS_UNION = NS_MASK + 1024, NS_BLIST = NS_UNION + 16, NS_END = NS_BLIST + 512;
static_assert(NS_END <= LDSCTL_OFF, "NSA LDS map");
__device__ __forceinline__ void nsa_dma(const bf16* Kb, const bf16* Vb, int row0, LAS unsigned char* lds, int buf, int wave, int lane) {
    dma16((const char*)Kb + (size_t)(row0 + lane) * 128 + wave * 16, lds + NS_K + buf * 8192 + wave * 1024);
    if (Vb) dma16((const char*)Vb + (size_t)(row0 + (wave & 3) * 16 + (lane >> 2)) * 128 + (wave >> 2) * 64 + (lane & 3) * 16, lds + NS_V + buf * 8192 + (wave >> 2) * 4096 + (wave & 3) * 1024);
}
#define NSA_STAGE_BAR() asm volatile("s_waitcnt vmcnt(0) lgkmcnt(0)\n\ts_barrier" ::: "memory")
template <int KSTEP> __device__ __forceinline__ void nsa_bias(f32x16& p0, f32x16& p1, int base, float sl, float mref, bool lanevalid = true) {
    const float A = lanevalid ? (-sl * (float)base - mref) : -INFINITY, slk = sl * (float)KSTEP, C = slk * 32.0f;
#pragma unroll
    for (int r = 0; r < 16; ++r) { const float tr = fmaf(slk, (float)((r & 3) + 8 * (r >> 2)), A); p0[r] = tr; p1[r] = tr + C; }
}
template <int KSTEP, bool WINDOW> __device__ __forceinline__ void nsa_mask(f32x16& p0, f32x16& p1, int base) {
#pragma unroll
    for (int r = 0; r < 16; ++r) { const int d0 = base - KSTEP * ((r & 3) + 8 * (r >> 2)), d1 = d0 - 32 * KSTEP;
        const bool v0 = WINDOW ? (d0 >= 0 && d0 < 512) : (d0 >= 0), v1 = WINDOW ? (d1 >= 0 && d1 < 512) : (d1 >= 0);
        p0[r] = v0 ? p0[r] : -INFINITY; p1[r] = v1 ? p1[r] : -INFINITY; }
}
template <int NDB> __device__ __forceinline__ void nsa_softmax(f32x16& p0, f32x16& p1, float& m, float& l, f32x16* o) {
    const float mx = max32(p0, p1);
    if (__any(mx > 8.0f)) { const float dl = (mx > 8.0f) ? mx : 0.f; m += dl; const float ef = __builtin_amdgcn_exp2f(-dl); l *= ef;
#pragma unroll
        for (int r = 0; r < 16; ++r) { p0[r] -= dl; p1[r] -= dl; }
#pragma unroll
        for (int db = 0; db < NDB; ++db)
#pragma unroll
            for (int r = 0; r < 16; ++r) o[db][r] *= ef; }
    float s = 0.f;
#pragma unroll
    for (int r = 0; r < 16; ++r) { p0[r] = __builtin_amdgcn_exp2f(p0[r]); p1[r] = __builtin_amdgcn_exp2f(p1[r]); s += p0[r] + p1[r]; }
    l += s;
}
__device__ __forceinline__ float dpp_xor1(float v) { return __int_as_float(__builtin_amdgcn_mov_dpp(__float_as_int(v), 0xB1, 0xf, 0xf, true)); }
__device__ __forceinline__ float dpp_xor2(float v) { return __int_as_float(__builtin_amdgcn_mov_dpp(__float_as_int(v), 0x4E, 0xf, 0xf, true)); }
__device__ __forceinline__ void ph_nsa_mfma(Frame& F) {
    const bf16* PB = WSP(bf16, WS_R1); const bf16* KVC = WSP(bf16, WS_KVC); const bf16* KCMP = WSP(bf16, WS_KCMP); bf16* CAT = WSP(bf16, WS_CAT);
    const int lane = F.lane, wave = F.wave, tid = F.tid, r32 = lane & 31, hi = lane >> 5, hp = r32 & 3, q8 = r32 >> 2, ql = 8 * wave + q8;
    LAS unsigned char* lds = F.lds;
    LAS float* Lmain = (LAS float*)(lds + NS_MAIN); LAS float* Lspill = (LAS float*)(lds + NS_SPILL); LAS unsigned* Lmask = (LAS unsigned*)(lds + NS_MASK); LAS unsigned* Lunion = (LAS unsigned*)(lds + NS_UNION); LAS int* Lblist = (LAS int*)(lds + NS_BLIST);
    const int nunits = 1024, per = (nunits + F.G - 1) / F.G;
#define NSA_UNIT(ui_, bg_, qt_, ok_) do { if (F.G == 256) { const int s_ = blockIdx.x & 31; bg_ = blockIdx.x >> 5; qt_ = ((ui_) == 0) ? s_ : ((ui_) == 1) ? 63 - s_ : ((ui_) == 2) ? 64 + s_ : 127 - s_; ok_ = (ui_) < 4; } \
        else { const int u_ = blockIdx.x + (ui_) * F.G; ok_ = (ui_) < per && u_ < nunits; bg_ = u_ >> 7; qt_ = u_ & 127; } } while (0)
    int sp = 0;
    if (wave >= 4) __builtin_amdgcn_s_setprio(1);
    { int bg0, qt0; bool ok0; NSA_UNIT(0, bg0, qt0, ok0);
      if (ok0) { const int nt0 = (4 * qt0 + 3 + 63) >> 6; const bf16* kc0 = KCMP + (size_t)(bg0 * NCMPP) * 64; nsa_dma(kc0, nullptr, (nt0 - 1) * 64, lds, 0, wave, lane); if (nt0 > 1) nsa_dma(kc0, nullptr, (nt0 - 2) * 64, lds, 1, wave, lane); } }
    bf16x8 qnx[4]; unsigned short gnx[3];
    { int bg0, qt0; bool ok0; NSA_UNIT(0, bg0, qt0, ok0); if (!ok0) { bg0 = 0; qt0 = 0; }
      const size_t row0_ = (size_t)(bg0 >> 1) * T + qt0 * 64 + ql; const int head0_ = (bg0 & 1) * 4 + hp;
#pragma unroll
      for (int d0 = 0; d0 < 4; ++d0) qnx[d0] = *(const bf16x8*)(PB + row0_ * NPB + PB_Q + head0_ * 64 + d0 * 16 + hi * 8);
#pragma unroll
      for (int i = 0; i < 3; ++i) gnx[i] = PB[row0_ * NPB + PB_GL + head0_ * 3 + i]; }
#pragma unroll 1
    for (int ui = 0; ui < per; ++ui) {
        int bg, qt; bool ok_u; NSA_UNIT(ui, bg, qt, ok_u); if (!ok_u) break;
        int bgn, qtn; bool ok_n; NSA_UNIT(ui + 1, bgn, qtn, ok_n);
        const int b = bg >> 1, g = bg & 1, t0 = qt * 64, t = t0 + ql, cur = qt, tmin = t0 + 8 * wave;
        const size_t row = (size_t)b * T + t; const int head = g * 4 + hp;
        const float slope2 = exp2f(-(float)(head + 1)) * 1.4426950408889634f;
        bf16x8 qr[4];
#pragma unroll
        for (int d0 = 0; d0 < 4; ++d0) qr[d0] = qnx[d0];
        float gate[3];
#pragma unroll
        for (int i = 0; i < 3; ++i) gate[i] = pg8::sigmoid_f(bf2f(gnx[i]));
        if (tid < 4) Lunion[tid] = 0u;
        LAS float* Ltot = (LAS float*)(lds + NS_MAIN) + tid;
        const bf16* kcb = KCMP + (size_t)(bg * NCMPP) * 64; const bf16* vcb = KCMP + (size_t)(4096 + bg * NCMPP) * 64;
        const int nt = (4 * qt + 3 + 63) >> 6;
        float m = 0.f, l = 0.f;
#pragma unroll 1
        for (int st = 0; 2 * st < nt; ++st) {
            NSA_STAGE_BAR();
            { const int i2 = 2 * st + 2, sb = ((sp + st + 1) & 1) * 2; if (i2 < nt) { nsa_dma(kcb, nullptr, (nt - 1 - i2) * 64, lds, sb, wave, lane); if (i2 + 1 < nt) nsa_dma(kcb, nullptr, (nt - 2 - i2) * 64, lds, sb + 1, wave, lane); }
              else { nsa_dma(kcb, vcb, (nt - 1) * 64, lds, sb, wave, lane); if (nt > 1) nsa_dma(kcb, vcb, (nt - 2) * 64, lds, sb + 1, wave, lane); } }
#pragma unroll 1
            for (int h2 = 0; h2 < 2; ++h2) { const int it = 2 * st + h2; if (it >= nt) break; const int kt = nt - 1 - it, buf = ((sp + st) & 1) * 2 + h2;
                const int base = t - 31 - 16 * (64 * kt + 4 * hi);
                f32x16 p0, p1; nsa_bias<16>(p0, p1, base, slope2, m); qkt<4>(p0, p1, lds + NS_K + buf * 8192, qr, r32, hi);
                if (1024 * kt + 1039 > tmin) nsa_mask<16, false>(p0, p1, base);
                nsa_softmax<0>(p0, p1, m, l, nullptr); }
        }
        sp = (sp + ((nt + 1) >> 1)) & 1;
        l += __shfl_xor(l, 32);
        const float invl = 1.0f / fmaxf(l, 1e-30f);
        f32x16 o[2]; o[0] = (f32x16){}; o[1] = (f32x16){};
        const bf16* ksb = KVC + 2 * KVSTRIDE + (size_t)bg * 8192 * 64; const bf16* vsb = KVC + 3 * KVSTRIDE + (size_t)bg * 8192 * 64;
#pragma unroll 1
        for (int st = 0; 2 * st < nt; ++st) {
            NSA_STAGE_BAR();
            { const int i2 = 2 * st + 2, sb = ((sp + st + 1) & 1) * 2; if (i2 < nt) { nsa_dma(kcb, vcb, (nt - 1 - i2) * 64, lds, sb, wave, lane); if (i2 + 1 < nt) nsa_dma(kcb, vcb, (nt - 2 - i2) * 64, lds, sb + 1, wave, lane); }
              else { nsa_dma(ksb, vsb, cur * 64, lds, sb, wave, lane); if (cur > 0) nsa_dma(ksb, vsb, (cur - 1) * 64, lds, sb + 1, wave, lane); } }
#pragma unroll 1
            for (int h2 = 0; h2 < 2; ++h2) { const int it = 2 * st + h2; if (it >= nt) break; const int kt = nt - 1 - it, buf = ((sp + st) & 1) * 2 + h2;
                const int base = t - 31 - 16 * (64 * kt + 4 * hi);
                f32x16 p0, p1; nsa_bias<16>(p0, p1, base, slope2, m); qkt<4>(p0, p1, lds + NS_K + buf * 8192, qr, r32, hi);
                s16x4 vl[2][4], vh[2][4]; vfrag_issue<2>(vl, vh, lds + NS_V + buf * 8192, lane);
                if (1024 * kt + 1039 > tmin) nsa_mask<16, false>(p0, p1, base);
#pragma unroll
                for (int r = 0; r < 16; ++r) { p0[r] = __builtin_amdgcn_exp2f(p0[r]) * invl; p1[r] = __builtin_amdgcn_exp2f(p1[r]) * invl; }
#pragma unroll
                for (int pi = 0; pi < 2; ++pi)
#pragma unroll
                    for (int rg = 0; rg < 4; ++rg) { const f32x16& pp = pi ? p1 : p0; float v3 = 0.5f * pp[4 * rg + 3]; float vm = (pp[4 * rg] + pp[4 * rg + 1]) + (pp[4 * rg + 2] + v3);
                        vm += dpp_xor1(vm); vm += dpp_xor2(vm); v3 += dpp_xor1(v3); v3 += dpp_xor2(v3);
                        const int a = 16 * kt + 8 * pi + 2 * rg + hi;
                        if (hp == 0) { Lmain[ql * NS_PITCH + a] = vm; Lspill[ql * NS_PITCH + a] = v3; } }
                bf16x8 pa[4]; pack_p(pa, p0, p1);
                pv_frag<2>(o, vl, vh, pa); }
        }
        sp = (sp + ((nt + 1) >> 1)) & 1;
        __syncthreads();
#pragma unroll
        for (int db = 0; db < 2; ++db)
#pragma unroll
            for (int r = 0; r < 16; ++r) o[db][r] *= gate[0];
        {
            int q = tid >> 3, s8 = tid & 7; asm volatile("" : "+v"(q), "+v"(s8));
            unsigned mw0 = 0u, mw1 = 0u, mw2 = 0u, mw3 = 0u;
            if (cur < 16) { mw0 = (1u << (cur + 1)) - 1u; }
            else {
                float val[16];
#pragma unroll
                for (int k = 0; k < 16; ++k) { const int j = s8 + 8 * k;
                    val[k] = (j > cur) ? -INFINITY : ((j == 0 || j >= cur - 1) ? INFINITY : Lmain[q * NS_PITCH + j] + Lspill[q * NS_PITCH + j - 1]); }
#pragma unroll 1
                for (int round = 0; round < 16; ++round) {
                    float bv = val[0]; int bj = s8;
#pragma unroll
                    for (int k = 1; k < 16; ++k) { const bool gt = val[k] > bv; bv = gt ? val[k] : bv; bj = gt ? (s8 + 8 * k) : bj; }
#pragma unroll
                    for (int stp = 0; stp < 3; ++stp) {
                        const float ov = __int_as_float(stp == 0 ? __builtin_amdgcn_mov_dpp(__float_as_int(bv), 0xB1, 0xf, 0xf, true) : stp == 1 ? __builtin_amdgcn_mov_dpp(__float_as_int(bv), 0x4E, 0xf, 0xf, true) : __builtin_amdgcn_mov_dpp(__float_as_int(bv), 0x141, 0xf, 0xf, true));
                        const int oj = stp == 0 ? __builtin_amdgcn_mov_dpp(bj, 0xB1, 0xf, 0xf, true) : stp == 1 ? __builtin_amdgcn_mov_dpp(bj, 0x4E, 0xf, 0xf, true) : __builtin_amdgcn_mov_dpp(bj, 0x141, 0xf, 0xf, true);
                        const bool tk = (ov > bv) || (ov == bv && oj < bj); bv = tk ? ov : bv; bj = tk ? oj : bj; }
#pragma unroll
                    for (int k = 0; k < 16; ++k) val[k] = (bj == s8 + 8 * k) ? -INFINITY : val[k];
                    const unsigned bit = 1u << (bj & 31); const int wsel = bj >> 5;
                    mw0 |= (wsel == 0) ? bit : 0u; mw1 |= (wsel == 1) ? bit : 0u; mw2 |= (wsel == 2) ? bit : 0u; mw3 |= (wsel == 3) ? bit : 0u;
                }
            }
            if (s8 == 0) { Lmask[q * 4 + 0] = mw0; Lmask[q * 4 + 1] = mw1; Lmask[q * 4 + 2] = mw2; Lmask[q * 4 + 3] = mw3;
                atomicOr((unsigned*)&Lunion[0], mw0); atomicOr((unsigned*)&Lunion[1], mw1); atomicOr((unsigned*)&Lunion[2], mw2); atomicOr((unsigned*)&Lunion[3], mw3); }
        }
        __syncthreads();
        int nsel;
        { const unsigned u0 = Lunion[0], u1 = Lunion[1], u2 = Lunion[2], u3 = Lunion[3];
          nsel = __builtin_amdgcn_readfirstlane(__popc(u0) + __popc(u1) + __popc(u2) + __popc(u3));
          if (tid < 128) { const unsigned uw = (tid < 32) ? u0 : (tid < 64) ? u1 : (tid < 96) ? u2 : u3; const int bp = tid & 31;
              if ((uw >> bp) & 1u) { int pos = __popc(uw & ((1u << bp) - 1u)); if (tid >= 32) pos += __popc(u0); if (tid >= 64) pos += __popc(u1); if (tid >= 96) pos += __popc(u2); Lblist[pos] = tid; } } }
        const unsigned mq0 = Lmask[ql * 4 + 0], mq1 = Lmask[ql * 4 + 1], mq2 = Lmask[ql * 4 + 2], mq3 = Lmask[ql * 4 + 3];
        __syncthreads();
#pragma unroll
        for (int db = 0; db < 2; ++db)
#pragma unroll
            for (int r = 0; r < 16; ++r) Ltot[(db * 16 + r) * 512] = o[db][r];
        const bf16* kwb = KVC + 4 * KVSTRIDE + (size_t)bg * 8192 * 64; const bf16* vwb = KVC + 5 * KVSTRIDE + (size_t)bg * 8192 * 64;
        o[0] = (f32x16){}; o[1] = (f32x16){}; m = 0.f; l = 0.f;
#pragma unroll 1
        for (int st = 0; 2 * st < nsel; ++st) {
            NSA_STAGE_BAR();
            { const int i2 = 2 * st + 2, sb = ((sp + st + 1) & 1) * 2; if (i2 < nsel) { nsa_dma(ksb, vsb, __builtin_amdgcn_readfirstlane(Lblist[nsel - 1 - i2]) * 64, lds, sb, wave, lane); if (i2 + 1 < nsel) nsa_dma(ksb, vsb, __builtin_amdgcn_readfirstlane(Lblist[nsel - 2 - i2]) * 64, lds, sb + 1, wave, lane); }
              else { nsa_dma(kwb, vwb, qt * 64, lds, sb, wave, lane); if (qt > 0) nsa_dma(kwb, vwb, (qt - 1) * 64, lds, sb + 1, wave, lane); } }
#pragma unroll 1
            for (int h2 = 0; h2 < 2; ++h2) { const int i = 2 * st + h2; if (i >= nsel) break; const int j = __builtin_amdgcn_readfirstlane(Lblist[nsel - 1 - i]), buf = ((sp + st) & 1) * 2 + h2;
                const unsigned wj = (j < 32) ? mq0 : (j < 64) ? mq1 : (j < 96) ? mq2 : mq3; const bool selq = (wj >> (j & 31)) & 1u;
                const int base = t - (64 * j + 4 * hi);
                f32x16 p0, p1; nsa_bias<1>(p0, p1, base, slope2, m, selq);
                qkt<4>(p0, p1, lds + NS_K + buf * 8192, qr, r32, hi);
                s16x4 vl[2][4], vh[2][4]; vfrag_issue<2>(vl, vh, lds + NS_V + buf * 8192, lane);
                if (j == cur) nsa_mask<1, false>(p0, p1, base);
                nsa_softmax<2>(p0, p1, m, l, o);
                bf16x8 pa[4]; pack_p(pa, p0, p1);
                pv_frag<2>(o, vl, vh, pa); }
        }
        sp = (sp + ((nsel + 1) >> 1)) & 1;
        { l += __shfl_xor(l, 32); const float sc = gate[1] / fmaxf(l, 1e-30f);
#pragma unroll
          for (int db = 0; db < 2; ++db)
#pragma unroll
            for (int r = 0; r < 16; ++r) Ltot[(db * 16 + r) * 512] += sc * o[db][r]; }
        o[0] = (f32x16){}; o[1] = (f32x16){}; m = 0.f; l = 0.f;
        const int j0 = qt >= 8 ? qt - 8 : 0, nw = qt - j0 + 1;
#pragma unroll 1
        for (int st = 0; 2 * st < nw; ++st) {
            NSA_STAGE_BAR();
            if (st == 0 && ok_n) { const size_t rown_ = (size_t)(bgn >> 1) * T + qtn * 64 + ql; const int headn_ = (bgn & 1) * 4 + hp;
#pragma unroll
                for (int d0 = 0; d0 < 4; ++d0) qnx[d0] = *(const bf16x8*)(PB + rown_ * NPB + PB_Q + headn_ * 64 + d0 * 16 + hi * 8);
#pragma unroll
                for (int i = 0; i < 3; ++i) gnx[i] = PB[rown_ * NPB + PB_GL + headn_ * 3 + i]; }
            { const int i2 = 2 * st + 2, sb = ((sp + st + 1) & 1) * 2; if (i2 < nw) { nsa_dma(kwb, vwb, (qt - i2) * 64, lds, sb, wave, lane); if (i2 + 1 < nw) nsa_dma(kwb, vwb, (qt - i2 - 1) * 64, lds, sb + 1, wave, lane); }
              else if (ok_n) { const int ntn = (4 * qtn + 3 + 63) >> 6; const bf16* kcn = KCMP + (size_t)(bgn * NCMPP) * 64; nsa_dma(kcn, nullptr, (ntn - 1) * 64, lds, sb, wave, lane); if (ntn > 1) nsa_dma(kcn, nullptr, (ntn - 2) * 64, lds, sb + 1, wave, lane); } }
#pragma unroll 1
            for (int h2 = 0; h2 < 2; ++h2) { const int i = 2 * st + h2; if (i >= nw) break; const int j = qt - i, buf = ((sp + st) & 1) * 2 + h2;
                const int base = t - (64 * j + 4 * hi);
                f32x16 p0, p1; nsa_bias<1>(p0, p1, base, slope2, m); qkt<4>(p0, p1, lds + NS_K + buf * 8192, qr, r32, hi);
                s16x4 vl[2][4], vh[2][4]; vfrag_issue<2>(vl, vh, lds + NS_V + buf * 8192, lane);
                if (j == qt || j + 8 == qt) nsa_mask<1, true>(p0, p1, base);
                nsa_softmax<2>(p0, p1, m, l, o);
                bf16x8 pa[4]; pack_p(pa, p0, p1);
                pv_frag<2>(o, vl, vh, pa); }
        }
        sp = (sp + ((nw + 1) >> 1)) & 1;
        { l += __shfl_xor(l, 32); const float sc = gate[2] / fmaxf(l, 1e-30f);
          bf16* op = CAT + row * 1024 + head * 64;
#pragma unroll
          for (int db = 0; db < 2; ++db)
#pragma unroll
            for (int rg = 0; rg < 4; rg += 2) { v2u wp[2];
#pragma unroll
                for (int k = 0; k < 2; ++k) { const int r_ = 4 * (rg + k); const float v0 = Ltot[(db * 16 + r_) * 512] + sc * o[db][r_], v1 = Ltot[(db * 16 + r_ + 1) * 512] + sc * o[db][r_ + 1], v2 = Ltot[(db * 16 + r_ + 2) * 512] + sc * o[db][r_ + 2], v3 = Ltot[(db * 16 + r_ + 3) * 512] + sc * o[db][r_ + 3];
                    wp[k].x = cvtpk(v0, v1); wp[k].y = cvtpk(v2, v3); }
                st_pair16(op + 32 * db + 8 * rg, hi, wp[0], wp[1]); } }
    }
#undef NSA_UNIT
    __builtin_amdgcn_s_setprio(0);
    asm volatile("s_waitcnt vmcnt(0)" ::: "memory"); __syncthreads();
}
constexpr size_t WS_DS = WS_OG, WS_SP = WS_LA, WS_DEC = WS_R2 + 96 * MiB, WS_BC = WS_BND;
constexpr int GL_ALR = 0, GL_TOT = 4096, GL_BL = 5120, GL_KE = 8192, GL_V = 40960;
static_assert(GL_V + 65536 <= LDSCTL_OFF, "GLA LDS map");
__device__ __forceinline__ void gla_dma_v(const bf16* PA, int row0, LAS unsigned char* lds, int wave, int lane) {
#pragma unroll
    for (int j = 0; j < 8; ++j) { const int pc = wave * 8 + j, h = pc >> 4, db = (pc >> 2) & 3, kg4 = pc & 3;
        dma16((const char*)(PA + (size_t)(row0 + kg4 * 16 + (lane >> 2)) * NPA + PA_V + h * 128 + db * 32) + (lane & 3) * 16, lds + GL_V + h * 16384 + db * 4096 + kg4 * 1024); }
}
__device__ __forceinline__ void ph_gla_local(Frame& F) {
    const bf16* PA = WSP(bf16, WS_R1); float* BC = WSP(float, WS_BC); bf16* DS = WSP(bf16, WS_DS); float* DEC = WSP(float, WS_DEC);
    const float* wa = in_ptr(I_AWALPHA); const float* ba = in_ptr(I_ABALPHA);
    const int lane = F.lane, wave = F.wave, tid = F.tid, r32 = lane & 31, hi = lane >> 5;
    LAS unsigned char* lds = F.lds; LAS float* Lalr = (LAS float*)(lds + GL_ALR); LAS float* Ltot = (LAS float*)(lds + GL_TOT); LAS float* Lbl = (LAS float*)(lds + GL_BL);
    const int ch = tid & 255, half = tid >> 8, h = ch >> 6, d = ch & 63;
    float w[16];
#pragma unroll
    for (int j = 0; j < 16; ++j) w[j] = wa[j * 256 + ch];
    const float bias = ba[ch];
#pragma unroll 1
    for (int u = blockIdx.x; u < 512; u += F.G) {
        const int b = u >> 7, c = u & 127, row0 = b * T + c * 64;
        gla_dma_v(PA, row0, lds, wave, lane);
#pragma unroll
        for (int k = 0; k < 2; ++k) { const int idx = tid + 512 * k; Lalr[idx] = bf2f(PA[(size_t)(row0 + (idx >> 4)) * NPA + PA_ALR + (idx & 15)]); }
        unsigned short kraw[32];
#pragma unroll
        for (int i = 0; i < 32; ++i) kraw[i] = PA[(size_t)(row0 + half * 32 + i) * NPA + PA_K + ch];
        LDS_WAIT(); __syncthreads();
        float bb[32]; float run = 0.f;
#pragma unroll
        for (int i = 0; i < 32; ++i) { const LAS f32x4* ap = (const LAS f32x4*)(Lalr + (half * 32 + i) * 16); const f32x4 a0 = ap[0], a1 = ap[1], a2 = ap[2], a3 = ap[3];
            float z = bias + a0.x * w[0] + a0.y * w[1] + a0.z * w[2] + a0.w * w[3] + a1.x * w[4] + a1.y * w[5] + a1.z * w[6] + a1.w * w[7] + a2.x * w[8] + a2.y * w[9] + a2.z * w[10] + a2.w * w[11] + a3.x * w[12] + a3.y * w[13] + a3.z * w[14] + a3.w * w[15];
            const float ls = fminf(z, 0.f) - __logf(1.0f + __expf(-fabsf(z)));
            run += ls * (1.0f / 16.0f); bb[i] = run; }
        if (half == 0) Ltot[ch] = run;
        LDS_WAIT(); __syncthreads();
        if (half == 1) { const float off = Ltot[ch];
#pragma unroll
            for (int i = 0; i < 32; ++i) bb[i] += off;
            Lbl[ch] = bb[31]; }
        LDS_WAIT(); __syncthreads();
        const float bl = Lbl[ch];
        LAS bf16* ke = (LAS bf16*)(lds + GL_KE + h * 8192 + (d >> 5) * 4096 + (d & 31) * 2);
        {
#pragma unroll
          for (int i = 0; i < 32; ++i) { const int t = half * 32 + i; ke[t * 32] = (bf16)f2bf(bf2f(kraw[i]) * __expf(bl - bb[i])); }
#pragma unroll
          for (int i = 0; i < 32; ++i) BC[(size_t)(row0 + half * 32 + i) * 256 + ch] = bb[i]; }
        if (half == 1) DEC[((size_t)(b * 4 + h) * 128 + c) * 64 + d] = __expf(bl);
        asm volatile("s_waitcnt vmcnt(0)" ::: "memory"); LDS_WAIT(); __syncthreads();
        { const int hw = wave >> 1, nb = wave & 1;
          const unsigned lo_ = ((lane >> 4) & 1) * 32 + (lane & 3) * 8 + (8 * hi + ((lane & 15) >> 2)) * 64;
          const LAS unsigned char* kb = lds + GL_KE + hw * 8192 + nb * 4096 + lo_; const LAS unsigned char* vb = lds + GL_V + hw * 16384 + lo_;
          bf16x8 kf[4];
#pragma unroll
          for (int ks = 0; ks < 4; ++ks) { const s16x4 a = vtr(kb + ks * 1024), bq = vtr(kb + ks * 1024 + 256); kf[ks] = (bf16x8){a[0], a[1], a[2], a[3], bq[0], bq[1], bq[2], bq[3]}; }
          bf16* dsb = DS + ((size_t)(b * 4 + hw) * 128 + c) * 8192 + (size_t)r32 * 64 + nb * 32;
#pragma unroll
          for (int mb = 0; mb < 4; ++mb) { f32x16 acc = (f32x16){};
#pragma unroll
              for (int ks = 0; ks < 4; ++ks) { const s16x4 a = vtr(vb + mb * 4096 + ks * 1024), bq = vtr(vb + mb * 4096 + ks * 1024 + 256); const bf16x8 vf = {a[0], a[1], a[2], a[3], bq[0], bq[1], bq[2], bq[3]};
                  acc = __builtin_amdgcn_mfma_f32_32x32x16_bf16(kf[ks], vf, acc, 0, 0, 0); }
#pragma unroll
              for (int rg = 0; rg < 4; rg += 2) { v2u w, w2; w.x = cvtpk(acc[4 * rg], acc[4 * rg + 1]); w.y = cvtpk(acc[4 * rg + 2], acc[4 * rg + 3]); w2.x = cvtpk(acc[4 * rg + 4], acc[4 * rg + 5]); w2.y = cvtpk(acc[4 * rg + 6], acc[4 * rg + 7]);
                  st_pair16(dsb + (size_t)mb * 32 * 64 + 8 * rg, hi, w, w2); } } }
        __syncthreads();
    }
}
__device__ __forceinline__ void ph_gla_scan(Frame& F) {
    const bf16* __restrict__ DS = WSP(bf16, WS_DS); const float* __restrict__ DEC = WSP(float, WS_DEC); bf16* __restrict__ SP = WSP(bf16, WS_SP);
    typedef float f32x2_ __attribute__((ext_vector_type(2)));
    constexpr int NB_ = 32;
    if (F.tid >= 256) return;
#pragma unroll 1
    for (int i = blockIdx.x * 256 + F.tid; i < 16 * 128 * 32; i += F.G * 256) { const int dp = i & 31, e = (i >> 5) & 127, bh = i >> 12;
        const bf16* dsp = DS + (size_t)bh * 128 * 8192 + e * 64 + 2 * dp; const float* dcp = DEC + (size_t)bh * 128 * 64 + 2 * dp; bf16* spp = SP + (size_t)bh * 128 * 8192 + e * 64 + 2 * dp;
        float S0 = 0.f, S1 = 0.f; unsigned ds[NB_]; f32x2_ dc[NB_];
#pragma unroll
        for (int k = 0; k < NB_; ++k) { ds[k] = *(const unsigned*)(dsp + (size_t)k * 8192); dc[k] = *(const f32x2_*)(dcp + k * 64); }
#pragma unroll 1
        for (int c0 = 0; c0 < 128; c0 += NB_) { unsigned dn[NB_]; f32x2_ cn[NB_]; const int cn0 = c0 + NB_ < 128 ? c0 + NB_ : c0;
#pragma unroll
            for (int k = 0; k < NB_; ++k) { dn[k] = *(const unsigned*)(dsp + (size_t)(cn0 + k) * 8192); cn[k] = *(const f32x2_*)(dcp + (cn0 + k) * 64); }
#pragma unroll
            for (int k = 0; k < NB_; ++k) { *(unsigned*)(spp + (size_t)(c0 + k) * 8192) = pg8::cvt_pk_bf16(S0, S1); S0 = dc[k].x * S0 + bflo(ds[k]); S1 = dc[k].y * S1 + bfhi(ds[k]); }
#pragma unroll
            for (int k = 0; k < NB_; ++k) { ds[k] = dn[k]; dc[k] = cn[k]; } } }
}
__device__ __forceinline__ void ph_gla_out(Frame& F) {
    const bf16* __restrict__ PA = WSP(bf16, WS_R1); const float* __restrict__ BC = WSP(float, WS_BC); const bf16* __restrict__ SP = WSP(bf16, WS_SP); bf16* __restrict__ CAT = WSP(bf16, WS_CAT); const float* __restrict__ gh = in_ptr(I_AGHEAD);
    const int lane = F.lane, wave = F.wave, r32 = lane & 31, hi = lane >> 5;
    LAS unsigned char* lds = F.lds;
    typedef unsigned u32x4_t __attribute__((ext_vector_type(4)));
#pragma unroll 1
    for (int u = blockIdx.x; u < 512; u += F.G) {
        const int b = u >> 7, c = u & 127, row0 = b * T + c * 64, h = wave >> 1, tb = wave & 1, t = 32 * tb + r32;
        gla_dma_v(PA, row0, lds, wave, lane);
        u32x4_t qw[4]; f32x4 qb[4][2];
#pragma unroll
        for (int ks = 0; ks < 4; ++ks) { qw[ks] = *(const u32x4_t*)(PA + (size_t)(row0 + t) * NPA + PA_Q + h * 64 + 16 * ks + 8 * hi); const f32x4* bp = (const f32x4*)(BC + (size_t)(row0 + t) * 256 + h * 64 + 16 * ks + 8 * hi); qb[ks][0] = bp[0]; qb[ks][1] = bp[1]; }
        u32x4_t kw[4]; f32x4 kb[4][2];
#pragma unroll
        for (int ks = 0; ks < 4; ++ks) { kw[ks] = *(const u32x4_t*)(PA + (size_t)(row0 + r32) * NPA + PA_K + h * 64 + 16 * ks + 8 * hi); const f32x4* bp = (const f32x4*)(BC + (size_t)(row0 + r32) * 256 + h * 64 + 16 * ks + 8 * hi); kb[ks][0] = bp[0]; kb[ks][1] = bp[1]; }
        bf16x8 qr[4];
#pragma unroll
        for (int ks = 0; ks < 4; ++ks) { const u32x4_t w = qw[ks]; const f32x4 b0 = qb[ks][0], b1 = qb[ks][1];
            u32x4_t o_; o_.x = cvtpk(bflo(w.x) * 0.125f * __expf(b0.x), bfhi(w.x) * 0.125f * __expf(b0.y)); o_.y = cvtpk(bflo(w.y) * 0.125f * __expf(b0.z), bfhi(w.y) * 0.125f * __expf(b0.w));
            o_.z = cvtpk(bflo(w.z) * 0.125f * __expf(b1.x), bfhi(w.z) * 0.125f * __expf(b1.y)); o_.w = cvtpk(bflo(w.w) * 0.125f * __expf(b1.z), bfhi(w.w) * 0.125f * __expf(b1.w));
            qr[ks] = __builtin_bit_cast(bf16x8, o_); }
        f32x16 pT[2]; pT[0] = (f32x16){}; pT[1] = (f32x16){};
#pragma unroll
        for (int sb = 0; sb < 2; ++sb) { if (sb > tb) continue;
            bf16x8 kf[4];
#pragma unroll
            for (int ks = 0; ks < 4; ++ks) { const u32x4_t w = kw[ks]; const f32x4 b0 = kb[ks][0], b1 = kb[ks][1];
                u32x4_t o_; o_.x = cvtpk(bflo(w.x) * __expf(-b0.x), bfhi(w.x) * __expf(-b0.y)); o_.y = cvtpk(bflo(w.y) * __expf(-b0.z), bfhi(w.y) * __expf(-b0.w));
                o_.z = cvtpk(bflo(w.z) * __expf(-b1.x), bfhi(w.z) * __expf(-b1.y)); o_.w = cvtpk(bflo(w.w) * __expf(-b1.z), bfhi(w.w) * __expf(-b1.w));
                kf[ks] = __builtin_bit_cast(bf16x8, o_); }
            if (sb == 0 && tb == 1) {
#pragma unroll
                for (int ks = 0; ks < 4; ++ks) { kw[ks] = *(const u32x4_t*)(PA + (size_t)(row0 + 32 + r32) * NPA + PA_K + h * 64 + 16 * ks + 8 * hi); const f32x4* bp = (const f32x4*)(BC + (size_t)(row0 + 32 + r32) * 256 + h * 64 + 16 * ks + 8 * hi); kb[ks][0] = bp[0]; kb[ks][1] = bp[1]; } }
#pragma unroll
            for (int ks = 0; ks < 4; ++ks) pT[sb] = __builtin_amdgcn_mfma_f32_32x32x16_bf16(kf[ks], qr[ks], pT[sb], 0, 0, 0);
            if (sb == tb) {
#pragma unroll
                for (int r = 0; r < 16; ++r) pT[sb][r] = (crow(r, hi) <= r32) ? pT[sb][r] : 0.f; } }
        bf16x8 pa[4]; pack_p(pa, pT[0], pT[1]);
        f32x16 o[4];
        const bf16* spb = SP + ((size_t)(b * 4 + h) * 128 + c) * 8192 + (size_t)r32 * 64 + 8 * hi;
        { bf16x8 sf[4][4];
#pragma unroll
          for (int eb = 0; eb < 4; ++eb)
#pragma unroll
            for (int ks = 0; ks < 4; ++ks) sf[eb][ks] = *(const bf16x8*)(spb + (size_t)eb * 32 * 64 + 16 * ks);
#pragma unroll
          for (int eb = 0; eb < 4; ++eb) { o[eb] = (f32x16){};
#pragma unroll
            for (int ks = 0; ks < 4; ++ks) o[eb] = __builtin_amdgcn_mfma_f32_32x32x16_bf16(sf[eb][ks], qr[ks], o[eb], 0, 0, 0); } }
        const bf16* rp = PA + (size_t)(row0 + t) * NPA + PA_R + h * 128;
        v4u rw4[4][2];
#pragma unroll
        for (int eb = 0; eb < 4; ++eb)
#pragma unroll
            for (int rp2 = 0; rp2 < 2; ++rp2) rw4[eb][rp2] = *(const v4u*)(rp + 32 * eb + 16 * rp2 + 8 * hi);
        asm volatile("s_waitcnt vmcnt(0)" ::: "memory"); __syncthreads();
        { s16x4 vl[2][4], vh[2][4]; vfrag_issue<2>(vl, vh, lds + GL_V + h * 16384, lane); pv_frag<2>(o, vl, vh, pa);
          s16x4 vl2[2][4], vh2[2][4]; vfrag_issue<2>(vl2, vh2, lds + GL_V + h * 16384 + 8192, lane); pv_frag<2>(o + 2, vl2, vh2, pa); }
        float ss = 0.f;
#pragma unroll
        for (int eb = 0; eb < 4; ++eb)
#pragma unroll
            for (int r = 0; r < 16; ++r) ss += o[eb][r] * o[eb][r];
        ss += __shfl_xor(ss, 32);
        const float rs = __builtin_amdgcn_rsqf(ss * (1.0f / 128.0f) + 1e-6f);
        bf16* op = CAT + (size_t)(row0 + t) * 1024 + h * 128;
        v2u rw[4][4];
#pragma unroll
        for (int eb = 0; eb < 4; ++eb)
#pragma unroll
            for (int rp2 = 0; rp2 < 2; ++rp2) { const v4u w4 = rw4[eb][rp2];
                const auto r0 = __builtin_amdgcn_permlane32_swap(w4.x, w4.z, false, false); const auto r1 = __builtin_amdgcn_permlane32_swap(w4.y, w4.w, false, false);
                rw[eb][2 * rp2].x = r0[0]; rw[eb][2 * rp2].y = r1[0]; rw[eb][2 * rp2 + 1].x = r0[1]; rw[eb][2 * rp2 + 1].y = r1[1]; }
        f32x4 gv[4][4];
#pragma unroll
        for (int eb = 0; eb < 4; ++eb)
#pragma unroll
            for (int rg = 0; rg < 4; ++rg) gv[eb][rg] = *(const f32x4*)(gh + 32 * eb + 8 * rg + 4 * hi);
#pragma unroll
        for (int eb = 0; eb < 4; ++eb)
#pragma unroll
            for (int rg = 0; rg < 4; rg += 2) { v2u wp[2];
#pragma unroll
                for (int k = 0; k < 2; ++k) { const v2u w_ = rw[eb][rg + k]; const f32x4 g_ = gv[eb][rg + k]; const int r_ = 4 * (rg + k);
                    const float r0 = bflo(w_.x), r1 = bfhi(w_.x), r2 = bflo(w_.y), r3 = bfhi(w_.y);
                    const float y0 = o[eb][r_] * rs * g_.x * (r0 * pg8::sigmoid_f(r0)), y1 = o[eb][r_ + 1] * rs * g_.y * (r1 * pg8::sigmoid_f(r1)), y2 = o[eb][r_ + 2] * rs * g_.z * (r2 * pg8::sigmoid_f(r2)), y3 = o[eb][r_ + 3] * rs * g_.w * (r3 * pg8::sigmoid_f(r3));
                    wp[k].x = cvtpk(y0, y1); wp[k].y = cvtpk(y2, y3); }
                st_pair16(op + 32 * eb + 8 * rg, hi, wp[0], wp[1]); }
        __syncthreads();
    }
}
__device__ __forceinline__ void ph_ffn_fix(Frame& F, int layer) {
    const float* __restrict__ bndA = WSP(float, WS_BND); const float* __restrict__ bndHA = WSP(float, WS_BND + BND_ONE); const float* __restrict__ bndHB = WSP(float, WS_BND + 2 * BND_ONE); bf16* __restrict__ H = WSP(bf16, WS_R1);
    const float* __restrict__ cw = in_ptr(I_CONVW) + (size_t)layer * 3 * FF; const float* __restrict__ cb = in_ptr(I_CONVB) + (size_t)layer * FF;
    const int gt = blockIdx.x * 512 + F.tid, NT = F.G * 512; constexpr int NE = 512 * 2 * FF;
#pragma unroll 1
    for (int i0 = gt; i0 < NE; i0 += 4 * NT) {
        float a0[4], pm1[4], pm2[4], h0[4], hb[4], w0[4], w1[4], w2[4], c0[4]; int fr_[4], G_[4], f_[4]; bool ok[4], first[4];
#pragma unroll
        for (int j = 0; j < 4; ++j) { const int idx = i0 + j * NT; ok[j] = idx < NE; const int id = ok[j] ? idx : 0; const int f = id % FF, gr = id / FF, G = gr >> 1, fr = gr & 1; f_[j] = f; G_[j] = G; fr_[j] = fr; first[j] = (G & 127) == 0;
            const int Gp = first[j] ? G : G - 1;
            a0[j] = bndHA[id]; hb[j] = bndHB[id]; pm1[j] = bndA[((size_t)Gp * 2 + 1) * FF + f]; pm2[j] = bndA[((size_t)Gp * 2 + 0) * FF + f]; h0[j] = bndHA[((size_t)G * 2) * FF + f];
            w0[j] = cw[f]; w1[j] = cw[FF + f]; w2[j] = cw[2 * FF + f]; c0[j] = cb[f]; }
#pragma unroll
        for (int j = 0; j < 4; ++j) { if (!ok[j]) continue; const float p1 = first[j] ? 0.f : pm1[j], p2 = first[j] ? 0.f : pm2[j];
            const float a1 = fr_[j] ? h0[j] : p1, a2 = fr_[j] ? p1 : p2;
            const float cv = w0[j] * a2 + w1[j] * a1 + w2[j] * a0[j] + c0[j];
            H[(size_t)(G_[j] * 64 + fr_[j]) * FF + f_[j]] = (bf16)f2bf(cv / (1.0f + __expf(-cv)) * hb[j]); }
    }
}
__device__ __forceinline__ void ph_cmp2(Frame& F) {
    const bf16* CH = WSP(bf16, WS_CH); bf16* KC = WSP(bf16, WS_KCMP); const bf16* W2 = WSP(bf16, WS_WC2);
    const int gw = blockIdx.x * NWAVES + F.wave, NGW = F.G * NWAVES, lane = F.lane, r32 = lane & 31, hi = lane >> 5;
#pragma unroll 1
    for (int u = gw; u < 512; u += NGW) { const int cb = u & 1, rb = (u >> 1) & 127, mlp = u >> 8;
        const bf16* ap = W2 + (size_t)(mlp * 64 + 32 * cb + r32) * 256 + 8 * hi; const bf16* bp = CH + ((size_t)mlp * 4096 + 32 * rb + r32) * 256 + 8 * hi;
        f32x16 acc = (f32x16){};
#pragma unroll
        for (int ks = 0; ks < 16; ++ks) acc = __builtin_amdgcn_mfma_f32_32x32x16_bf16(*(const bf16x8*)(ap + 16 * ks), *(const bf16x8*)(bp + 16 * ks), acc, 0, 0, 0);
        bf16* op = KC + ((size_t)mlp * 4096 + 32 * rb + r32) * 64 + 32 * cb;
#pragma unroll
        for (int rg = 0; rg < 4; rg += 2) { v2u w, w2; w.x = cvtpk(acc[4 * rg], acc[4 * rg + 1]); w.y = cvtpk(acc[4 * rg + 2], acc[4 * rg + 3]); w2.x = cvtpk(acc[4 * rg + 4], acc[4 * rg + 5]); w2.y = cvtpk(acc[4 * rg + 6], acc[4 * rg + 7]);
            st_pair16(op + 8 * rg, hi, w, w2); } }
}
__device__ __forceinline__ void ph_final(Frame& F, float* dst) {
    const float* __restrict__ SS = WSP(float, WS_SS); const float* gf = in_ptr(I_GFINAL);
    const int gw = blockIdx.x * NWAVES + F.wave, NGW = F.G * NWAVES, lane = F.lane;
    const bf16* __restrict__ XBp = WSP(bf16, WS_XB);
    f32x4 g[4];
#pragma unroll
    for (int j = 0; j < 4; ++j) g[j] = *((const f32x4*)gf + lane + 64 * j);
#pragma unroll 1
    for (int m0 = gw; m0 < M; m0 += 4 * NGW) {
        v2u xw[4][4]; f32x4 sv[4];
#pragma unroll
        for (int q = 0; q < 4; ++q) { const int m = (m0 + q * NGW) < M ? (m0 + q * NGW) : (M - 1); sv[q] = *(const f32x4*)(SS + (size_t)m * 16 + 4 * (lane & 3));
#pragma unroll
            for (int j = 0; j < 4; ++j) xw[q][j] = *((const GAS v2u*)(XBp + (size_t)m * D) + lane + 64 * j); }
#pragma unroll
        for (int q = 0; q < 4; ++q) { const int m = m0 + q * NGW; if (m >= M) break;
            float ssum = (sv[q].x + sv[q].y) + (sv[q].z + sv[q].w); ssum += __shfl_xor(ssum, 1); ssum += __shfl_xor(ssum, 2);
            const float rs = __builtin_amdgcn_rsqf(ssum * (1.0f / 1024.0f) + pg8::RMS_EPS);
#pragma unroll
            for (int j = 0; j < 4; ++j) { f32x4 o; o.x = bflo(xw[q][j].x) * rs * g[j].x; o.y = bfhi(xw[q][j].x) * rs * g[j].y; o.z = bflo(xw[q][j].y) * rs * g[j].z; o.w = bfhi(xw[q][j].y) * rs * g[j].w;
                ((GAS f32x4*)(dst + (size_t)m * D) + lane)[64 * j] = o; } }
    }
}

#ifndef MK_PHASE_LAUNCHES
#define MK_PHASE_LAUNCHES 0
#endif
constexpr int N_PHASES = 18;
#ifndef PH_MASK
#define PH_MASK 0x3ffff
#endif
#define PH_ON(k) (((PH_MASK) >> (k)) & 1)
struct Args { const float* in[26]; float* out; unsigned char* ws; int ph_lo, ph_hi; };
__global__ void __launch_bounds__(NWAVES * 64, 2) yoco_fwd(Args args) {
    extern __shared__ __attribute__((aligned(16))) unsigned char lds[];
    Frame F;
    F.lds = (LAS unsigned char*)lds;
    F.MISC = (volatile LAS unsigned*)(F.lds + MISC_OFF);
    F.tid = threadIdx.x; F.lane = F.tid & 63; F.wave = __builtin_amdgcn_readfirstlane(F.tid >> 6);
    F.G = gridDim.x;
    F.out = args.out; F.ws = args.ws; F.ctl = (gu32*)(args.ws + WS_CTL);
    for (int u = F.tid; u < (LDS_BYTES - LDSCTL_OFF) / 4; u += NWAVES * 64) ((LAS unsigned*)(F.lds + LDSCTL_OFF))[u] = 0u;
    __syncthreads();
    XcdBarrier bar; bar.bar = (unsigned*)(F.ctl + CW_BAR); bar.x = 0; bar.st = nullptr;
    if (!MK_PHASE_LAUNCHES) bar = xcd_barrier_post((unsigned*)(F.ctl + CW_BAR), F.MISC + 8);
    using pg8::Gemm; using pg8::StaticOrder;
    const int bx = (int)blockIdx.x;
#pragma unroll 1
    for (int p = args.ph_lo; p < args.ph_hi; ++p) {
        { int t_ = threadIdx.x; asm volatile("" : "+v"(t_)); F.tid = t_; F.lane = t_ & 63; F.wave = __builtin_amdgcn_readfirstlane(t_ >> 6); }
        { GAS unsigned char* w_ = (GAS unsigned char*)args.ws; int g_ = gridDim.x; asm volatile("" : "+s"(w_), "+s"(g_)); F.ws = (unsigned char*)w_; F.G = g_; }
        bf16* const XB = WSP(bf16, WS_XB); bf16* const CAT = WSP(bf16, WS_CAT); float* const SS = WSP(float, WS_SS); bf16* const R1 = WSP(bf16, WS_R1);
        switch (p) {
        case 0: if (PH_ON(0)) p0_prologue(F); break;
        case 1:
#pragma unroll 1
            for (int s = 0; s < 2 * PH_ON(1); ++s) {
                Gemm g = s ? Gemm{WSP(bf16, WS_MEMB), WSP(bf16, WS_WM), MROWS, 2048, D, D} : Gemm{XB, WSP(bf16, WS_WA), M, NPA, D, D};
                StaticOrder S; S.init(g.M, g.N, F.G, s ? (bx + 128) % F.G : bx);
                pg8::EpiScaleBf16 E = s ? pg8::EpiScaleBf16{WSP(bf16, WS_MKV), 2048, WSP(float, WS_SSM), 0, 0, 1.0f} : pg8::EpiScaleBf16{R1, NPA, SS, PA_MQ / 256, PA_MQ / 256 + 2, MEM_QSCALE};
                pg8::gemm_phase<pg8::EpiScaleBf16, StaticOrder, true, true>(F.lds, g, S, E);
            }
            if (PH_ON(1) && F.G == 256 && bx >= 160) tr_items(F, (LAS float*)(F.lds + F.wave * 16384), (bx - 160) * NWAVES + F.wave, 96 * NWAVES, TR_NP0, TR_NITEMS, F.lane);
            if (PH_ON(1) && bx == F.G - 1) bias1_reduce(F);
            break;
        case 2: if (PH_ON(2)) { ph_gla_local(F); ph_memattn_mfma(F, R1, NPA, PA_MQ, 0, bx, F.G); } break;
        case 3: if (PH_ON(3)) ph_gla_scan(F); break;
        case 4: if (PH_ON(4)) ph_gla_out(F); break;
        case 5: case 8: case 13: case 16: if (PH_ON(5)) {
            const bool ffn = (p == 8 || p == 16); const int layer = p > 8 ? 1 : 0;
            Gemm g = ffn ? Gemm{R1, WSP(bf16, WS_WD) + (size_t)layer * D * FF, M, D, FF, FF} : Gemm{CAT, WSP(bf16, layer ? WS_WOB : WS_WOA), M, D, D, D};
            StaticOrder S; S.init(M, D, F.G, bx);
            if (p == 16 && F.G == 256) {
                pg8::EpiFinal E{XB, SS, F.out, in_ptr(I_GFINAL), (unsigned*)(F.ctl + CW_PANEL)};
                pg8::gemm_phase<pg8::EpiFinal, StaticOrder, true, true>(F.lds, g, S, E);
                break; }
            pg8::EpiResid E{XB, SS};
            pg8::gemm_phase<pg8::EpiResid, StaticOrder, true, true>(F.lds, g, S, E);
            break; }
        case 6: case 14: if (PH_ON(6)) {
            const int layer = p == 14 ? 1 : 0;
            Gemm g{XB, WSP(bf16, WS_WU) + (size_t)layer * 2 * FF * D, M, 2 * FF, D, D}; StaticOrder S; S.init(M, 2 * FF, F.G, bx);
            pg8::EpiUp E{R1, SS, in_ptr(I_CONVW) + (size_t)layer * 3 * FF, in_ptr(I_CONVB) + (size_t)layer * FF, WSP(float, WS_BND), WSP(float, WS_BND + BND_ONE), WSP(float, WS_BND + 2 * BND_ONE)};
            pg8::gemm_phase<pg8::EpiUp, StaticOrder, true, true>(F.lds, g, S, E);
            break; }
        case 7: case 15: if (PH_ON(7)) ph_ffn_fix(F, p == 15 ? 1 : 0); break;
        case 9: if (PH_ON(9)) {
            Gemm g{XB, WSP(bf16, WS_WB), M, NG5, D, D}; StaticOrder S; S.init(M, NG5, F.G, bx); pg8::EpiProjB E{WSP(bf16, WS_KVC), R1, SS};
            pg8::gemm_phase<pg8::EpiProjB, StaticOrder, true, true>(F.lds, g, S, E);
            break; }
        case 10:
#pragma unroll 1
            for (int s = 0; s < 2 * PH_ON(10); ++s) {
                Gemm g{WSP(bf16, WS_KVC) + (size_t)s * KVSTRIDE, WSP(bf16, WS_WC1) + (size_t)s * 256 * 2048, 4096, 256, 2048, 1024};
                StaticOrder S; S.init(4096, 256, F.G, s ? (bx + 240) % F.G : bx);
                pg8::EpiGelu E{WSP(bf16, WS_CH) + (size_t)s * 4096 * 256, WSP(float, WS_BIAS1) + s * 256};
                pg8::gemm_phase<pg8::EpiGelu, StaticOrder, true, true>(F.lds, g, S, E);
            }
            __syncthreads();
            if (PH_ON(10)) { if (F.G > 64) { if (bx >= 32) ph_memattn_mfma(F, R1, NPB, PB_MQ, 1, bx - 32, F.G - 32); }
                             else ph_memattn_mfma(F, R1, NPB, PB_MQ, 1, bx, F.G); }
            break;
        case 11: if (PH_ON(11)) ph_cmp2(F); break;
        case 12: if (PH_ON(12)) ph_nsa_mfma(F); break;
        case 17: if (PH_ON(17) && F.G != 256) ph_final(F, F.out); break;
        default: break;
        }
        if (p + 1 < args.ph_hi && !(p == 16 && F.G == 256)) xcd_barrier(bar);
    }
}

extern "C" void kernel_launch(void* const* d_in, const int* in_sizes, int n_in, void* d_out, int out_size, void* d_ws, size_t ws_size, hipStream_t stream) {
    static int grid = 0;
    if (grid == 0) {
        if (n_in != 26 || in_sizes[0] != M * D || out_size != M * D || ws_size < WS_END) { fprintf(stderr, "kernel_launch: unexpected shapes (n_in %d, in0 %d, out %d, ws %zu); nothing launched\n", n_in, n_in > 0 ? in_sizes[0] : -1, out_size, ws_size); grid = -1; return; }
        int dev = 0, cus = 0, per_cu = 0;
        if (hipGetDevice(&dev) != hipSuccess || hipDeviceGetAttribute(&cus, hipDeviceAttributeMultiprocessorCount, dev) != hipSuccess) { grid = -1; return; }
        if (hipFuncSetAttribute((const void*)yoco_fwd, hipFuncAttributeMaxDynamicSharedMemorySize, LDS_BYTES) != hipSuccess) { fprintf(stderr, "kernel_launch: hipFuncSetAttribute failed\n"); grid = -1; return; }
        if (hipOccupancyMaxActiveBlocksPerMultiprocessor(&per_cu, (const void*)yoco_fwd, NWAVES * 64, LDS_BYTES) != hipSuccess || per_cu < 1) { fprintf(stderr, "kernel_launch: occupancy query reports %d blocks per CU\n", per_cu); (void)hipGetLastError(); grid = -1; return; }
        grid = cus;
        if (grid > 256) grid = 256;
    }
    if (grid < 0) return;
    (void)hipMemsetAsync((char*)d_ws + WS_CTL, 0, CTL_ZERO_BYTES, stream);
    Args a{};
    for (int i = 0; i < 26; ++i) a.in[i] = (const float*)d_in[i];
    a.out = (float*)d_out; a.ws = (unsigned char*)d_ws;
#if MK_PHASE_LAUNCHES
    for (int p = 0; p < N_PHASES; ++p) { a.ph_lo = p; a.ph_hi = p + 1; hipLaunchKernelGGL(yoco_fwd, dim3(grid), dim3(NWAVES * 64), LDS_BYTES, stream, a); }
#else
    a.ph_lo = 0; a.ph_hi = N_PHASES;
    hipLaunchKernelGGL(yoco_fwd, dim3(grid), dim3(NWAVES * 64), LDS_BYTES, stream, a);
#endif
    const hipError_t le = hipPeekAtLastError();
    if (le != hipSuccess) fprintf(stderr, "kernel_launch: launch failed: %s\n", hipGetErrorName(le));
}
```

```cpp
#include <hip/hip_runtime.h>
#include <cstdio>
#include <cstdint>
namespace pg8 {
#define PG8_LAS __attribute__((address_space(3)))
typedef unsigned short bf16_t;
typedef short bf16x8 __attribute__((ext_vector_type(8)));
typedef float f32x4 __attribute__((ext_vector_type(4)));
typedef unsigned u32x4 __attribute__((ext_vector_type(4)));
typedef unsigned u32x2 __attribute__((ext_vector_type(2)));
constexpr int BM = 256, BK = 64, HALF = 128, HTB = HALF * BK * 2  , STAGE_BYTES = 8 * HTB, NXCD = 8, WGM = 8;

__host__ __device__ __forceinline__ int lds_byte(int r, int c) { const int st = (r >> 4) * 2 + (c >> 5), rr = r & 15, cc = c & 31, ob = rr * 64 + cc * 2; return st * 1024 + (ob ^ (((ob >> 9) & 1) << 5)); }
__host__ __device__ __forceinline__ void stage_rc(int b, int& R, int& C) { const int st = b / 1024, sb = b % 1024, swz = sb ^ (((sb >> 9) & 1) << 5); R = (st >> 1) * 16 + swz / 64; C = (st & 1) * 32 + (swz % 64) / 2; }
__host__ __device__ __forceinline__ int perm32(int rho) { const int n = rho >> 4, i = rho & 15; return 8 * (i >> 2) + 4 * n + (i & 3); }

struct Unit { int pm, pn; };
struct Gemm { const bf16_t* A; const bf16_t* Bt; int M, N, K, lda; };

struct StaticOrder {
    int nM, nN, nwg, G, c;
    __host__ __device__ void init(int M, int N, int G_, int c_) { nM = M / BM; nN = N / BM; nwg = nM * nN; G = G_; c = c_; }
    __host__ __device__ bool next(int i, Unit& u) const {
        const long L = (long)i * G + c; if (L >= nwg) return false;
        int wgid = (int)L; { const int q = nwg / NXCD, r = nwg % NXCD, xcd = wgid % NXCD, off = wgid / NXCD; wgid = (xcd < r ? xcd * (q + 1) : r * (q + 1) + (xcd - r) * q) + off; }
        const int nig = WGM * nN, gid = wgid / nig, fm = gid * WGM, gsz = (nM - fm) < WGM ? (nM - fm) : WGM;
        u.pm = fm + ((wgid % nig) % gsz); u.pn = (wgid % nig) / gsz; return true;
    }
    __device__ __forceinline__ void a_ready(const Unit&) const {}
    __device__ __forceinline__ void done(const Unit&) const {}
};


typedef float f32x2c __attribute__((ext_vector_type(2))); typedef __bf16 bf16x2c __attribute__((ext_vector_type(2)));
__device__ __forceinline__ unsigned cvt_pk_bf16(float lo, float hi) { const f32x2c v = {lo, hi}; return __builtin_bit_cast(unsigned, __builtin_convertvector(v, bf16x2c)); }
constexpr float RMS_EPS = 1e-6f;
__device__ __forceinline__ float rstd_row(const float* SS, int row) {
    const f32x4* p = (const f32x4*)(SS + (size_t)row * 16); const f32x4 a = p[0], b = p[1], c = p[2], d = p[3];
    const float s = (((a.x + a.y) + (a.z + a.w)) + ((b.x + b.y) + (b.z + b.w))) + (((c.x + c.y) + (c.z + c.w)) + ((d.x + d.y) + (d.z + d.w)));
    return 1.0f / sqrtf(s * (1.0f / 1024.0f) + RMS_EPS);
}
__device__ __forceinline__ float sigmoid_f(float x) { return __builtin_amdgcn_rcpf(1.0f + __expf(-x)); }

__device__ __forceinline__ void rstd8(float (&rs)[2][4], const char* ssb0  , unsigned ls  , int lane) {
    f32x4 a[8];
#pragma unroll
    for (int i = 0; i < 8; ++i) a[i] = *(const f32x4*)(ssb0 + (size_t)((i >> 2) * HALF + (i & 3) * 16) * 64 + ls);
    float sv[8], tv[8];
#pragma unroll
    for (int i = 0; i < 8; ++i) sv[i] = (a[i].x + a[i].y) + (a[i].z + a[i].w);
    const int x16 = (lane ^ 16) * 4, x32 = (lane ^ 32) * 4;
#pragma unroll
    for (int i = 0; i < 8; ++i) tv[i] = __int_as_float(__builtin_amdgcn_ds_bpermute(x16, __float_as_int(sv[i])));
#pragma unroll
    for (int i = 0; i < 8; ++i) sv[i] += tv[i];
#pragma unroll
    for (int i = 0; i < 8; ++i) tv[i] = __int_as_float(__builtin_amdgcn_ds_bpermute(x32, __float_as_int(sv[i])));
#pragma unroll
    for (int i = 0; i < 8; ++i) rs[i >> 2][i & 3] = __builtin_amdgcn_rsqf((sv[i] + tv[i]) * (1.0f / 1024.0f) + RMS_EPS);
}
__device__ __forceinline__ u32x4 pack8(const f32x4 v0, const f32x4 v1) { u32x4 w; w.x = cvt_pk_bf16(v0[0], v0[1]); w.y = cvt_pk_bf16(v0[2], v0[3]); w.z = cvt_pk_bf16(v1[0], v1[1]); w.w = cvt_pk_bf16(v1[2], v1[3]); return w; }

struct EpiScaleBf16 {
    static constexpr bool PERM = true, AFTER_DRAIN = false;
    bf16_t* O; int ldc; const float* SS; int sc_from, sc_to; float sc;
    __device__ __forceinline__ void operator()(f32x4 (&acc)[2][2][4][2], const Unit& u, int wr, int wc, int fr, int fq) const {
        asm volatile("" : "+v"(fr), "+v"(fq));
        const unsigned lrow = wr * 64 + fr; const unsigned lo = lrow * (unsigned)ldc * 2u + (unsigned)(wc * 32 + 8 * fq) * 2u, ls = lrow * 64u + (unsigned)fq * 16u;
        float rs[2][4]; rstd8(rs, (const char*)SS + (size_t)(u.pm * BM) * 64, ls, fr + 16 * fq);
        const float xs = (u.pn >= sc_from && u.pn < sc_to) ? sc : 1.0f;
#pragma unroll
        for (int ai = 0; ai < 2; ++ai)
#pragma unroll
            for (int m = 0; m < 4; ++m) { const int urow = u.pm * BM + ai * HALF + m * 16; char* ob = (char*)O + ((size_t)urow * ldc + u.pn * BM) * 2; const float r_ = rs[ai][m] * xs;
#pragma unroll
                for (int bj = 0; bj < 2; ++bj) *(u32x4*)(ob + lo + bj * HALF * 2) = pack8(acc[ai][bj][m][0] * r_, acc[ai][bj][m][1] * r_); }
    }
};

struct EpiResid {
    static constexpr bool PERM = true, AFTER_DRAIN = false;
    bf16_t* xb; float* SS;
    __device__ __forceinline__ void operator()(f32x4 (&acc)[2][2][4][2], const Unit& u, int wr, int wc, int fr, int fq) const {
        asm volatile("" : "+v"(fr), "+v"(fq));
        const unsigned lrow = wr * 64 + fr; const unsigned lo = lrow * 2048u + (unsigned)(wc * 32 + 8 * fq) * 2u, ls = lrow * 64u + (unsigned)wc * 4u;
        char* const xb0 = (char*)xb + (size_t)(u.pm * BM) * 2048 + (size_t)u.pn * 512;
        u32x4 rw[2][4][2];
#pragma unroll
        for (int ai = 0; ai < 2; ++ai)
#pragma unroll
            for (int m = 0; m < 4; ++m)
#pragma unroll
                for (int bj = 0; bj < 2; ++bj) rw[ai][m][bj] = *(const u32x4*)(xb0 + (size_t)(ai * HALF + m * 16) * 2048 + lo + bj * 256);
#pragma unroll
        for (int ai = 0; ai < 2; ++ai)
#pragma unroll
            for (int m = 0; m < 4; ++m) { const int urow = u.pm * BM + ai * HALF + m * 16; float ssq = 0.f;
#pragma unroll
                for (int bj = 0; bj < 2; ++bj) { const u32x4 r = rw[ai][m][bj];
                    f32x4 o0 = acc[ai][bj][m][0], o1 = acc[ai][bj][m][1];
                    o0[0] += __uint_as_float(r.x << 16); o0[1] += __uint_as_float(r.x & 0xffff0000u); o0[2] += __uint_as_float(r.y << 16); o0[3] += __uint_as_float(r.y & 0xffff0000u);
                    o1[0] += __uint_as_float(r.z << 16); o1[1] += __uint_as_float(r.z & 0xffff0000u); o1[2] += __uint_as_float(r.w << 16); o1[3] += __uint_as_float(r.w & 0xffff0000u);
                    ssq += ((o0[0] * o0[0] + o0[1] * o0[1]) + (o0[2] * o0[2] + o0[3] * o0[3])) + ((o1[0] * o1[0] + o1[1] * o1[1]) + (o1[2] * o1[2] + o1[3] * o1[3]));
                    *(u32x4*)(xb0 + (size_t)(ai * HALF + m * 16) * 2048 + lo + bj * 256) = pack8(o0, o1); }
                ssq += __shfl_xor(ssq, 16); ssq += __shfl_xor(ssq, 32);
                if (fq == 0) *(float*)((char*)SS + (size_t)urow * 64 + u.pn * 16 + ls) = ssq; }
    }
};

struct EpiFinal {
    static constexpr bool PERM = true, AFTER_DRAIN = false;
    const bf16_t* xb; float* SS; float* out; const float* gf; unsigned* cnt;
    __device__ __forceinline__ void operator()(f32x4 (&acc)[2][2][4][2], const Unit& u, int wr, int wc, int fr, int fq) const {
        asm volatile("" : "+v"(fr), "+v"(fq));
        const unsigned lrow = wr * 64 + fr; const unsigned lo = lrow * 2048u + (unsigned)(wc * 32 + 8 * fq) * 2u, ls = lrow * 64u + (unsigned)wc * 4u;
        const char* const xb0 = (const char*)xb + (size_t)(u.pm * BM) * 2048 + (size_t)u.pn * 512;
        u32x4 rw[2][4][2];
#pragma unroll
        for (int ai = 0; ai < 2; ++ai)
#pragma unroll
            for (int m = 0; m < 4; ++m)
#pragma unroll
                for (int bj = 0; bj < 2; ++bj) rw[ai][m][bj] = *(const u32x4*)(xb0 + (size_t)(ai * HALF + m * 16) * 2048 + lo + bj * 256);
#pragma unroll
        for (int ai = 0; ai < 2; ++ai)
#pragma unroll
            for (int m = 0; m < 4; ++m) { const int urow = u.pm * BM + ai * HALF + m * 16; float ssq = 0.f;
#pragma unroll
                for (int bj = 0; bj < 2; ++bj) { const u32x4 r = rw[ai][m][bj];
                    f32x4 o0 = acc[ai][bj][m][0], o1 = acc[ai][bj][m][1];
                    o0[0] += __uint_as_float(r.x << 16); o0[1] += __uint_as_float(r.x & 0xffff0000u); o0[2] += __uint_as_float(r.y << 16); o0[3] += __uint_as_float(r.y & 0xffff0000u);
                    o1[0] += __uint_as_float(r.z << 16); o1[1] += __uint_as_float(r.z & 0xffff0000u); o1[2] += __uint_as_float(r.w << 16); o1[3] += __uint_as_float(r.w & 0xffff0000u);
                    ssq += ((o0[0] * o0[0] + o0[1] * o0[1]) + (o0[2] * o0[2] + o0[3] * o0[3])) + ((o1[0] * o1[0] + o1[1] * o1[1]) + (o1[2] * o1[2] + o1[3] * o1[3]));
                    acc[ai][bj][m][0] = o0; acc[ai][bj][m][1] = o1; }
                ssq += __shfl_xor(ssq, 16); ssq += __shfl_xor(ssq, 32);
                if (fq == 0) __hip_atomic_store((float*)((char*)SS + (size_t)urow * 64 + u.pn * 16 + ls), ssq, __ATOMIC_RELAXED, __HIP_MEMORY_SCOPE_AGENT); }
        asm volatile("s_waitcnt vmcnt(0)" ::: "memory");
        __builtin_amdgcn_s_barrier();
        if ((fr | fq | wr | wc) == 0) { unsigned* c = cnt + u.pm * 16; __hip_atomic_fetch_add(c, 1u, __ATOMIC_RELAXED, __HIP_MEMORY_SCOPE_AGENT);
            for (int spin = 0; spin < (1 << 22) && __hip_atomic_load(c, __ATOMIC_RELAXED, __HIP_MEMORY_SCOPE_AGENT) < 4u; ++spin) __builtin_amdgcn_s_sleep(1); }
        __builtin_amdgcn_s_barrier();
        asm volatile("" ::: "memory");
        const unsigned lq = lrow * 64u + (unsigned)fq * 16u;
        const char* const ssb0 = (const char*)SS + (size_t)(u.pm * BM) * 64;
        unsigned long long pa[8][2];
#pragma unroll
        for (int i = 0; i < 8; ++i) { const unsigned long long* p = (const unsigned long long*)(ssb0 + (size_t)((i >> 2) * HALF + (i & 3) * 16) * 64 + lq);
            pa[i][0] = __hip_atomic_load(p, __ATOMIC_RELAXED, __HIP_MEMORY_SCOPE_AGENT); pa[i][1] = __hip_atomic_load(p + 1, __ATOMIC_RELAXED, __HIP_MEMORY_SCOPE_AGENT); }
        f32x4 gv[2][2];
#pragma unroll
        for (int bj = 0; bj < 2; ++bj) { const char* gp = (const char*)gf + (size_t)u.pn * 1024 + bj * 512 + (unsigned)(wc * 32 + 8 * fq) * 4u; gv[bj][0] = *(const f32x4*)gp; gv[bj][1] = *(const f32x4*)(gp + 16); }
        float sv[8], tv[8];
#pragma unroll
        for (int i = 0; i < 8; ++i) sv[i] = (__uint_as_float((unsigned)pa[i][0]) + __uint_as_float((unsigned)(pa[i][0] >> 32))) + (__uint_as_float((unsigned)pa[i][1]) + __uint_as_float((unsigned)(pa[i][1] >> 32)));
        const int lane = fr + 16 * fq, x16 = (lane ^ 16) * 4, x32 = (lane ^ 32) * 4;
#pragma unroll
        for (int i = 0; i < 8; ++i) tv[i] = __int_as_float(__builtin_amdgcn_ds_bpermute(x16, __float_as_int(sv[i])));
#pragma unroll
        for (int i = 0; i < 8; ++i) sv[i] += tv[i];
#pragma unroll
        for (int i = 0; i < 8; ++i) tv[i] = __int_as_float(__builtin_amdgcn_ds_bpermute(x32, __float_as_int(sv[i])));
        char* const ob0 = (char*)out + (size_t)(u.pm * BM) * 4096 + (size_t)u.pn * 1024;
        const unsigned loo = lrow * 4096u + (unsigned)(wc * 32 + 8 * fq) * 4u;
#pragma unroll
        for (int ai = 0; ai < 2; ++ai)
#pragma unroll
            for (int m = 0; m < 4; ++m) { const float rs = __builtin_amdgcn_rsqf((sv[ai * 4 + m] + tv[ai * 4 + m]) * (1.0f / 1024.0f) + RMS_EPS);
#pragma unroll
                for (int bj = 0; bj < 2; ++bj) { char* op = ob0 + (size_t)(ai * HALF + m * 16) * 4096 + loo + bj * 512;
                    *(f32x4*)op = acc[ai][bj][m][0] * rs * gv[bj][0]; *(f32x4*)(op + 16) = acc[ai][bj][m][1] * rs * gv[bj][1]; } }
    }
};

struct EpiUp {
    static constexpr bool PERM = true, AFTER_DRAIN = false;
    bf16_t* H; const float* SS; const float* cw; const float* cb; float* bndA; float* bndHA; float* bndHB;
    __device__ __forceinline__ static f32x4 ror1(const f32x4 v) { f32x4 r;
#pragma unroll
        for (int e = 0; e < 4; ++e) r[e] = __int_as_float(__builtin_amdgcn_update_dpp(0, __float_as_int(v[e]), 0x121, 0xf, 0xf, false)); return r; }
    __device__ __forceinline__ static f32x4 ror2(const f32x4 v) { f32x4 r;
#pragma unroll
        for (int e = 0; e < 4; ++e) r[e] = __int_as_float(__builtin_amdgcn_update_dpp(0, __float_as_int(v[e]), 0x122, 0xf, 0xf, false)); return r; }
    __device__ __forceinline__ void operator()(f32x4 (&acc)[2][2][4][2], const Unit& u, int wr, int wc, int fr, int fq) const {
        asm volatile("" : "+v"(fr), "+v"(fq));
        constexpr int FF = 2816;
        const unsigned lch = (unsigned)(wc * 32 + 8 * fq);
        const unsigned lrow = wr * 64 + fr, ls = lrow * 64u + (unsigned)fq * 16u, lh = lrow * (unsigned)(FF * 2) + lch * 2u;
        const unsigned lb = (unsigned)(fr & 1) * (unsigned)(FF * 4) + lch * 4u;
        const char* cwb = (const char*)cw + (size_t)u.pn * 512; const char* cbb = (const char*)cb + (size_t)u.pn * 512;
        const bool f1 = fr >= 1, f2 = fr >= 2;
        float rsa[2][4]; f32x4 cwv[2][4];
        rstd8(rsa, (const char*)SS + (size_t)(u.pm * BM) * 64, ls, fr + 16 * fq);
#pragma unroll
        for (int n = 0; n < 2; ++n) { cwv[n][0] = *(const f32x4*)(cwb + lch * 4u + n * 16); cwv[n][1] = *(const f32x4*)(cwb + lch * 4u + FF * 4 + n * 16); cwv[n][2] = *(const f32x4*)(cwb + lch * 4u + 2 * FF * 4 + n * 16); cwv[n][3] = *(const f32x4*)(cbb + lch * 4u + n * 16); }
#pragma unroll
        for (int ai = 0; ai < 2; ++ai) {
            const int urow = u.pm * BM + ai * HALF; const int G = (urow >> 6) + wr;
            float rs[4];
#pragma unroll
            for (int m = 0; m < 4; ++m) rs[m] = rsa[ai][m];
            const size_t ub = ((size_t)G * 2 * FF + (size_t)u.pn * 128) * 4;
            char* const pA = (char*)bndA + ub; char* const pHA = (char*)bndHA + ub; char* const pHB = (char*)bndHB + ub;
            if (fr >= 14) { *(f32x4*)(pA + lb) = acc[ai][0][3][0] * rs[3]; *(f32x4*)(pA + lb + 16) = acc[ai][0][3][1] * rs[3]; }
            if (fr < 2) { *(f32x4*)(pHA + lb) = acc[ai][0][0][0] * rs[0]; *(f32x4*)(pHA + lb + 16) = acc[ai][0][0][1] * rs[0]; *(f32x4*)(pHB + lb) = acc[ai][1][0][0] * rs[0]; *(f32x4*)(pHB + lb + 16) = acc[ai][1][0][1] * rs[0]; }
#pragma unroll
            for (int n = 0; n < 2; ++n) {
                const f32x4 w0 = cwv[n][0], w1 = cwv[n][1], w2 = cwv[n][2], cbv = cwv[n][3];
                f32x4 r1p = (f32x4){0.f, 0.f, 0.f, 0.f}, r2p = r1p;
#pragma unroll
                for (int m = 0; m < 4; ++m) {
                    const f32x4 am = acc[ai][0][m][n] * rs[m], bm = acc[ai][1][m][n] * rs[m];
                    const f32x4 r1 = ror1(am), r2 = ror2(am); f32x4 p1, p2;
#pragma unroll
                    for (int e = 0; e < 4; ++e) { p1[e] = f1 ? r1[e] : r1p[e]; p2[e] = f2 ? r2[e] : r2p[e]; }
                    const f32x4 cv = w0 * p2 + w1 * p1 + w2 * am + cbv; f32x4 hv;
#pragma unroll
                    for (int e = 0; e < 4; ++e) hv[e] = cv[e] * sigmoid_f(cv[e]) * bm[e];
                    acc[ai][0][m][n] = hv; r1p = r1; r2p = r2; }
                asm volatile("" : "+v"(acc[ai][0][0][n]), "+v"(acc[ai][0][1][n]), "+v"(acc[ai][0][2][n]), "+v"(acc[ai][0][3][n]) :: "memory");
            }
            char* const hb = (char*)H + ((size_t)urow * FF + (size_t)u.pn * 128) * 2;
#pragma unroll
            for (int m = 0; m < 4; ++m) { if (m == 0 && fr < 2) continue;
                *(u32x4*)(hb + lh + m * 16 * FF * 2) = pack8(acc[ai][0][m][0], acc[ai][0][m][1]); }
            asm volatile("" ::: "memory");
        }
    }
};

struct EpiProjB {
    static constexpr bool PERM = true, AFTER_DRAIN = false;
    bf16_t* kvc; bf16_t* PB; const float* SS;
    __device__ __forceinline__ void operator()(f32x4 (&acc)[2][2][4][2], const Unit& u, int wr, int wc, int fr, int fq) const {
        asm volatile("" : "+v"(fr), "+v"(fq));
        constexpr size_t KVSTRIDE = (size_t)8 * 8192 * 64;
        const unsigned lrow = wr * 64 + fr, ls = lrow * 64u + (unsigned)fq * 16u;
        const unsigned lkv = lrow * 128u + (unsigned)((wc & 1) * 32 + 8 * fq) * 2u, lpb = lrow * 2560u + (unsigned)(wc * 32 + 8 * fq) * 2u;
        const int g = wc >> 1, b = u.pm >> 5;
        float rsa[2][4]; rstd8(rsa, (const char*)SS + (size_t)(u.pm * BM) * 64, ls, fr + 16 * fq);
        const float xs = (u.pn == 3 || u.pn == 4) ? 0.125f * 1.4426950408889634f : ((u.pn == 5 || u.pn == 6) ? 0.08838834764831845f * 1.4426950408889634f : 1.0f);
#pragma unroll
        for (int ai = 0; ai < 2; ++ai)
#pragma unroll
            for (int m = 0; m < 4; ++m) { const int urow = u.pm * BM + ai * HALF + m * 16; const float rs = rsa[ai][m] * xs;
#pragma unroll
                for (int bj = 0; bj < 2; ++bj) { const u32x4 w = pack8(acc[ai][bj][m][0] * rs, acc[ai][bj][m][1] * rs);
                    if (u.pn < 3) *(u32x4*)((char*)kvc + ((size_t)(u.pn * 2 + bj) * KVSTRIDE + ((size_t)urow + (size_t)(b + g) * 8192) * 64) * 2 + lkv) = w;
                    else *(u32x4*)((char*)PB + ((size_t)urow * 1280 + (size_t)(u.pn - 3) * 256 + bj * HALF) * 2 + lpb) = w; } }
    }
};

struct EpiGelu {
    static constexpr bool PERM = true, AFTER_DRAIN = false;
    bf16_t* O; const float* bias;
    __device__ __forceinline__ static float gelu_t(float x) { const float u2 = 1.5957691216f * (x + 0.044715f * x * x * x); return x * sigmoid_f(u2); }
    __device__ __forceinline__ void operator()(f32x4 (&acc)[2][2][4][2], const Unit& u, int wr, int wc, int fr, int fq) const {
        asm volatile("" : "+v"(fr), "+v"(fq));
        const unsigned lrow = wr * 64 + fr, lc = (unsigned)(wc * 32 + 8 * fq), lo = lrow * 512u + lc * 2u;
        f32x4 bv[2][2];
#pragma unroll
        for (int bj = 0; bj < 2; ++bj) { bv[bj][0] = *(const f32x4*)((const char*)bias + lc * 4u + bj * 512); bv[bj][1] = *(const f32x4*)((const char*)bias + lc * 4u + bj * 512 + 16); }
#pragma unroll
        for (int ai = 0; ai < 2; ++ai)
#pragma unroll
            for (int m = 0; m < 4; ++m) { char* ob = (char*)O + (size_t)(u.pm * BM + ai * HALF + m * 16) * 512;
#pragma unroll
                for (int bj = 0; bj < 2; ++bj) { f32x4 v0 = acc[ai][bj][m][0] + bv[bj][0], v1 = acc[ai][bj][m][1] + bv[bj][1];
#pragma unroll
                    for (int e = 0; e < 4; ++e) { v0[e] = gelu_t(v0[e]); v1[e] = gelu_t(v1[e]); }
                    *(u32x4*)(ob + lo + bj * HALF * 2) = pack8(v0, v1); } }
    }
};

template <class Epi, class Sched, bool ALIGN_EPI = false, bool SP2 = false>
__device__ __forceinline__ void gemm_phase(PG8_LAS unsigned char* lds, const Gemm g, const Sched& S, const Epi& E) {
    int tid_ = threadIdx.x; asm volatile("" : "+v"(tid_));
    const int tid = tid_, wid = __builtin_amdgcn_readfirstlane(tid >> 6), lane = tid & 63, wr = wid >> 2, wc = wid & 3, fr = lane & 15, fq = lane >> 4;
    const int K = g.K, nt = K / BK;
    unsigned voffA[2], voffB[2];
#pragma unroll
    for (int i = 0; i < 2; ++i) { int R, C; stage_rc(tid * 16 + i * 8192, R, C); const int Rb = Epi::PERM ? ((R & ~31) + perm32(R & 31)) : R;
        voffA[i] = (unsigned)(R * g.lda + C) * 2u; voffB[i] = (unsigned)(Rb * K + C) * 2u; }
    const size_t kstep = (size_t)(BK * 2);
    const size_t hsA = (size_t)HALF * g.lda * 2, hsB = (size_t)HALF * K * 2;
    const size_t tsA = 2 * hsA, tsB = 2 * hsB;
    const unsigned ldsw = (unsigned)wid * 1024u;
    const int aoff = lds_byte(wr * 64 + fr, fq * 8), boff = lds_byte(wc * 32 + fr, fq * 8);
#define PG8_SA(b, h) (((b) * 2 + (h)) * HTB)
#define PG8_SB(b, h) ((4 + (b) * 2 + (h)) * HTB)
#define PG8_STAGE(bufoff, gbase, voff) do { _Pragma("unroll") for (int _i = 0; _i < 2; ++_i) \
        __builtin_amdgcn_global_load_lds((const unsigned*)((const char*)(gbase) + (voff)[_i]), (PG8_LAS unsigned*)(lds + (bufoff) + ldsw + _i * 8192), 16, 0, 0); } while (0)
#define PG8_LDA(dst, b, h) do { _Pragma("unroll") for (int m = 0; m < 4; ++m) _Pragma("unroll") for (int k = 0; k < 2; ++k) dst[m][k] = *(const PG8_LAS bf16x8*)(lds + PG8_SA(b, h) + aoff + m * 2048 + k * 1024); } while (0)
#define PG8_LDB(dst, b, h) do { _Pragma("unroll") for (int n = 0; n < 2; ++n) _Pragma("unroll") for (int k = 0; k < 2; ++k) dst[n][k] = *(const PG8_LAS bf16x8*)(lds + PG8_SB(b, h) + boff + n * 2048 + k * 1024); } while (0)
#define PG8_MMA(ai, bj, At, Bt) do { __builtin_amdgcn_s_setprio(1); _Pragma("unroll") for (int m = 0; m < 4; ++m) _Pragma("unroll") for (int n = 0; n < 2; ++n) _Pragma("unroll") for (int k = 0; k < 2; ++k) \
        acc[ai][bj][m][n] = __builtin_amdgcn_mfma_f32_16x16x32_bf16(Bt[n][k], At[m][k], acc[ai][bj][m][n], 0, 0, 0); __builtin_amdgcn_s_setprio(0); } while (0)
#define PG8_WAIT_V(n) asm volatile("s_waitcnt vmcnt(" #n ")" ::: "memory")
#define PG8_WAIT_L(n) asm volatile("s_waitcnt lgkmcnt(" #n ")" ::: "memory")
#define PG8_BAR __builtin_amdgcn_s_barrier()
#define PG8_SCHED __builtin_amdgcn_sched_barrier(0)
    Unit cur, nxt; int ui = 0;
    if (!S.next(0, cur)) return;
    f32x4 acc[2][2][4][2];
#pragma unroll
    for (int a = 0; a < 2; ++a)
#pragma unroll
        for (int b = 0; b < 2; ++b)
#pragma unroll
            for (int m = 0; m < 4; ++m)
#pragma unroll
                for (int n = 0; n < 2; ++n) acc[a][b][m][n] = (f32x4){0.f, 0.f, 0.f, 0.f};
    bf16x8 At[4][2], B0[2][2], B1[2][2];
    const char* cA = (const char*)g.A + (size_t)cur.pm * tsA; const char* cB = (const char*)g.Bt + (size_t)cur.pn * tsB;
    S.a_ready(cur);
    if constexpr (SP2) {
        PG8_STAGE(PG8_SB(0, 0), cB, voffB); PG8_STAGE(PG8_SB(0, 1), cB + hsB, voffB); PG8_STAGE(PG8_SA(0, 0), cA, voffA); PG8_STAGE(PG8_SA(0, 1), cA + hsA, voffA);
        if (wr == 1) PG8_BAR;
        PG8_WAIT_V(2); PG8_BAR;
        PG8_STAGE(PG8_SB(1, 0), cB + kstep, voffB); PG8_STAGE(PG8_SA(1, 0), cA + kstep, voffA); PG8_STAGE(PG8_SB(1, 1), cB + hsB + kstep, voffB);
        PG8_WAIT_V(6); PG8_BAR;
    } else {
        PG8_STAGE(PG8_SB(0, 0), cB, voffB); PG8_STAGE(PG8_SA(0, 0), cA, voffA); PG8_STAGE(PG8_SB(0, 1), cB + hsB, voffB); PG8_STAGE(PG8_SA(0, 1), cA + hsA, voffA);
        if (wr == 1) PG8_BAR;
        PG8_WAIT_V(4); PG8_BAR;
        PG8_STAGE(PG8_SB(1, 0), cB + kstep, voffB); PG8_STAGE(PG8_SA(1, 0), cA + kstep, voffA); PG8_STAGE(PG8_SB(1, 1), cB + hsB + kstep, voffB);
        PG8_WAIT_V(6); PG8_BAR;
    }
    for (;;) {
        const bool has_next = S.next(ui + 1, nxt);
        const char* nA = has_next ? (const char*)g.A + (size_t)nxt.pm * tsA : cA; const char* nB = has_next ? (const char*)g.Bt + (size_t)nxt.pn * tsB : cB;
        for (int t = 0; t < nt; t += 2) {
            const bool last = (t == nt - 2);
            const char* a1 = cA + (size_t)(t + 1) * kstep;
            const char* a2 = last ? nA : cA + (size_t)(t + 2) * kstep; const char* b2 = last ? nB : cB + (size_t)(t + 2) * kstep;
            const char* a3 = a2 + kstep; const char* b3 = b2 + kstep;
            if (last && has_next) S.a_ready(nxt);
            if constexpr (SP2) {
            PG8_LDB(B0, 0, 0); PG8_LDB(B1, 0, 1); PG8_SCHED; PG8_LDA(At, 0, 0); PG8_STAGE(PG8_SA(1, 1), a1 + hsA, voffA);
            PG8_WAIT_V(8); PG8_WAIT_L(0); PG8_BAR; PG8_MMA(0, 0, At, B0); PG8_MMA(0, 1, At, B1); PG8_BAR; PG8_SCHED;
            PG8_LDA(At, 0, 1); PG8_STAGE(PG8_SB(0, 0), b2, voffB); PG8_STAGE(PG8_SB(0, 1), b2 + hsB, voffB); PG8_STAGE(PG8_SA(0, 0), a2, voffA);
            PG8_WAIT_V(8); PG8_WAIT_L(0); PG8_BAR; PG8_MMA(1, 0, At, B0); PG8_MMA(1, 1, At, B1); PG8_BAR; PG8_SCHED;
            PG8_LDB(B0, 1, 0); PG8_LDB(B1, 1, 1); PG8_SCHED; PG8_LDA(At, 1, 0); PG8_STAGE(PG8_SA(0, 1), a2 + hsA, voffA);
            PG8_WAIT_V(8); PG8_WAIT_L(0); PG8_BAR; PG8_MMA(0, 0, At, B0); PG8_MMA(0, 1, At, B1); PG8_BAR; PG8_SCHED;
            PG8_LDA(At, 1, 1); PG8_STAGE(PG8_SB(1, 0), b3, voffB); PG8_STAGE(PG8_SB(1, 1), b3 + hsB, voffB); PG8_STAGE(PG8_SA(1, 0), a3, voffA);
            PG8_WAIT_V(8); PG8_WAIT_L(0); PG8_BAR; PG8_MMA(1, 0, At, B0); PG8_MMA(1, 1, At, B1); PG8_BAR; PG8_SCHED;
            } else {
            PG8_LDB(B0, 0, 0); PG8_SCHED; PG8_LDA(At, 0, 0); PG8_STAGE(PG8_SA(1, 1), a1 + hsA, voffA);
            PG8_WAIT_L(8); PG8_BAR; PG8_WAIT_L(0); PG8_MMA(0, 0, At, B0); PG8_BAR; PG8_SCHED;
            PG8_LDB(B1, 0, 1); PG8_STAGE(PG8_SB(0, 0), b2, voffB);
            PG8_BAR; PG8_WAIT_L(0); PG8_MMA(0, 1, At, B1); PG8_BAR;
            PG8_LDA(At, 0, 1); PG8_STAGE(PG8_SA(0, 0), a2, voffA);
            PG8_BAR; PG8_WAIT_L(0); PG8_MMA(1, 0, At, B0); PG8_BAR; PG8_SCHED;
            PG8_STAGE(PG8_SB(0, 1), b2 + hsB, voffB);
            PG8_WAIT_V(6); PG8_BAR; PG8_MMA(1, 1, At, B1); PG8_BAR;
            PG8_LDB(B0, 1, 0); PG8_SCHED; PG8_LDA(At, 1, 0); PG8_STAGE(PG8_SA(0, 1), a2 + hsA, voffA);
            PG8_WAIT_L(8); PG8_BAR; PG8_WAIT_L(0); PG8_MMA(0, 0, At, B0); PG8_BAR; PG8_SCHED;
            PG8_LDB(B1, 1, 1); PG8_STAGE(PG8_SB(1, 0), b3, voffB);
            PG8_BAR; PG8_WAIT_L(0); PG8_MMA(0, 1, At, B1); PG8_BAR;
            PG8_LDA(At, 1, 1); PG8_STAGE(PG8_SA(1, 0), a3, voffA);
            PG8_BAR; PG8_WAIT_L(0); PG8_MMA(1, 0, At, B0); PG8_BAR; PG8_SCHED;
            PG8_STAGE(PG8_SB(1, 1), b3 + hsB, voffB);
            PG8_WAIT_V(6); PG8_BAR; PG8_MMA(1, 1, At, B1); PG8_BAR;
            }
        }
        if constexpr (ALIGN_EPI) { if (wr == 0) PG8_BAR; }
        if constexpr (!Epi::AFTER_DRAIN) { E(acc, cur, wr, wc, fr, fq); S.done(cur); }
        if (!has_next) break;
#pragma unroll
        for (int a = 0; a < 2; ++a)
#pragma unroll
            for (int b = 0; b < 2; ++b)
#pragma unroll
                for (int m = 0; m < 4; ++m)
#pragma unroll
                    for (int n = 0; n < 2; ++n) acc[a][b][m][n] = (f32x4){0.f, 0.f, 0.f, 0.f};
        cur = nxt; cA = nA; cB = nB; ++ui;
        if constexpr (ALIGN_EPI) { if (wr == 1) PG8_BAR; }
    }
    PG8_WAIT_V(0);
    if constexpr (!ALIGN_EPI) { if (wr == 0) PG8_BAR; }
    PG8_BAR;
    if constexpr (Epi::AFTER_DRAIN) { E.fused(acc, cur, wr, wc, fr, fq, lds, wid, lane); S.done(cur); }
#undef PG8_SA
#undef PG8_SB
#undef PG8_STAGE
#undef PG8_LDA
#undef PG8_LDB
#undef PG8_MMA
#undef PG8_WAIT_V
#undef PG8_WAIT_L
#undef PG8_BAR
#undef PG8_SCHED
}
}

#define LAS __attribute__((address_space(3)))
#define XB_TMO      128
#define XB_XCNT(j)  (256  + 64 * (j))
#define XB_XSUB(j)  (1280 + 64 * (j))
#define XB_XGEN(j)  (2304 + 64 * (j))
#define XB_TOP      3328
#define XB_TOPGEN   3392
#define XCD_BAR_WORDS 3456
#define XB_SPIN_CAP (1u << 18)

__device__ __forceinline__ unsigned xb_ld(unsigned* p)              { return __hip_atomic_load(p, __ATOMIC_RELAXED, __HIP_MEMORY_SCOPE_AGENT); }
__device__ __forceinline__ unsigned xb_add(unsigned* p, unsigned v) { return __hip_atomic_fetch_add(p, v, __ATOMIC_RELAXED, __HIP_MEMORY_SCOPE_AGENT); }
__device__ __forceinline__ unsigned xb_xcc_id() { return (unsigned)__builtin_amdgcn_s_getreg((3 << 11) | 20) & 0xFu; }
#define XB_SPIN(cond, bar) do { unsigned _sp = 0; while (cond) { __builtin_amdgcn_s_sleep(1); \
    if ((++_sp & 255u) == 0u) { if (xb_ld(&(bar)[XB_TMO])) break; if (_sp > XB_SPIN_CAP) { atomicAdd(&(bar)[XB_TMO], 1u); break; } } } } while (0)

struct XcdBarrier {
    unsigned* bar; unsigned x;
    volatile LAS unsigned* st;
};

__device__ __forceinline__ XcdBarrier xcd_barrier_post(unsigned* bar, volatile LAS unsigned* st) {
    XcdBarrier b; b.bar = bar; b.x = xb_xcc_id(); b.st = st;
    if (threadIdx.x == 0) (void)xb_add(&bar[XB_XCNT(b.x)], 1u);
    return b;
}
__device__ __forceinline__ void xcd_barrier_complete(unsigned* bar, unsigned x, unsigned& nloc, unsigned& nx) {
    const unsigned G = gridDim.x * gridDim.y * gridDim.z;
    unsigned sum, cnt, mine, sp = 0u;
    for (;;) {
        sum = 0u; cnt = 0u; mine = 0u;
#pragma unroll
        for (unsigned j = 0; j < 16; ++j) { const unsigned c = xb_ld(&bar[XB_XCNT(j)]); sum += c; cnt += (c > 0u) ? 1u : 0u; mine = (j == x) ? c : mine; }
        if (sum == G) break;
        __builtin_amdgcn_s_sleep(1);
        if ((++sp & 255u) == 0u) { if (xb_ld(&bar[XB_TMO])) break; if (sp > XB_SPIN_CAP) { atomicAdd(&bar[XB_TMO], 1u); break; } }
    }
    nloc = mine > 0u ? mine : 1u; nx = cnt > 0u ? cnt : 1u;
}

__device__ __forceinline__ void xcd_barrier(const XcdBarrier& b) {
    asm volatile("s_waitcnt vmcnt(0)" ::: "memory");
    __syncthreads();
    if (threadIdx.x == 0) {
        unsigned* bar = b.bar;
        __builtin_amdgcn_s_waitcnt(0);
        unsigned nloc = b.st[0], nx = b.st[1];
        if (nloc == 0u) { xcd_barrier_complete(bar, b.x, nloc, nx); b.st[0] = nloc; b.st[1] = nx; }
        const unsigned old = xb_add(&bar[XB_XSUB(b.x)], 1u);
        const unsigned gen = old / nloc;
        if (old + 1u == (gen + 1u) * nloc) {
            __builtin_amdgcn_fence(__ATOMIC_RELEASE, "agent");
            asm volatile("s_waitcnt vmcnt(0)" ::: "memory");
            const unsigned og = xb_add(&bar[XB_TOP], 1u);
            const unsigned tg = og / nx;
            if (og + 1u == (tg + 1u) * nx) xb_add(&bar[XB_TOPGEN], 1u);
            else XB_SPIN(xb_ld(&bar[XB_TOPGEN]) == tg, bar);
            __builtin_amdgcn_fence(__ATOMIC_ACQUIRE, "agent");
            xb_add(&bar[XB_XGEN(b.x)], 1u);
            asm volatile("s_waitcnt vmcnt(0)" ::: "memory");
        } else {
            XB_SPIN(xb_ld(&bar[XB_XGEN(b.x)]) == gen, bar);
            __builtin_amdgcn_fence(__ATOMIC_ACQUIRE, "agent");
            asm volatile("s_waitcnt vmcnt(0)" ::: "memory");
        }
    }
    __syncthreads();
}

constexpr int NWAVES = 8;
constexpr int NB = 4, T = 8192, D = 1024, M = NB * T;
constexpr int MEML = 256, MROWS = NB * MEML;
constexpr int FF = 2816;
constexpr int NPA = 2304;
constexpr int PA_Q = 0, PA_K = 256, PA_V = 512, PA_R = 1024, PA_MQ = 1536, PA_ALR = 2048;
constexpr int NPB = 1280;
constexpr int PB_Q = 0, PB_MQ = 512, PB_GL = 1024;
constexpr int NG5 = 2048;
constexpr float MEM_QSCALE = 0.08838834764831845f * 1.4426950408889634f;
constexpr int NCMP = 511, NCMPP = 512;
constexpr size_t MiB = 1u << 20;
constexpr size_t WS_CTL = 0, CTL_ZERO_BYTES = 1 * MiB;
constexpr size_t WS_SS = 1 * MiB;
constexpr size_t WS_SSM = 3 * MiB;
constexpr size_t WS_BIAS1 = 3 * MiB + 256 * 1024;
constexpr size_t WS_BPART = 3 * MiB + 512 * 1024;
constexpr size_t WS_WA = 4 * MiB;
constexpr size_t WS_WM = 9 * MiB;
constexpr size_t WS_WOA = 13 * MiB, WS_WOB = 15 * MiB;
constexpr size_t WS_WU = 17 * MiB;
constexpr size_t WS_WD = 39 * MiB;
constexpr size_t WS_WB = 50 * MiB;
constexpr size_t WS_WC1 = 54 * MiB;
constexpr size_t WS_WC2 = 56 * MiB;
constexpr size_t WS_XB = 64 * MiB;
constexpr size_t WS_CAT = 128 * MiB;
constexpr size_t WS_R1 = 192 * MiB;
constexpr size_t WS_R2 = 368 * MiB;
constexpr size_t WS_OG = WS_R2;
constexpr size_t WS_LA = WS_R2 + 64 * MiB;
constexpr size_t WS_KVC = WS_R2;
constexpr size_t WS_CH = WS_R2 + 50 * MiB;
constexpr size_t WS_KCMP = WS_R2 + 54 * MiB;
constexpr size_t WS_BND = WS_R2 + 102 * MiB;
constexpr size_t BND_ONE = (size_t)512 * 2 * FF * 4;
constexpr size_t WS_MKV = WS_R2 + 138 * MiB;
constexpr size_t WS_MEMB = WS_R2 + 142 * MiB;
constexpr size_t WS_END = 512 * MiB;
static_assert(WS_BND + 3 * BND_ONE <= WS_MKV && WS_LA + 32 * MiB <= WS_BND && WS_R1 + (size_t)M * FF * 2 <= WS_R2, "ws map");
constexpr size_t KVSTRIDE = (size_t)8 * 8192 * 64;
constexpr int CW_BAR = 4096, CW_PANEL = 1024;
constexpr int RING_BYTES = 131072;
constexpr int WSCR_BYTES = 17408;
constexpr int BLIST_OFF = 8 * WSCR_BYTES;
constexpr int LDSCTL_OFF = BLIST_OFF + 512, MISC_OFF = LDSCTL_OFF + 320;
constexpr int LDS_BYTES = 147456;
static_assert(MISC_OFF + 128 <= LDS_BYTES, "LDS map");

#define GAS __attribute__((address_space(1)))
#define LAS __attribute__((address_space(3)))
typedef unsigned short bf16;
typedef unsigned v4u __attribute__((ext_vector_type(4)));
typedef unsigned v2u __attribute__((ext_vector_type(2)));
typedef float f32x4 __attribute__((ext_vector_type(4)));
typedef GAS unsigned gu32;
#define LDS_WAIT() asm volatile("s_waitcnt lgkmcnt(0)" ::: "memory")
#define VM_WAIT() asm volatile("s_waitcnt vmcnt(0)" ::: "memory")
__device__ __forceinline__ unsigned f2bf(float f) { unsigned u = __builtin_bit_cast(unsigned, f); return (u + 0x7fffu + ((u >> 16) & 1u)) >> 16; }
__device__ __forceinline__ unsigned pk2(float lo, float hi) { return f2bf(lo) | (f2bf(hi) << 16); }
__device__ __forceinline__ float bf2f(unsigned short b) { return __uint_as_float((unsigned)b << 16); }
__device__ __forceinline__ float bflo(unsigned w) { return __uint_as_float(w << 16); }
__device__ __forceinline__ float bfhi(unsigned w) { return __uint_as_float(w & 0xffff0000u); }

struct Frame {
    LAS unsigned char* lds;
    volatile LAS unsigned* MISC;
    gu32* ctl;
    int tid, lane, wave, G;
    float* out; unsigned char* ws;
};
__device__ __forceinline__ const float* in_ptr(int i) { return ((const float* const __attribute__((address_space(4)))*)__builtin_amdgcn_kernarg_segment_ptr())[i]; }
enum { I_X = 0, I_MEM, I_GMIX, I_GFFN, I_GMEM, I_WMEMKV, I_WUP, I_CONVW, I_CONVB, I_WDOWN, I_AWIN, I_AWALPHA, I_ABALPHA, I_AGHEAD, I_AWOUT, I_GKV, I_WKV, I_PEK, I_PEV,
       I_WCK1, I_WCK2, I_WCV1, I_WCV2, I_BWIN, I_BWOUT, I_GFINAL };
#define WSP(T_, off) ((T_*)(F.ws + (off)))

__device__ __forceinline__ float wave_sum(float v) {
#pragma unroll
    for (int o = 1; o < 64; o <<= 1) v += __shfl_xor(v, o);
    return v;
}
__device__ __forceinline__ float wave_max(float v) {
#pragma unroll
    for (int o = 1; o < 64; o <<= 1) v = fmaxf(v, __shfl_xor(v, o));
    return v;
}

template <int MAP> __device__ __forceinline__ int map_row(int n) {
    if (MAP == 1) { return n < 1536 ? n : (n < 1552 ? n + 512 : n - 16); }
    if (MAP == 2) { return 768 + (n < 512 ? n : (n < 536 ? n + 512 : n - 24)); }
    if (MAP == 3) { const int half = n >= FF ? 1 : 0, f = n - half * FF; return 256 * (f >> 7) + 128 * half + (f & 127); }
    return n;
}
struct TrD { const float* W; const float* gain; bf16* WT; int K, N, row_off, map, item; };
__device__ __forceinline__ int map_row_rt(int map, int n) {
    if (map == 1) return map_row<1>(n);
    if (map == 2) return map_row<2>(n);
    if (map == 3) return map_row<3>(n);
    return n;
}
__device__ __forceinline__ void tr_load(float (&vv)[32], f32x4& ga, f32x4& gb, const TrD& d, int lane) {
    const int nblk = (d.N + 31) >> 5, kb = d.item / nblk, nb = d.item - kb * nblk, k0 = 64 * kb, n0 = 32 * nb;
    const int nn = n0 + (lane & 31);
    const float* wp = d.W + (size_t)(k0 + (lane >> 5)) * d.N + (nn < d.N ? nn : 0);
#pragma unroll
    for (int i = 0; i < 32; ++i) vv[i] = wp[(size_t)(2 * i) * d.N];
    ga = (f32x4){1.f, 1.f, 1.f, 1.f}; gb = ga;
    if (d.gain) { const f32x4* gp = (const f32x4*)(d.gain + k0 + 8 * (lane & 7)); ga = gp[0]; gb = gp[1]; }
}
__device__ __forceinline__ void tr_store(const float (&vv)[32], const f32x4 ga, const f32x4 gb, const TrD& d, LAS float* scr, int lane) {
    const int nblk = (d.N + 31) >> 5, kb = d.item / nblk, nb = d.item - kb * nblk, k0 = 64 * kb, n0 = 32 * nb;
#pragma unroll
    for (int i = 0; i < 32; ++i) scr[(2 * i + (lane >> 5)) * 33 + (lane & 31)] = vv[i];
    LDS_WAIT(); asm volatile("" ::: "memory");
    const int c = lane & 7;
#pragma unroll
    for (int j = 0; j < 4; ++j) { const int n = (lane >> 3) + 8 * j; const LAS float* s = scr + (8 * c) * 33 + n;
        v4u o; o.x = pg8::cvt_pk_bf16(s[0 * 33] * ga.x, s[1 * 33] * ga.y); o.y = pg8::cvt_pk_bf16(s[2 * 33] * ga.z, s[3 * 33] * ga.w); o.z = pg8::cvt_pk_bf16(s[4 * 33] * gb.x, s[5 * 33] * gb.y); o.w = pg8::cvt_pk_bf16(s[6 * 33] * gb.z, s[7 * 33] * gb.w);
        if (n0 + n < d.N) *(GAS v4u*)(d.WT + (size_t)(d.row_off + map_row_rt(d.map, n0 + n)) * d.K + k0 + 8 * c) = o; }
    LDS_WAIT(); asm volatile("" ::: "memory");
}
__device__ __forceinline__ void row_to_bf16_ss(const float* xrow, bf16* orow, float* ss, int lane) {
    const GAS f32x4* xr = (const GAS f32x4*)xrow + lane;
    f32x4 v[4]; float s = 0.f;
#pragma unroll
    for (int j = 0; j < 4; ++j) { v[j] = xr[64 * j]; s += (v[j].x * v[j].x + v[j].y * v[j].y) + (v[j].z * v[j].z + v[j].w * v[j].w); }
    s = wave_sum(s);
    GAS unsigned long long* o8 = (GAS unsigned long long*)orow + lane;
#pragma unroll
    for (int j = 0; j < 4; ++j) o8[64 * j] = (unsigned long long)pk2(v[j].x, v[j].y) | ((unsigned long long)pk2(v[j].z, v[j].w) << 32);
    if (lane < 16) ss[lane] = (lane == 0) ? s : 0.f;
}
constexpr int TR_I0 = 16 * 65, TR_I1 = 16 * 32, TR_I4 = 16 * 176, TR_I6 = 44 * 32, TR_I8 = 16 * 24, TR_I9 = 16 * 33, TR_I11 = 32 * 8, TR_I13 = 4 * 2;
constexpr int TR_NP0 = TR_I0 + 4 * TR_I1 + TR_I4 + TR_I6 + TR_I8 + TR_I9 + 2 * TR_I11 + 2 * TR_I13, TR_NITEMS = TR_NP0 + TR_I4 + TR_I6;
__device__ __forceinline__ TrD tr_decode(Frame& F, int r) {
    if (r < TR_I0) return TrD{in_ptr(I_AWIN), in_ptr(I_GMIX), WSP(bf16, WS_WA), 1024, 2064, 0, 1, r}; r -= TR_I0;
    if (r < TR_I1) return TrD{in_ptr(I_WMEMKV), in_ptr(I_GMEM), WSP(bf16, WS_WM), 1024, 1024, 0, 0, r}; r -= TR_I1;
    if (r < TR_I1) return TrD{in_ptr(I_WMEMKV) + 1024 * 1024, in_ptr(I_GMEM) + 1024, WSP(bf16, WS_WM), 1024, 1024, 1024, 0, r}; r -= TR_I1;
    if (r < TR_I1) return TrD{in_ptr(I_AWOUT), nullptr, WSP(bf16, WS_WOA), 1024, 1024, 0, 0, r}; r -= TR_I1;
    if (r < TR_I4) return TrD{in_ptr(I_WUP), in_ptr(I_GFFN), WSP(bf16, WS_WU), 1024, 2 * FF, 0, 3, r}; r -= TR_I4;
    if (r < TR_I6) return TrD{in_ptr(I_WDOWN), nullptr, WSP(bf16, WS_WD), FF, 1024, 0, 0, r}; r -= TR_I6;
    if (r < TR_I8) return TrD{in_ptr(I_WKV), in_ptr(I_GKV), WSP(bf16, WS_WB), 1024, 768, 0, 0, r}; r -= TR_I8;
    if (r < TR_I9) return TrD{in_ptr(I_BWIN), in_ptr(I_GMIX) + 1024, WSP(bf16, WS_WB), 1024, 1048, 0, 2, r}; r -= TR_I9;
    if (r < TR_I11) return TrD{in_ptr(I_WCK1), nullptr, WSP(bf16, WS_WC1), 2048, 256, 0, 0, r}; r -= TR_I11;
    if (r < TR_I11) return TrD{in_ptr(I_WCV1), nullptr, WSP(bf16, WS_WC1) + (size_t)256 * 2048, 2048, 256, 0, 0, r}; r -= TR_I11;
    if (r < TR_I13) return TrD{in_ptr(I_WCK2), nullptr, WSP(bf16, WS_WC2), 256, 64, 0, 0, r}; r -= TR_I13;
    if (r < TR_I13) return TrD{in_ptr(I_WCV2), nullptr, WSP(bf16, WS_WC2) + 64 * 256, 256, 64, 0, 0, r}; r -= TR_I13;
    if (r < TR_I1) return TrD{in_ptr(I_BWOUT), nullptr, WSP(bf16, WS_WOB), 1024, 1024, 0, 0, r}; r -= TR_I1;
    if (r < TR_I4) return TrD{in_ptr(I_WUP) + (size_t)1024 * 2 * FF, in_ptr(I_GFFN) + 1024, WSP(bf16, WS_WU) + (size_t)2 * FF * 1024, 1024, 2 * FF, 0, 3, r}; r -= TR_I4;
    return TrD{in_ptr(I_WDOWN) + (size_t)FF * 1024, nullptr, WSP(bf16, WS_WD) + (size_t)1024 * FF, FF, 1024, 0, 0, r};
}
__device__ __forceinline__ void tr_items(Frame& F, LAS float* scr, int w, int nw, int lo, int hi, int lane) {
    int it = lo + w;
    if (it >= hi) return;
    TrD d0 = tr_decode(F, it); float v0[32]; f32x4 g0a, g0b; tr_load(v0, g0a, g0b, d0, lane);
    TrD d1 = tr_decode(F, (it + nw < hi) ? it + nw : it); float v1[32]; f32x4 g1a, g1b; tr_load(v1, g1a, g1b, d1, lane);
#pragma unroll 1
    for (;;) {
        const int it2 = it + 2 * nw;
        const TrD d2 = tr_decode(F, (it2 < hi) ? it2 : it); float v2[32]; f32x4 g2a, g2b; tr_load(v2, g2a, g2b, d2, lane);
        tr_store(v0, g0a, g0b, d0, scr, lane);
        if (it + nw >= hi) break;
        it += nw; d0 = d1; g0a = g1a; g0b = g1b; d1 = d2; g1a = g2a; g1b = g2b;
#pragma unroll
        for (int i = 0; i < 32; ++i) { v0[i] = v1[i]; v1[i] = v2[i]; }
    }
}
__device__ __forceinline__ void p0_prologue(Frame& F) {
    LAS float* scr = (LAS float*)(F.lds + F.wave * 16384);
    const int gw = blockIdx.x * NWAVES + F.wave, NGW = F.G * NWAVES, lane = F.lane;
    for (int m = gw; m < MROWS; m += NGW) row_to_bf16_ss(in_ptr(I_MEM) + (size_t)m * D, WSP(bf16, WS_MEMB) + (size_t)m * D, WSP(float, WS_SSM) + (size_t)m * 16, lane);
    for (int o = gw; o < 512; o += NGW) { const int task = o >> 2, mlp = task >> 6, gi = task & 63, j = (o & 3) * 64 + lane; const float* pe = in_ptr(mlp ? I_PEV : I_PEK) + 32 * gi; const float* w1 = in_ptr(mlp ? I_WCV1 : I_WCK1) + (size_t)(32 * gi) * 256 + j;
        float wv[32];
#pragma unroll
        for (int kk = 0; kk < 32; ++kk) wv[kk] = w1[kk * 256];
        float s_ = 0.f;
#pragma unroll
        for (int kk = 0; kk < 32; ++kk) s_ += pe[kk] * wv[kk];
        WSP(float, WS_BPART)[(size_t)task * 256 + j] = s_; }
    tr_items(F, scr, gw, NGW, 0, (F.G == 256) ? TR_NP0 : TR_NITEMS, lane);
    { const int gt = blockIdx.x * 512 + F.tid, NT = F.G * 512; const v4u z = {0u, 0u, 0u, 0u};
      for (int i = gt; i < 240 * 128; i += NT) *(GAS v4u*)(WSP(bf16, WS_WA) + (size_t)2064 * 1024 + (size_t)i * 8) = z;
      for (int i = gt; i < 232 * 128; i += NT) *(GAS v4u*)(WSP(bf16, WS_WB) + (size_t)1816 * 1024 + (size_t)i * 8) = z; }
    { const float* xin = in_ptr(I_X); bf16* xbp = WSP(bf16, WS_XB); float* ssp = WSP(float, WS_SS);
      f32x4 v[8][4];
#pragma unroll
      for (int q = 0; q < 8; ++q) { const int mq = gw + q * NGW;
#pragma unroll
          for (int j = 0; j < 4; ++j) v[q][j] = ((const GAS f32x4*)(xin + (size_t)(mq < M ? mq : (M - 1)) * D) + lane)[64 * j]; }
#pragma unroll 1
      for (int m = gw; m < M; m += 8 * NGW) {
#pragma unroll
          for (int q = 0; q < 8; ++q) { const int mm = m + q * NGW; if (mm >= M) break;
              float s_ = 0.f;
#pragma unroll
              for (int j = 0; j < 4; ++j) s_ += (v[q][j].x * v[q][j].x + v[q][j].y * v[q][j].y) + (v[q][j].z * v[q][j].z + v[q][j].w * v[q][j].w);
              s_ += __int_as_float(__builtin_amdgcn_mov_dpp(__float_as_int(s_), 0xB1, 0xf, 0xf, true)); s_ += __int_as_float(__builtin_amdgcn_mov_dpp(__float_as_int(s_), 0x4E, 0xf, 0xf, true));
              GAS v2u* o8 = (GAS v2u*)(xbp + (size_t)mm * D) + lane;
#pragma unroll
              for (int j = 0; j < 4; ++j) { v2u w; w.x = pg8::cvt_pk_bf16(v[q][j].x, v[q][j].y); w.y = pg8::cvt_pk_bf16(v[q][j].z, v[q][j].w); o8[64 * j] = w; }
              if ((lane & 3) == 0) ssp[(size_t)mm * 16 + (lane >> 2)] = s_;
              const int mn = mm + 8 * NGW;
              if (mn < M) {
#pragma unroll
                  for (int j = 0; j < 4; ++j) v[q][j] = ((const GAS f32x4*)(xin + (size_t)mn * D) + lane)[64 * j]; } } } }
}
__device__ __forceinline__ void bias1_reduce(Frame& F) {
    const float* bp = WSP(float, WS_BPART) + (size_t)(F.tid >> 8) * 64 * 256 + (F.tid & 255);
    float v[64];
#pragma unroll
    for (int gi = 0; gi < 64; ++gi) v[gi] = bp[gi * 256];
    float s_ = 0.f;
#pragma unroll
    for (int gi = 0; gi < 64; ++gi) s_ += v[gi];
    WSP(float, WS_BIAS1)[F.tid] = s_;
}


typedef short bf16x8 __attribute__((ext_vector_type(8)));
typedef short s16x4 __attribute__((ext_vector_type(4)));
typedef float f32x16 __attribute__((ext_vector_type(16)));
__device__ __forceinline__ int crow(int r, int hi) { return (r & 3) + 8 * (r >> 2) + 4 * hi; }
typedef float f32x2_t __attribute__((ext_vector_type(2))); typedef __bf16 bf16x2_t __attribute__((ext_vector_type(2)));
__device__ __forceinline__ unsigned cvtpk(float lo, float hi) { const f32x2_t v = {lo, hi}; return __builtin_bit_cast(unsigned, __builtin_convertvector(v, bf16x2_t)); }
__device__ __forceinline__ void st_pair16(bf16* p0, int hi, v2u a, v2u b) {
    const auto r0 = __builtin_amdgcn_permlane32_swap(a.x, b.x, false, false); const auto r1 = __builtin_amdgcn_permlane32_swap(a.y, b.y, false, false);
    v4u w; w.x = r0[0]; w.y = r1[0]; w.z = r0[1]; w.w = r1[1];
    *(v4u*)(p0 + 8 * hi) = w;
}
__device__ __forceinline__ void dma16(const void* gsrc, LAS unsigned char* ldst) { __builtin_amdgcn_global_load_lds((const unsigned*)gsrc, (LAS unsigned*)ldst, 16, 0, 0); }
template <int NK16> __device__ __forceinline__ void qkt(f32x16& p0, f32x16& p1, const LAS unsigned char* Kt, const bf16x8* qr, int r32, int hi) {
    const LAS unsigned char* kb = Kt + hi * 1024 + r32 * 16;
    bf16x8 kf[2 * NK16];
#pragma unroll
    for (int d0 = 0; d0 < NK16; ++d0) { kf[2 * d0] = *(const LAS bf16x8*)(kb + d0 * 2048); kf[2 * d0 + 1] = *(const LAS bf16x8*)(kb + d0 * 2048 + 512); }
    __builtin_amdgcn_sched_barrier(0);
#pragma unroll
    for (int d0 = 0; d0 < NK16; ++d0) { p0 = __builtin_amdgcn_mfma_f32_32x32x16_bf16(kf[2 * d0], qr[d0], p0, 0, 0, 0); p1 = __builtin_amdgcn_mfma_f32_32x32x16_bf16(kf[2 * d0 + 1], qr[d0], p1, 0, 0, 0); }
    __builtin_amdgcn_sched_barrier(0);
}
__device__ __forceinline__ s16x4 vtr(const LAS unsigned char* p) { typedef short v4i16_t __attribute__((ext_vector_type(4))); return __builtin_bit_cast(s16x4, __builtin_amdgcn_ds_read_tr16_b64_v4i16((LAS v4i16_t*)p)); }
__device__ __forceinline__ void pack_p(bf16x8 (&pa)[4], const f32x16& p0, const f32x16& p1) {
    typedef unsigned u32x4_t __attribute__((ext_vector_type(4)));
    const u32x4_t w0 = {cvtpk(p0[0], p0[1]), cvtpk(p0[2], p0[3]), cvtpk(p0[4], p0[5]), cvtpk(p0[6], p0[7])}, w1 = {cvtpk(p0[8], p0[9]), cvtpk(p0[10], p0[11]), cvtpk(p0[12], p0[13]), cvtpk(p0[14], p0[15])};
    const u32x4_t w2 = {cvtpk(p1[0], p1[1]), cvtpk(p1[2], p1[3]), cvtpk(p1[4], p1[5]), cvtpk(p1[6], p1[7])}, w3 = {cvtpk(p1[8], p1[9]), cvtpk(p1[10], p1[11]), cvtpk(p1[12], p1[13]), cvtpk(p1[14], p1[15])};
    pa[0] = __builtin_bit_cast(bf16x8, w0); pa[1] = __builtin_bit_cast(bf16x8, w1); pa[2] = __builtin_bit_cast(bf16x8, w2); pa[3] = __builtin_bit_cast(bf16x8, w3);
}
template <int NDB> __device__ __forceinline__ void vfrag_issue(s16x4 (&vl)[NDB][4], s16x4 (&vh)[NDB][4], const LAS unsigned char* Vt, int lane) {
    const unsigned vb = (unsigned)(uintptr_t)(Vt + ((lane >> 4) & 1) * 32 + (lane & 3) * 8 + (4 * (lane >> 5) + ((lane & 15) >> 2)) * 64);
    asm volatile("s_waitcnt lgkmcnt(0)" ::: "memory");
#pragma unroll
    for (int db = 0; db < NDB; ++db)
#pragma unroll
        for (int ks = 0; ks < 4; ++ks) {
            asm volatile("ds_read_b64_tr_b16 %0, %1 offset:%c2" : "=&v"(vl[db][ks]) : "v"(vb), "i"(db * 4096 + ks * 1024) : "memory");
            asm volatile("ds_read_b64_tr_b16 %0, %1 offset:%c2" : "=&v"(vh[db][ks]) : "v"(vb), "i"(db * 4096 + ks * 1024 + 512) : "memory"); }
}
template <int NDB> __device__ __forceinline__ void pv_frag(f32x16* o, s16x4 (&vl)[NDB][4], s16x4 (&vh)[NDB][4], const bf16x8 (&pa)[4]) {
    asm volatile("s_waitcnt lgkmcnt(0)" ::: "memory");
#pragma unroll
    for (int db = 0; db < NDB; ++db)
#pragma unroll
        for (int ks = 0; ks < 4; ++ks) { asm volatile("" : "+v"(vl[db][ks]), "+v"(vh[db][ks]));
            const bf16x8 vf = {vl[db][ks][0], vl[db][ks][1], vl[db][ks][2], vl[db][ks][3], vh[db][ks][0], vh[db][ks][1], vh[db][ks][2], vh[db][ks][3]};
            o[db] = __builtin_amdgcn_mfma_f32_32x32x16_bf16(vf, pa[ks], o[db], 0, 0, 0); }
}
__device__ __forceinline__ float max3f(float a, float b, float c) { return __builtin_fmaxf(__builtin_fmaxf(a, b), c); }
__device__ __forceinline__ float max32(const f32x16& p0, const f32x16& p1) {
    float a = max3f(p0[0], p0[1], p1[0]), b = max3f(p0[2], p0[3], p1[1]); a = max3f(a, p1[2], p1[3]);
#pragma unroll
    for (int r = 4; r < 16; r += 4) { a = max3f(a, p0[r], p0[r + 1]); b = max3f(b, p0[r + 2], p0[r + 3]); a = max3f(a, p1[r], p1[r + 1]); b = max3f(b, p1[r + 2], p1[r + 3]); }
    const float m = fmaxf(a, b);
    const auto rr = __builtin_amdgcn_permlane32_swap(__float_as_uint(m), __float_as_uint(m), false, false);
    return fmaxf(__uint_as_float(rr[0]), __uint_as_float(rr[1]));
}
template <int NDB> __device__ __forceinline__ void softmax_step(f32x16& p0, f32x16& p1, float& m, float& l, f32x16* o) {
    const float mn = fmaxf(m, max32(p0, p1)); const float mu = (mn == -INFINITY) ? 0.f : mn; const float alpha = __builtin_amdgcn_exp2f(m - mu);
    float s = 0.f;
#pragma unroll
    for (int r = 0; r < 16; ++r) { p0[r] = __builtin_amdgcn_exp2f(p0[r] - mu); p1[r] = __builtin_amdgcn_exp2f(p1[r] - mu); s += p0[r] + p1[r]; }
    l = l * alpha + s; m = mn;
#pragma unroll
    for (int db = 0; db < NDB; ++db)
#pragma unroll
        for (int r = 0; r < 16; ++r) o[db][r] *= alpha;
}

__device__ __forceinline__ void ph_memattn_mfma(Frame& F, const bf16* Qb, int ldq, int qcol0, int layer, int vb, int VG) {
    const bf16* MKV = WSP(bf16, WS_MKV); bf16* CAT = WSP(bf16, WS_CAT);
    const int lane = F.lane, wave = F.wave, r32 = lane & 31, hi = lane >> 5;
    LAS unsigned char* Kl = F.lds; LAS unsigned char* Vl = F.lds + 65536;
    const int vlo = (vb * 512) / VG, vhi = ((vb + 1) * 512) / VG;
    int cur_bh = -1;
#pragma unroll 1
    for (int v = vlo; v < vhi; ++v) {
        const int bh = v >> 5, b = bh >> 2, h = bh & 3, q0 = (v & 31) * 256 + wave * 32;
        const size_t row = (size_t)b * T + q0 + r32;
        bf16x8 qr[8];
#pragma unroll
        for (int d0 = 0; d0 < 8; ++d0) qr[d0] = *(const bf16x8*)(Qb + row * ldq + qcol0 + h * 128 + d0 * 16 + hi * 8);
        if (bh != cur_bh) {
            __syncthreads();
            const char* kg = (const char*)(MKV + (size_t)(b * 256) * 2048 + layer * 1024 + h * 128); const char* vg = kg + 1024;
#pragma unroll
            for (int j = 0; j < 8; ++j) { const int pc = wave * 8 + j;
                dma16(kg + (size_t)((pc >> 4) * 64 + lane) * 4096 + (pc & 15) * 16, Kl + (pc >> 4) * 16384 + (pc & 15) * 1024);
                dma16(vg + (size_t)((pc >> 4) * 64 + (pc & 3) * 16 + (lane >> 2)) * 4096 + ((pc >> 2) & 3) * 64 + (lane & 3) * 16, Vl + (pc >> 4) * 16384 + ((pc >> 2) & 3) * 4096 + (pc & 3) * 1024); }
            cur_bh = bh;
            asm volatile("s_waitcnt vmcnt(0)" ::: "memory");
            __syncthreads();
        }
        f32x16 o[4]; o[0] = (f32x16){}; o[1] = (f32x16){}; o[2] = (f32x16){}; o[3] = (f32x16){};
        float m = -INFINITY, l = 0.f;
#pragma unroll 1
        for (int kt = 0; kt < 4; ++kt) {
            f32x16 p0 = (f32x16){}, p1 = (f32x16){}; qkt<8>(p0, p1, Kl + kt * 16384, qr, r32, hi);
            s16x4 vl[2][4], vh[2][4]; vfrag_issue<2>(vl, vh, Vl + kt * 16384, lane);
            softmax_step<4>(p0, p1, m, l, o);
            bf16x8 pa[4]; pack_p(pa, p0, p1);
            pv_frag<2>(o, vl, vh, pa);
            s16x4 vl2[2][4], vh2[2][4]; vfrag_issue<2>(vl2, vh2, Vl + kt * 16384 + 8192, lane);
            pv_frag<2>(o + 2, vl2, vh2, pa);
        }
        l += __shfl_xor(l, 32); const float inv = 1.0f / l;
        bf16* op = CAT + row * 1024 + 512 + h * 128;
#pragma unroll
        for (int db = 0; db < 4; ++db)
#pragma unroll
            for (int rg = 0; rg < 4; rg += 2) { v2u w, w2; w.x = cvtpk(o[db][4 * rg] * inv, o[db][4 * rg + 1] * inv); w.y = cvtpk(o[db][4 * rg + 2] * inv, o[db][4 * rg + 3] * inv);
                w2.x = cvtpk(o[db][4 * rg + 4] * inv, o[db][4 * rg + 5] * inv); w2.y = cvtpk(o[db][4 * rg + 6] * inv, o[db][4 * rg + 7] * inv);
                st_pair16(op + 32 * db + 8 * rg, hi, w, w2); }
    }
    __syncthreads();
}

constexpr int NS_K = 0, NS_V = 32768, NS_MAIN = 65536, NS_PITCH = 129, NS_SPILL = NS_MAIN + 64 * NS_PITCH * 4, NS_MASK = NS_SPILL + 64 * NS_PITCH * 4, NS_UNION = NS_MASK + 1024, NS_BLIST = NS_UNION + 16, NS_END = NS_BLIST + 512;
static_assert(NS_END <= LDSCTL_OFF, "NSA LDS map");
__device__ __forceinline__ void nsa_dma(const bf16* Kb, const bf16* Vb, int row0, LAS unsigned char* lds, int buf, int wave, int lane) {
    dma16((const char*)Kb + (size_t)(row0 + lane) * 128 + wave * 16, lds + NS_K + buf * 8192 + wave * 1024);
    if (Vb) dma16((const char*)Vb + (size_t)(row0 + (wave & 3) * 16 + (lane >> 2)) * 128 + (wave >> 2) * 64 + (lane & 3) * 16, lds + NS_V + buf * 8192 + (wave >> 2) * 4096 + (wave & 3) * 1024);
}
#define NSA_STAGE_BAR() asm volatile("s_waitcnt vmcnt(0) lgkmcnt(0)\n\ts_barrier" ::: "memory")
template <int KSTEP> __device__ __forceinline__ void nsa_bias(f32x16& p0, f32x16& p1, int base, float sl, float mref, bool lanevalid = true) {
    const float A = lanevalid ? (-sl * (float)base - mref) : -INFINITY, slk = sl * (float)KSTEP, C = slk * 32.0f;
#pragma unroll
    for (int r = 0; r < 16; ++r) { const float tr = fmaf(slk, (float)((r & 3) + 8 * (r >> 2)), A); p0[r] = tr; p1[r] = tr + C; }
}
template <int KSTEP, bool WINDOW> __device__ __forceinline__ void nsa_mask(f32x16& p0, f32x16& p1, int base) {
#pragma unroll
    for (int r = 0; r < 16; ++r) { const int d0 = base - KSTEP * ((r & 3) + 8 * (r >> 2)), d1 = d0 - 32 * KSTEP;
        const bool v0 = WINDOW ? (d0 >= 0 && d0 < 512) : (d0 >= 0), v1 = WINDOW ? (d1 >= 0 && d1 < 512) : (d1 >= 0);
        p0[r] = v0 ? p0[r] : -INFINITY; p1[r] = v1 ? p1[r] : -INFINITY; }
}
template <int NDB> __device__ __forceinline__ void nsa_softmax(f32x16& p0, f32x16& p1, float& m, float& l, f32x16* o) {
    const float mx = max32(p0, p1);
    if (__any(mx > 8.0f)) { const float dl = (mx > 8.0f) ? mx : 0.f; m += dl; const float ef = __builtin_amdgcn_exp2f(-dl); l *= ef;
#pragma unroll
        for (int r = 0; r < 16; ++r) { p0[r] -= dl; p1[r] -= dl; }
#pragma unroll
        for (int db = 0; db < NDB; ++db)
#pragma unroll
            for (int r = 0; r < 16; ++r) o[db][r] *= ef; }
    float s = 0.f;
#pragma unroll
    for (int r = 0; r < 16; ++r) { p0[r] = __builtin_amdgcn_exp2f(p0[r]); p1[r] = __builtin_amdgcn_exp2f(p1[r]); s += p0[r] + p1[r]; }
    l += s;
}
__device__ __forceinline__ float dpp_xor1(float v) { return __int_as_float(__builtin_amdgcn_mov_dpp(__float_as_int(v), 0xB1, 0xf, 0xf, true)); }
__device__ __forceinline__ float dpp_xor2(float v) { return __int_as_float(__builtin_amdgcn_mov_dpp(__float_as_int(v), 0x4E, 0xf, 0xf, true)); }
__device__ __forceinline__ void ph_nsa_mfma(Frame& F) {
    const bf16* PB = WSP(bf16, WS_R1); const bf16* KVC = WSP(bf16, WS_KVC); const bf16* KCMP = WSP(bf16, WS_KCMP); bf16* CAT = WSP(bf16, WS_CAT);
    const int lane = F.lane, wave = F.wave, tid = F.tid, r32 = lane & 31, hi = lane >> 5, hp = r32 & 3, q8 = r32 >> 2, ql = 8 * wave + q8;
    LAS unsigned char* lds = F.lds;
    LAS float* Lmain = (LAS float*)(lds + NS_MAIN); LAS float* Lspill = (LAS float*)(lds + NS_SPILL); LAS unsigned* Lmask = (LAS unsigned*)(lds + NS_MASK); LAS unsigned* Lunion = (LAS unsigned*)(lds + NS_UNION); LAS int* Lblist = (LAS int*)(lds + NS_BLIST);
    const int nunits = 1024, per = (nunits + F.G - 1) / F.G;
#define NSA_UNIT(ui_, bg_, qt_, ok_) do { if (F.G == 256) { const int s_ = blockIdx.x & 31; bg_ = blockIdx.x >> 5; qt_ = ((ui_) == 0) ? s_ : ((ui_) == 1) ? 63 - s_ : ((ui_) == 2) ? 64 + s_ : 127 - s_; ok_ = (ui_) < 4; } \
        else { const int u_ = blockIdx.x + (ui_) * F.G; ok_ = (ui_) < per && u_ < nunits; bg_ = u_ >> 7; qt_ = u_ & 127; } } while (0)
    int sp = 0;
    if (wave >= 4) __builtin_amdgcn_s_setprio(1);
    { int bg0, qt0; bool ok0; NSA_UNIT(0, bg0, qt0, ok0);
      if (ok0) { const int nt0 = (4 * qt0 + 3 + 63) >> 6; const bf16* kc0 = KCMP + (size_t)(bg0 * NCMPP) * 64; nsa_dma(kc0, nullptr, (nt0 - 1) * 64, lds, 0, wave, lane); if (nt0 > 1) nsa_dma(kc0, nullptr, (nt0 - 2) * 64, lds, 1, wave, lane); } }
    bf16x8 qnx[4]; unsigned short gnx[3];
    { int bg0, qt0; bool ok0; NSA_UNIT(0, bg0, qt0, ok0); if (!ok0) { bg0 = 0; qt0 = 0; }
      const size_t row0_ = (size_t)(bg0 >> 1) * T + qt0 * 64 + ql; const int head0_ = (bg0 & 1) * 4 + hp;
#pragma unroll
      for (int d0 = 0; d0 < 4; ++d0) qnx[d0] = *(const bf16x8*)(PB + row0_ * NPB + PB_Q + head0_ * 64 + d0 * 16 + hi * 8);
#pragma unroll
      for (int i = 0; i < 3; ++i) gnx[i] = PB[row0_ * NPB + PB_GL + head0_ * 3 + i]; }
#pragma unroll 1
    for (int ui = 0; ui < per; ++ui) {
        int bg, qt; bool ok_u; NSA_UNIT(ui, bg, qt, ok_u); if (!ok_u) break;
        int bgn, qtn; bool ok_n; NSA_UNIT(ui + 1, bgn, qtn, ok_n);
        const int b = bg >> 1, g = bg & 1, t0 = qt * 64, t = t0 + ql, cur = qt, tmin = t0 + 8 * wave;
        const size_t row = (size_t)b * T + t; const int head = g * 4 + hp;
        const float slope2 = exp2f(-(float)(head + 1)) * 1.4426950408889634f;
        bf16x8 qr[4];
#pragma unroll
        for (int d0 = 0; d0 < 4; ++d0) qr[d0] = qnx[d0];
        float gate[3];
#pragma unroll
        for (int i = 0; i < 3; ++i) gate[i] = pg8::sigmoid_f(bf2f(gnx[i]));
        if (tid < 4) Lunion[tid] = 0u;
        LAS float* Ltot = (LAS float*)(lds + NS_MAIN) + tid;
        const bf16* kcb = KCMP + (size_t)(bg * NCMPP) * 64; const bf16* vcb = KCMP + (size_t)(4096 + bg * NCMPP) * 64;
        const int nt = (4 * qt + 3 + 63) >> 6;
        float m = 0.f, l = 0.f;
#pragma unroll 1
        for (int st = 0; 2 * st < nt; ++st) {
            NSA_STAGE_BAR();
            { const int i2 = 2 * st + 2, sb = ((sp + st + 1) & 1) * 2; if (i2 < nt) { nsa_dma(kcb, nullptr, (nt - 1 - i2) * 64, lds, sb, wave, lane); if (i2 + 1 < nt) nsa_dma(kcb, nullptr, (nt - 2 - i2) * 64, lds, sb + 1, wave, lane); }
              else { nsa_dma(kcb, vcb, (nt - 1) * 64, lds, sb, wave, lane); if (nt > 1) nsa_dma(kcb, vcb, (nt - 2) * 64, lds, sb + 1, wave, lane); } }
#pragma unroll 1
            for (int h2 = 0; h2 < 2; ++h2) { const int it = 2 * st + h2; if (it >= nt) break; const int kt = nt - 1 - it, buf = ((sp + st) & 1) * 2 + h2;
                const int base = t - 31 - 16 * (64 * kt + 4 * hi);
                f32x16 p0, p1; nsa_bias<16>(p0, p1, base, slope2, m); qkt<4>(p0, p1, lds + NS_K + buf * 8192, qr, r32, hi);
                if (1024 * kt + 1039 > tmin) nsa_mask<16, false>(p0, p1, base);
                nsa_softmax<0>(p0, p1, m, l, nullptr); }
        }
        sp = (sp + ((nt + 1) >> 1)) & 1;
        l += __shfl_xor(l, 32);
        const float invl = 1.0f / fmaxf(l, 1e-30f);
        f32x16 o[2]; o[0] = (f32x16){}; o[1] = (f32x16){};
        const bf16* ksb = KVC + 2 * KVSTRIDE + (size_t)bg * 8192 * 64; const bf16* vsb = KVC + 3 * KVSTRIDE + (size_t)bg * 8192 * 64;
#pragma unroll 1
        for (int st = 0; 2 * st < nt; ++st) {
            NSA_STAGE_BAR();
            { const int i2 = 2 * st + 2, sb = ((sp + st + 1) & 1) * 2; if (i2 < nt) { nsa_dma(kcb, vcb, (nt - 1 - i2) * 64, lds, sb, wave, lane); if (i2 + 1 < nt) nsa_dma(kcb, vcb, (nt - 2 - i2) * 64, lds, sb + 1, wave, lane); }
              else { nsa_dma(ksb, vsb, cur * 64, lds, sb, wave, lane); if (cur > 0) nsa_dma(ksb, vsb, (cur - 1) * 64, lds, sb + 1, wave, lane); } }
#pragma unroll 1
            for (int h2 = 0; h2 < 2; ++h2) { const int it = 2 * st + h2; if (it >= nt) break; const int kt = nt - 1 - it, buf = ((sp + st) & 1) * 2 + h2;
                const int base = t - 31 - 16 * (64 * kt + 4 * hi);
                f32x16 p0, p1; nsa_bias<16>(p0, p1, base, slope2, m); qkt<4>(p0, p1, lds + NS_K + buf * 8192, qr, r32, hi);
                s16x4 vl[2][4], vh[2][4]; vfrag_issue<2>(vl, vh, lds + NS_V + buf * 8192, lane);
                if (1024 * kt + 1039 > tmin) nsa_mask<16, false>(p0, p1, base);
#pragma unroll
                for (int r = 0; r < 16; ++r) { p0[r] = __builtin_amdgcn_exp2f(p0[r]) * invl; p1[r] = __builtin_amdgcn_exp2f(p1[r]) * invl; }
#pragma unroll
                for (int pi = 0; pi < 2; ++pi)
#pragma unroll
                    for (int rg = 0; rg < 4; ++rg) { const f32x16& pp = pi ? p1 : p0; float v3 = 0.5f * pp[4 * rg + 3]; float vm = (pp[4 * rg] + pp[4 * rg + 1]) + (pp[4 * rg + 2] + v3);
                        vm += dpp_xor1(vm); vm += dpp_xor2(vm); v3 += dpp_xor1(v3); v3 += dpp_xor2(v3);
                        const int a = 16 * kt + 8 * pi + 2 * rg + hi;
                        if (hp == 0) { Lmain[ql * NS_PITCH + a] = vm; Lspill[ql * NS_PITCH + a] = v3; } }
                bf16x8 pa[4]; pack_p(pa, p0, p1);
                pv_frag<2>(o, vl, vh, pa); }
        }
        sp = (sp + ((nt + 1) >> 1)) & 1;
        __syncthreads();
#pragma unroll
        for (int db = 0; db < 2; ++db)
#pragma unroll
            for (int r = 0; r < 16; ++r) o[db][r] *= gate[0];
        {
            int q = tid >> 3, s8 = tid & 7; asm volatile("" : "+v"(q), "+v"(s8));
            unsigned mw0 = 0u, mw1 = 0u, mw2 = 0u, mw3 = 0u;
            if (cur < 16) { mw0 = (1u << (cur + 1)) - 1u; }
            else {
                float val[16];
#pragma unroll
                for (int k = 0; k < 16; ++k) { const int j = s8 + 8 * k;
                    val[k] = (j > cur) ? -INFINITY : ((j == 0 || j >= cur - 1) ? INFINITY : Lmain[q * NS_PITCH + j] + Lspill[q * NS_PITCH + j - 1]); }
#pragma unroll 1
                for (int round = 0; round < 16; ++round) {
                    float bv = val[0]; int bj = s8;
#pragma unroll
                    for (int k = 1; k < 16; ++k) { const bool gt = val[k] > bv; bv = gt ? val[k] : bv; bj = gt ? (s8 + 8 * k) : bj; }
#pragma unroll
                    for (int stp = 0; stp < 3; ++stp) {
                        const float ov = __int_as_float(stp == 0 ? __builtin_amdgcn_mov_dpp(__float_as_int(bv), 0xB1, 0xf, 0xf, true) : stp == 1 ? __builtin_amdgcn_mov_dpp(__float_as_int(bv), 0x4E, 0xf, 0xf, true) : __builtin_amdgcn_mov_dpp(__float_as_int(bv), 0x141, 0xf, 0xf, true));
                        const int oj = stp == 0 ? __builtin_amdgcn_mov_dpp(bj, 0xB1, 0xf, 0xf, true) : stp == 1 ? __builtin_amdgcn_mov_dpp(bj, 0x4E, 0xf, 0xf, true) : __builtin_amdgcn_mov_dpp(bj, 0x141, 0xf, 0xf, true);
                        const bool tk = (ov > bv) || (ov == bv && oj < bj); bv = tk ? ov : bv; bj = tk ? oj : bj; }
#pragma unroll
                    for (int k = 0; k < 16; ++k) val[k] = (bj == s8 + 8 * k) ? -INFINITY : val[k];
                    const unsigned bit = 1u << (bj & 31); const int wsel = bj >> 5;
                    mw0 |= (wsel == 0) ? bit : 0u; mw1 |= (wsel == 1) ? bit : 0u; mw2 |= (wsel == 2) ? bit : 0u; mw3 |= (wsel == 3) ? bit : 0u;
                }
            }
            if (s8 == 0) { Lmask[q * 4 + 0] = mw0; Lmask[q * 4 + 1] = mw1; Lmask[q * 4 + 2] = mw2; Lmask[q * 4 + 3] = mw3;
                atomicOr((unsigned*)&Lunion[0], mw0); atomicOr((unsigned*)&Lunion[1], mw1); atomicOr((unsigned*)&Lunion[2], mw2); atomicOr((unsigned*)&Lunion[3], mw3); }
        }
        __syncthreads();
        int nsel;
        { const unsigned u0 = Lunion[0], u1 = Lunion[1], u2 = Lunion[2], u3 = Lunion[3];
          nsel = __builtin_amdgcn_readfirstlane(__popc(u0) + __popc(u1) + __popc(u2) + __popc(u3));
          if (tid < 128) { const unsigned uw = (tid < 32) ? u0 : (tid < 64) ? u1 : (tid < 96) ? u2 : u3; const int bp = tid & 31;
              if ((uw >> bp) & 1u) { int pos = __popc(uw & ((1u << bp) - 1u)); if (tid >= 32) pos += __popc(u0); if (tid >= 64) pos += __popc(u1); if (tid >= 96) pos += __popc(u2); Lblist[pos] = tid; } } }
        const unsigned mq0 = Lmask[ql * 4 + 0], mq1 = Lmask[ql * 4 + 1], mq2 = Lmask[ql * 4 + 2], mq3 = Lmask[ql * 4 + 3];
        __syncthreads();
#pragma unroll
        for (int db = 0; db < 2; ++db)
#pragma unroll
            for (int r = 0; r < 16; ++r) Ltot[(db * 16 + r) * 512] = o[db][r];
        const bf16* kwb = KVC + 4 * KVSTRIDE + (size_t)bg * 8192 * 64; const bf16* vwb = KVC + 5 * KVSTRIDE + (size_t)bg * 8192 * 64;
        o[0] = (f32x16){}; o[1] = (f32x16){}; m = 0.f; l = 0.f;
#pragma unroll 1
        for (int st = 0; 2 * st < nsel; ++st) {
            NSA_STAGE_BAR();
            { const int i2 = 2 * st + 2, sb = ((sp + st + 1) & 1) * 2; if (i2 < nsel) { nsa_dma(ksb, vsb, __builtin_amdgcn_readfirstlane(Lblist[nsel - 1 - i2]) * 64, lds, sb, wave, lane); if (i2 + 1 < nsel) nsa_dma(ksb, vsb, __builtin_amdgcn_readfirstlane(Lblist[nsel - 2 - i2]) * 64, lds, sb + 1, wave, lane); }
              else { nsa_dma(kwb, vwb, qt * 64, lds, sb, wave, lane); if (qt > 0) nsa_dma(kwb, vwb, (qt - 1) * 64, lds, sb + 1, wave, lane); } }
#pragma unroll 1
            for (int h2 = 0; h2 < 2; ++h2) { const int i = 2 * st + h2; if (i >= nsel) break; const int j = __builtin_amdgcn_readfirstlane(Lblist[nsel - 1 - i]), buf = ((sp + st) & 1) * 2 + h2;
                const unsigned wj = (j < 32) ? mq0 : (j < 64) ? mq1 : (j < 96) ? mq2 : mq3; const bool selq = (wj >> (j & 31)) & 1u;
                const int base = t - (64 * j + 4 * hi);
                f32x16 p0, p1; nsa_bias<1>(p0, p1, base, slope2, m, selq);
                qkt<4>(p0, p1, lds + NS_K + buf * 8192, qr, r32, hi);
                s16x4 vl[2][4], vh[2][4]; vfrag_issue<2>(vl, vh, lds + NS_V + buf * 8192, lane);
                if (j == cur) nsa_mask<1, false>(p0, p1, base);
                nsa_softmax<2>(p0, p1, m, l, o);
                bf16x8 pa[4]; pack_p(pa, p0, p1);
                pv_frag<2>(o, vl, vh, pa); }
        }
        sp = (sp + ((nsel + 1) >> 1)) & 1;
        { l += __shfl_xor(l, 32); const float sc = gate[1] / fmaxf(l, 1e-30f);
#pragma unroll
          for (int db = 0; db < 2; ++db)
#pragma unroll
            for (int r = 0; r < 16; ++r) Ltot[(db * 16 + r) * 512] += sc * o[db][r]; }
        o[0] = (f32x16){}; o[1] = (f32x16){}; m = 0.f; l = 0.f;
        const int j0 = qt >= 8 ? qt - 8 : 0, nw = qt - j0 + 1;
#pragma unroll 1
        for (int st = 0; 2 * st < nw; ++st) {
            NSA_STAGE_BAR();
            if (st == 0 && ok_n) { const size_t rown_ = (size_t)(bgn >> 1) * T + qtn * 64 + ql; const int headn_ = (bgn & 1) * 4 + hp;
#pragma unroll
                for (int d0 = 0; d0 < 4; ++d0) qnx[d0] = *(const bf16x8*)(PB + rown_ * NPB + PB_Q + headn_ * 64 + d0 * 16 + hi * 8);
#pragma unroll
                for (int i = 0; i < 3; ++i) gnx[i] = PB[rown_ * NPB + PB_GL + headn_ * 3 + i]; }
            { const int i2 = 2 * st + 2, sb = ((sp + st + 1) & 1) * 2; if (i2 < nw) { nsa_dma(kwb, vwb, (qt - i2) * 64, lds, sb, wave, lane); if (i2 + 1 < nw) nsa_dma(kwb, vwb, (qt - i2 - 1) * 64, lds, sb + 1, wave, lane); }
              else if (ok_n) { const int ntn = (4 * qtn + 3 + 63) >> 6; const bf16* kcn = KCMP + (size_t)(bgn * NCMPP) * 64; nsa_dma(kcn, nullptr, (ntn - 1) * 64, lds, sb, wave, lane); if (ntn > 1) nsa_dma(kcn, nullptr, (ntn - 2) * 64, lds, sb + 1, wave, lane); } }
#pragma unroll 1
            for (int h2 = 0; h2 < 2; ++h2) { const int i = 2 * st + h2; if (i >= nw) break; const int j = qt - i, buf = ((sp + st) & 1) * 2 + h2;
                const int base = t - (64 * j + 4 * hi);
                f32x16 p0, p1; nsa_bias<1>(p0, p1, base, slope2, m); qkt<4>(p0, p1, lds + NS_K + buf * 8192, qr, r32, hi);
                s16x4 vl[2][4], vh[2][4]; vfrag_issue<2>(vl, vh, lds + NS_V + buf * 8192, lane);
                if (j == qt || j + 8 == qt) nsa_mask<1, true>(p0, p1, base);
                nsa_softmax<2>(p0, p1, m, l, o);
                bf16x8 pa[4]; pack_p(pa, p0, p1);
                pv_frag<2>(o, vl, vh, pa); }
        }
        sp = (sp + ((nw + 1) >> 1)) & 1;
        { l += __shfl_xor(l, 32); const float sc = gate[2] / fmaxf(l, 1e-30f);
          bf16* op = CAT + row * 1024 + head * 64;
#pragma unroll
          for (int db = 0; db < 2; ++db)
#pragma unroll
            for (int rg = 0; rg < 4; rg += 2) { v2u wp[2];
#pragma unroll
                for (int k = 0; k < 2; ++k) { const int r_ = 4 * (rg + k); const float v0 = Ltot[(db * 16 + r_) * 512] + sc * o[db][r_], v1 = Ltot[(db * 16 + r_ + 1) * 512] + sc * o[db][r_ + 1], v2 = Ltot[(db * 16 + r_ + 2) * 512] + sc * o[db][r_ + 2], v3 = Ltot[(db * 16 + r_ + 3) * 512] + sc * o[db][r_ + 3];
                    wp[k].x = cvtpk(v0, v1); wp[k].y = cvtpk(v2, v3); }
                st_pair16(op + 32 * db + 8 * rg, hi, wp[0], wp[1]); } }
    }
#undef NSA_UNIT
    __builtin_amdgcn_s_setprio(0);
    asm volatile("s_waitcnt vmcnt(0)" ::: "memory"); __syncthreads();
}
constexpr size_t WS_DS = WS_OG, WS_SP = WS_LA, WS_DEC = WS_R2 + 96 * MiB, WS_BC = WS_BND;
constexpr int GL_ALR = 0, GL_TOT = 4096  , GL_KE = 8192, GL_V = 40960;
static_assert(GL_V + 65536 <= LDSCTL_OFF, "GLA LDS map");
__device__ __forceinline__ void gla_dma_v(const bf16* PA, int row0, LAS unsigned char* lds, int wave, int lane) {
#pragma unroll
    for (int j = 0; j < 8; ++j) { const int pc = wave * 8 + j, h = pc >> 4, db = (pc >> 2) & 3, kg4 = pc & 3;
        dma16((const char*)(PA + (size_t)(row0 + kg4 * 16 + (lane >> 2)) * NPA + PA_V + h * 128 + db * 32) + (lane & 3) * 16, lds + GL_V + h * 16384 + db * 4096 + kg4 * 1024); }
}
__device__ __forceinline__ void ph_gla_local(Frame& F) {
    const bf16* PA = WSP(bf16, WS_R1); float* BC = WSP(float, WS_BC); bf16* DS = WSP(bf16, WS_DS); float* DEC = WSP(float, WS_DEC);
    const float* wa = in_ptr(I_AWALPHA); const float* ba = in_ptr(I_ABALPHA);
    const int lane = F.lane, wave = F.wave, tid = F.tid, r32 = lane & 31, hi = lane >> 5;
    LAS unsigned char* lds = F.lds; LAS float* Lalr = (LAS float*)(lds + GL_ALR); LAS float* Ltot = (LAS float*)(lds + GL_TOT);
    typedef float f32x2_ __attribute__((ext_vector_type(2)));
    const int cp = tid & 127, qtr = tid >> 7, ch = 2 * cp, h = ch >> 6, d = ch & 63;
    float w0[16], w1[16];
#pragma unroll
    for (int j = 0; j < 16; ++j) { const f32x2_ t_ = *(const f32x2_*)(wa + j * 256 + ch); w0[j] = t_.x; w1[j] = t_.y; }
    const f32x2_ bias2 = *(const f32x2_*)(ba + ch);
#pragma unroll 1
    for (int u = blockIdx.x; u < 512; u += F.G) {
        const int b = u >> 7, c = u & 127, row0 = b * T + c * 64;
        gla_dma_v(PA, row0, lds, wave, lane);
#pragma unroll
        for (int k = 0; k < 2; ++k) { const int idx = tid + 512 * k; Lalr[idx] = bf2f(PA[(size_t)(row0 + (idx >> 4)) * NPA + PA_ALR + (idx & 15)]); }
        unsigned kraw[16];
#pragma unroll
        for (int i = 0; i < 16; ++i) kraw[i] = *(const unsigned*)(PA + (size_t)(row0 + qtr * 16 + i) * NPA + PA_K + ch);
        LDS_WAIT(); __syncthreads();
        float b0[16], b1[16]; float run0 = 0.f, run1 = 0.f;
#pragma unroll
        for (int i = 0; i < 16; ++i) { const LAS f32x4* ap = (const LAS f32x4*)(Lalr + (qtr * 16 + i) * 16); const f32x4 a0 = ap[0], a1 = ap[1], a2 = ap[2], a3 = ap[3];
            const float z0 = bias2.x + a0.x * w0[0] + a0.y * w0[1] + a0.z * w0[2] + a0.w * w0[3] + a1.x * w0[4] + a1.y * w0[5] + a1.z * w0[6] + a1.w * w0[7] + a2.x * w0[8] + a2.y * w0[9] + a2.z * w0[10] + a2.w * w0[11] + a3.x * w0[12] + a3.y * w0[13] + a3.z * w0[14] + a3.w * w0[15];
            const float z1 = bias2.y + a0.x * w1[0] + a0.y * w1[1] + a0.z * w1[2] + a0.w * w1[3] + a1.x * w1[4] + a1.y * w1[5] + a1.z * w1[6] + a1.w * w1[7] + a2.x * w1[8] + a2.y * w1[9] + a2.z * w1[10] + a2.w * w1[11] + a3.x * w1[12] + a3.y * w1[13] + a3.z * w1[14] + a3.w * w1[15];
            const float ls0 = fminf(z0, 0.f) - __logf(1.0f + __expf(-fabsf(z0))), ls1 = fminf(z1, 0.f) - __logf(1.0f + __expf(-fabsf(z1)));
            run0 += ls0 * (1.0f / 16.0f); b0[i] = run0; run1 += ls1 * (1.0f / 16.0f); b1[i] = run1; }
        { f32x2_ t_; t_.x = run0; t_.y = run1; ((LAS f32x2_*)Ltot)[qtr * 128 + cp] = t_; }
        LDS_WAIT(); __syncthreads();
        float bl0, bl1;
        { const f32x2_ t0 = ((const LAS f32x2_*)Ltot)[cp], t1 = ((const LAS f32x2_*)Ltot)[128 + cp], t2 = ((const LAS f32x2_*)Ltot)[256 + cp], t3 = ((const LAS f32x2_*)Ltot)[384 + cp];
          const float o1x = t0.x, o2x = t0.x + t1.x, o3x = o2x + t2.x, o1y = t0.y, o2y = t0.y + t1.y, o3y = o2y + t2.y;
          bl0 = o3x + t3.x; bl1 = o3y + t3.y;
          const float off0 = qtr == 0 ? 0.f : qtr == 1 ? o1x : qtr == 2 ? o2x : o3x, off1 = qtr == 0 ? 0.f : qtr == 1 ? o1y : qtr == 2 ? o2y : o3y;
#pragma unroll
          for (int i = 0; i < 16; ++i) { b0[i] = off0 + b0[i]; b1[i] = off1 + b1[i]; } }
        LAS unsigned* ke = (LAS unsigned*)(lds + GL_KE + h * 8192 + (d >> 5) * 4096 + (d & 31) * 2);
        {
#pragma unroll
          for (int i = 0; i < 16; ++i) { const int t = qtr * 16 + i; ke[t * 16] = pk2(bflo(kraw[i]) * __expf(bl0 - b0[i]), bfhi(kraw[i]) * __expf(bl1 - b1[i])); }
#pragma unroll
          for (int i = 0; i < 16; ++i) { f32x2_ t_; t_.x = b0[i]; t_.y = b1[i]; *(f32x2_*)(BC + (size_t)(row0 + qtr * 16 + i) * 256 + ch) = t_; } }
        if (qtr == 3) { f32x2_ t_; t_.x = __expf(bl0); t_.y = __expf(bl1); *(f32x2_*)(DEC + ((size_t)(b * 4 + h) * 128 + c) * 64 + d) = t_; }
        asm volatile("s_waitcnt vmcnt(0)" ::: "memory"); LDS_WAIT(); __syncthreads();
        { const int hw = wave >> 1, nb = wave & 1;
          const unsigned lo_ = ((lane >> 4) & 1) * 32 + (lane & 3) * 8 + (8 * hi + ((lane & 15) >> 2)) * 64;
          const LAS unsigned char* kb = lds + GL_KE + hw * 8192 + nb * 4096 + lo_; const LAS unsigned char* vb = lds + GL_V + hw * 16384 + lo_;
          bf16x8 kf[4];
#pragma unroll
          for (int ks = 0; ks < 4; ++ks) { const s16x4 a = vtr(kb + ks * 1024), bq = vtr(kb + ks * 1024 + 256); kf[ks] = (bf16x8){a[0], a[1], a[2], a[3], bq[0], bq[1], bq[2], bq[3]}; }
          bf16* dsb = DS + ((size_t)(b * 4 + hw) * 128 + c) * 8192 + (size_t)r32 * 64 + nb * 32;
#pragma unroll
          for (int mb = 0; mb < 4; ++mb) { f32x16 acc = (f32x16){};
#pragma unroll
              for (int ks = 0; ks < 4; ++ks) { const s16x4 a = vtr(vb + mb * 4096 + ks * 1024), bq = vtr(vb + mb * 4096 + ks * 1024 + 256); const bf16x8 vf = {a[0], a[1], a[2], a[3], bq[0], bq[1], bq[2], bq[3]};
                  acc = __builtin_amdgcn_mfma_f32_32x32x16_bf16(kf[ks], vf, acc, 0, 0, 0); }
#pragma unroll
              for (int rg = 0; rg < 4; rg += 2) { v2u w, w2; w.x = cvtpk(acc[4 * rg], acc[4 * rg + 1]); w.y = cvtpk(acc[4 * rg + 2], acc[4 * rg + 3]); w2.x = cvtpk(acc[4 * rg + 4], acc[4 * rg + 5]); w2.y = cvtpk(acc[4 * rg + 6], acc[4 * rg + 7]);
                  st_pair16(dsb + (size_t)mb * 32 * 64 + 8 * rg, hi, w, w2); } } }
        __syncthreads();
    }
}
__device__ __forceinline__ void ph_gla_scan(Frame& F) {
    const bf16* __restrict__ DS = WSP(bf16, WS_DS); const float* __restrict__ DEC = WSP(float, WS_DEC); bf16* __restrict__ SP = WSP(bf16, WS_SP);
    typedef float f32x2_ __attribute__((ext_vector_type(2)));
    constexpr int NB_ = 32;
    if (F.tid >= 256) return;
#pragma unroll 1
    for (int i = blockIdx.x * 256 + F.tid; i < 16 * 128 * 32; i += F.G * 256) { const int dp = i & 31, e = (i >> 5) & 127, bh = i >> 12;
        const bf16* dsp = DS + (size_t)bh * 128 * 8192 + e * 64 + 2 * dp; const float* dcp = DEC + (size_t)bh * 128 * 64 + 2 * dp; bf16* spp = SP + (size_t)bh * 128 * 8192 + e * 64 + 2 * dp;
        float S0 = 0.f, S1 = 0.f; unsigned ds[NB_]; f32x2_ dc[NB_];
#pragma unroll
        for (int k = 0; k < NB_; ++k) { ds[k] = *(const unsigned*)(dsp + (size_t)k * 8192); dc[k] = *(const f32x2_*)(dcp + k * 64); }
#pragma unroll 1
        for (int c0 = 0; c0 < 128; c0 += NB_) { unsigned dn[NB_]; f32x2_ cn[NB_]; const int cn0 = c0 + NB_ < 128 ? c0 + NB_ : c0;
#pragma unroll
            for (int k = 0; k < NB_; ++k) { dn[k] = *(const unsigned*)(dsp + (size_t)(cn0 + k) * 8192); cn[k] = *(const f32x2_*)(dcp + (cn0 + k) * 64); }
#pragma unroll
            for (int k = 0; k < NB_; ++k) { *(unsigned*)(spp + (size_t)(c0 + k) * 8192) = pg8::cvt_pk_bf16(S0, S1); S0 = dc[k].x * S0 + bflo(ds[k]); S1 = dc[k].y * S1 + bfhi(ds[k]); }
#pragma unroll
            for (int k = 0; k < NB_; ++k) { ds[k] = dn[k]; dc[k] = cn[k]; } } }
}
__device__ __forceinline__ void ph_gla_out(Frame& F) {
    const bf16* __restrict__ PA = WSP(bf16, WS_R1); const float* __restrict__ BC = WSP(float, WS_BC); const bf16* __restrict__ SP = WSP(bf16, WS_SP); bf16* __restrict__ CAT = WSP(bf16, WS_CAT); const float* __restrict__ gh = in_ptr(I_AGHEAD);
    const int lane = F.lane, wave = F.wave, r32 = lane & 31, hi = lane >> 5;
    LAS unsigned char* lds = F.lds;
    typedef unsigned u32x4_t __attribute__((ext_vector_type(4)));
#pragma unroll 1
    for (int u = blockIdx.x; u < 512; u += F.G) {
        const int b = u >> 7, c = u & 127, row0 = b * T + c * 64, h = wave >> 1, tb = wave & 1, t = 32 * tb + r32;
        gla_dma_v(PA, row0, lds, wave, lane);
        u32x4_t qw[4]; f32x4 qb[4][2];
#pragma unroll
        for (int ks = 0; ks < 4; ++ks) { qw[ks] = *(const u32x4_t*)(PA + (size_t)(row0 + t) * NPA + PA_Q + h * 64 + 16 * ks + 8 * hi); const f32x4* bp = (const f32x4*)(BC + (size_t)(row0 + t) * 256 + h * 64 + 16 * ks + 8 * hi); qb[ks][0] = bp[0]; qb[ks][1] = bp[1]; }
        u32x4_t kw[4]; f32x4 kb[4][2];
#pragma unroll
        for (int ks = 0; ks < 4; ++ks) { kw[ks] = *(const u32x4_t*)(PA + (size_t)(row0 + r32) * NPA + PA_K + h * 64 + 16 * ks + 8 * hi); const f32x4* bp = (const f32x4*)(BC + (size_t)(row0 + r32) * 256 + h * 64 + 16 * ks + 8 * hi); kb[ks][0] = bp[0]; kb[ks][1] = bp[1]; }
        bf16x8 qr[4];
#pragma unroll
        for (int ks = 0; ks < 4; ++ks) { const u32x4_t w = qw[ks]; const f32x4 b0 = qb[ks][0], b1 = qb[ks][1];
            u32x4_t o_; o_.x = cvtpk(bflo(w.x) * 0.125f * __expf(b0.x), bfhi(w.x) * 0.125f * __expf(b0.y)); o_.y = cvtpk(bflo(w.y) * 0.125f * __expf(b0.z), bfhi(w.y) * 0.125f * __expf(b0.w));
            o_.z = cvtpk(bflo(w.z) * 0.125f * __expf(b1.x), bfhi(w.z) * 0.125f * __expf(b1.y)); o_.w = cvtpk(bflo(w.w) * 0.125f * __expf(b1.z), bfhi(w.w) * 0.125f * __expf(b1.w));
            qr[ks] = __builtin_bit_cast(bf16x8, o_); }
        f32x16 pT[2]; pT[0] = (f32x16){}; pT[1] = (f32x16){};
#pragma unroll
        for (int sb = 0; sb < 2; ++sb) { if (sb > tb) continue;
            bf16x8 kf[4];
#pragma unroll
            for (int ks = 0; ks < 4; ++ks) { const u32x4_t w = kw[ks]; const f32x4 b0 = kb[ks][0], b1 = kb[ks][1];
                u32x4_t o_; o_.x = cvtpk(bflo(w.x) * __expf(-b0.x), bfhi(w.x) * __expf(-b0.y)); o_.y = cvtpk(bflo(w.y) * __expf(-b0.z), bfhi(w.y) * __expf(-b0.w));
                o_.z = cvtpk(bflo(w.z) * __expf(-b1.x), bfhi(w.z) * __expf(-b1.y)); o_.w = cvtpk(bflo(w.w) * __expf(-b1.z), bfhi(w.w) * __expf(-b1.w));
                kf[ks] = __builtin_bit_cast(bf16x8, o_); }
            if (sb == 0 && tb == 1) {
#pragma unroll
                for (int ks = 0; ks < 4; ++ks) { kw[ks] = *(const u32x4_t*)(PA + (size_t)(row0 + 32 + r32) * NPA + PA_K + h * 64 + 16 * ks + 8 * hi); const f32x4* bp = (const f32x4*)(BC + (size_t)(row0 + 32 + r32) * 256 + h * 64 + 16 * ks + 8 * hi); kb[ks][0] = bp[0]; kb[ks][1] = bp[1]; } }
#pragma unroll
            for (int ks = 0; ks < 4; ++ks) pT[sb] = __builtin_amdgcn_mfma_f32_32x32x16_bf16(kf[ks], qr[ks], pT[sb], 0, 0, 0);
            if (sb == tb) {
#pragma unroll
                for (int r = 0; r < 16; ++r) pT[sb][r] = (crow(r, hi) <= r32) ? pT[sb][r] : 0.f; } }
        bf16x8 pa[4]; pack_p(pa, pT[0], pT[1]);
        f32x16 o[4];
        const bf16* spb = SP + ((size_t)(b * 4 + h) * 128 + c) * 8192 + (size_t)r32 * 64 + 8 * hi;
        { bf16x8 sf[4][4];
#pragma unroll
          for (int eb = 0; eb < 4; ++eb)
#pragma unroll
            for (int ks = 0; ks < 4; ++ks) sf[eb][ks] = *(const bf16x8*)(spb + (size_t)eb * 32 * 64 + 16 * ks);
#pragma unroll
          for (int eb = 0; eb < 4; ++eb) { o[eb] = (f32x16){};
#pragma unroll
            for (int ks = 0; ks < 4; ++ks) o[eb] = __builtin_amdgcn_mfma_f32_32x32x16_bf16(sf[eb][ks], qr[ks], o[eb], 0, 0, 0); } }
        const bf16* rp = PA + (size_t)(row0 + t) * NPA + PA_R + h * 128;
        v4u rw4[4][2];
#pragma unroll
        for (int eb = 0; eb < 4; ++eb)
#pragma unroll
            for (int rp2 = 0; rp2 < 2; ++rp2) rw4[eb][rp2] = *(const v4u*)(rp + 32 * eb + 16 * rp2 + 8 * hi);
        asm volatile("s_waitcnt vmcnt(0)" ::: "memory"); __syncthreads();
        { s16x4 vl[2][4], vh[2][4]; vfrag_issue<2>(vl, vh, lds + GL_V + h * 16384, lane); pv_frag<2>(o, vl, vh, pa);
          s16x4 vl2[2][4], vh2[2][4]; vfrag_issue<2>(vl2, vh2, lds + GL_V + h * 16384 + 8192, lane); pv_frag<2>(o + 2, vl2, vh2, pa); }
        float ss = 0.f;
#pragma unroll
        for (int eb = 0; eb < 4; ++eb)
#pragma unroll
            for (int r = 0; r < 16; ++r) ss += o[eb][r] * o[eb][r];
        ss += __shfl_xor(ss, 32);
        const float rs = __builtin_amdgcn_rsqf(ss * (1.0f / 128.0f) + 1e-6f);
        bf16* op = CAT + (size_t)(row0 + t) * 1024 + h * 128;
        v2u rw[4][4];
#pragma unroll
        for (int eb = 0; eb < 4; ++eb)
#pragma unroll
            for (int rp2 = 0; rp2 < 2; ++rp2) { const v4u w4 = rw4[eb][rp2];
                const auto r0 = __builtin_amdgcn_permlane32_swap(w4.x, w4.z, false, false); const auto r1 = __builtin_amdgcn_permlane32_swap(w4.y, w4.w, false, false);
                rw[eb][2 * rp2].x = r0[0]; rw[eb][2 * rp2].y = r1[0]; rw[eb][2 * rp2 + 1].x = r0[1]; rw[eb][2 * rp2 + 1].y = r1[1]; }
        f32x4 gv[4][4];
#pragma unroll
        for (int eb = 0; eb < 4; ++eb)
#pragma unroll
            for (int rg = 0; rg < 4; ++rg) gv[eb][rg] = *(const f32x4*)(gh + 32 * eb + 8 * rg + 4 * hi);
#pragma unroll
        for (int eb = 0; eb < 4; ++eb)
#pragma unroll
            for (int rg = 0; rg < 4; rg += 2) { v2u wp[2];
#pragma unroll
                for (int k = 0; k < 2; ++k) { const v2u w_ = rw[eb][rg + k]; const f32x4 g_ = gv[eb][rg + k]; const int r_ = 4 * (rg + k);
                    const float r0 = bflo(w_.x), r1 = bfhi(w_.x), r2 = bflo(w_.y), r3 = bfhi(w_.y);
                    const float y0 = o[eb][r_] * rs * g_.x * (r0 * pg8::sigmoid_f(r0)), y1 = o[eb][r_ + 1] * rs * g_.y * (r1 * pg8::sigmoid_f(r1)), y2 = o[eb][r_ + 2] * rs * g_.z * (r2 * pg8::sigmoid_f(r2)), y3 = o[eb][r_ + 3] * rs * g_.w * (r3 * pg8::sigmoid_f(r3));
                    wp[k].x = cvtpk(y0, y1); wp[k].y = cvtpk(y2, y3); }
                st_pair16(op + 32 * eb + 8 * rg, hi, wp[0], wp[1]); }
        __syncthreads();
    }
}
__device__ __forceinline__ void ph_ffn_fix(Frame& F, int layer) {
    typedef float f32x2_ __attribute__((ext_vector_type(2)));
    const float* __restrict__ bndA = WSP(float, WS_BND); const float* __restrict__ bndHA = WSP(float, WS_BND + BND_ONE); const float* __restrict__ bndHB = WSP(float, WS_BND + 2 * BND_ONE); bf16* __restrict__ H = WSP(bf16, WS_R1);
    const float* __restrict__ cw = in_ptr(I_CONVW) + (size_t)layer * 3 * FF; const float* __restrict__ cb = in_ptr(I_CONVB) + (size_t)layer * FF;
    const int gt = blockIdx.x * 512 + F.tid, NT = F.G * 512; constexpr int FP = FF / 2, NE = 512 * 2 * FP;
#pragma unroll 1
    for (int i0 = gt; i0 < NE; i0 += 4 * NT) {
        f32x2_ a0[4], pm1[4], pm2[4], h0[4], hb[4], w0[4], w1[4], w2[4], c0[4]; int fr_[4], G_[4], f_[4]; bool ok[4], first[4];
#pragma unroll
        for (int j = 0; j < 4; ++j) { const int idx = i0 + j * NT; ok[j] = idx < NE; const int id = ok[j] ? idx : 0; const int f = 2 * (id % FP), gr = id / FP, G = gr >> 1, fr = gr & 1; f_[j] = f; G_[j] = G; fr_[j] = fr; first[j] = (G & 127) == 0;
            const int Gp = first[j] ? G : G - 1; const size_t e = (size_t)gr * FF + f;
            a0[j] = *(const f32x2_*)(bndHA + e); hb[j] = *(const f32x2_*)(bndHB + e); pm1[j] = *(const f32x2_*)(bndA + ((size_t)Gp * 2 + 1) * FF + f); pm2[j] = *(const f32x2_*)(bndA + ((size_t)Gp * 2 + 0) * FF + f); h0[j] = *(const f32x2_*)(bndHA + ((size_t)G * 2) * FF + f);
            w0[j] = *(const f32x2_*)(cw + f); w1[j] = *(const f32x2_*)(cw + FF + f); w2[j] = *(const f32x2_*)(cw + 2 * FF + f); c0[j] = *(const f32x2_*)(cb + f); }
#pragma unroll
        for (int j = 0; j < 4; ++j) { if (!ok[j]) continue; float hv[2];
#pragma unroll
            for (int e = 0; e < 2; ++e) { const float p1 = first[j] ? 0.f : pm1[j][e], p2 = first[j] ? 0.f : pm2[j][e];
                const float a1 = fr_[j] ? h0[j][e] : p1, a2 = fr_[j] ? p1 : p2;
                const float cv = w0[j][e] * a2 + w1[j][e] * a1 + w2[j][e] * a0[j][e] + c0[j][e];
                hv[e] = cv / (1.0f + __expf(-cv)) * hb[j][e]; }
            *(unsigned*)(H + (size_t)(G_[j] * 64 + fr_[j]) * FF + f_[j]) = pk2(hv[0], hv[1]); }
    }
}
__device__ __forceinline__ void ph_cmp2(Frame& F) {
    const bf16* CH = WSP(bf16, WS_CH); bf16* KC = WSP(bf16, WS_KCMP); const bf16* W2 = WSP(bf16, WS_WC2);
    const int gw = blockIdx.x * NWAVES + F.wave, NGW = F.G * NWAVES, lane = F.lane, r32 = lane & 31, hi = lane >> 5;
#pragma unroll 1
    for (int u = gw; u < 512; u += NGW) { const int cb = u & 1, rb = (u >> 1) & 127, mlp = u >> 8;
        const bf16* ap = W2 + (size_t)(mlp * 64 + 32 * cb + r32) * 256 + 8 * hi; const bf16* bp = CH + ((size_t)mlp * 4096 + 32 * rb + r32) * 256 + 8 * hi;
        f32x16 acc = (f32x16){};
#pragma unroll
        for (int ks = 0; ks < 16; ++ks) acc = __builtin_amdgcn_mfma_f32_32x32x16_bf16(*(const bf16x8*)(ap + 16 * ks), *(const bf16x8*)(bp + 16 * ks), acc, 0, 0, 0);
        bf16* op = KC + ((size_t)mlp * 4096 + 32 * rb + r32) * 64 + 32 * cb;
#pragma unroll
        for (int rg = 0; rg < 4; rg += 2) { v2u w, w2; w.x = cvtpk(acc[4 * rg], acc[4 * rg + 1]); w.y = cvtpk(acc[4 * rg + 2], acc[4 * rg + 3]); w2.x = cvtpk(acc[4 * rg + 4], acc[4 * rg + 5]); w2.y = cvtpk(acc[4 * rg + 6], acc[4 * rg + 7]);
            st_pair16(op + 8 * rg, hi, w, w2); } }
}
__device__ __forceinline__ void ph_final(Frame& F, float* dst) {
    const float* __restrict__ SS = WSP(float, WS_SS); const float* gf = in_ptr(I_GFINAL);
    const int gw = blockIdx.x * NWAVES + F.wave, NGW = F.G * NWAVES, lane = F.lane;
    const bf16* __restrict__ XBp = WSP(bf16, WS_XB);
    f32x4 g[4];
#pragma unroll
    for (int j = 0; j < 4; ++j) g[j] = *((const f32x4*)gf + lane + 64 * j);
#pragma unroll 1
    for (int m0 = gw; m0 < M; m0 += 4 * NGW) {
        v2u xw[4][4]; f32x4 sv[4];
#pragma unroll
        for (int q = 0; q < 4; ++q) { const int m = (m0 + q * NGW) < M ? (m0 + q * NGW) : (M - 1); sv[q] = *(const f32x4*)(SS + (size_t)m * 16 + 4 * (lane & 3));
#pragma unroll
            for (int j = 0; j < 4; ++j) xw[q][j] = *((const GAS v2u*)(XBp + (size_t)m * D) + lane + 64 * j); }
#pragma unroll
        for (int q = 0; q < 4; ++q) { const int m = m0 + q * NGW; if (m >= M) break;
            float ssum = (sv[q].x + sv[q].y) + (sv[q].z + sv[q].w); ssum += __shfl_xor(ssum, 1); ssum += __shfl_xor(ssum, 2);
            const float rs = __builtin_amdgcn_rsqf(ssum * (1.0f / 1024.0f) + pg8::RMS_EPS);
#pragma unroll
            for (int j = 0; j < 4; ++j) { f32x4 o; o.x = bflo(xw[q][j].x) * rs * g[j].x; o.y = bfhi(xw[q][j].x) * rs * g[j].y; o.z = bflo(xw[q][j].y) * rs * g[j].z; o.w = bfhi(xw[q][j].y) * rs * g[j].w;
                ((GAS f32x4*)(dst + (size_t)m * D) + lane)[64 * j] = o; } }
    }
}

#ifndef MK_PHASE_LAUNCHES
#define MK_PHASE_LAUNCHES 0
#endif
constexpr int N_PHASES = 18;
#ifndef PH_MASK
#define PH_MASK 0x3ffff
#endif
#define PH_ON(k) (((PH_MASK) >> (k)) & 1)
struct Args { const float* in[26]; float* out; unsigned char* ws; int ph_lo, ph_hi; };
__global__ void __launch_bounds__(NWAVES * 64, 2) yoco_fwd(Args args) {
    extern __shared__ __attribute__((aligned(16))) unsigned char lds[];
    Frame F;
    F.lds = (LAS unsigned char*)lds;
    F.MISC = (volatile LAS unsigned*)(F.lds + MISC_OFF);
    F.tid = threadIdx.x; F.lane = F.tid & 63; F.wave = __builtin_amdgcn_readfirstlane(F.tid >> 6);
    F.G = gridDim.x;
    F.out = args.out; F.ws = args.ws; F.ctl = (gu32*)(args.ws + WS_CTL);
    for (int u = F.tid; u < (LDS_BYTES - LDSCTL_OFF) / 4; u += NWAVES * 64) ((LAS unsigned*)(F.lds + LDSCTL_OFF))[u] = 0u;
    __syncthreads();
    XcdBarrier bar; bar.bar = (unsigned*)(F.ctl + CW_BAR); bar.x = 0; bar.st = nullptr;
    if (!MK_PHASE_LAUNCHES) bar = xcd_barrier_post((unsigned*)(F.ctl + CW_BAR), F.MISC + 8);
    using pg8::Gemm; using pg8::StaticOrder;
    const int bx = (int)blockIdx.x;
#pragma unroll 1
    for (int p = args.ph_lo; p < args.ph_hi; ++p) {
        { int t_ = threadIdx.x; asm volatile("" : "+v"(t_)); F.tid = t_; F.lane = t_ & 63; F.wave = __builtin_amdgcn_readfirstlane(t_ >> 6); }
        { GAS unsigned char* w_ = (GAS unsigned char*)args.ws; int g_ = gridDim.x; asm volatile("" : "+s"(w_), "+s"(g_)); F.ws = (unsigned char*)w_; F.G = g_; }
        bf16* const XB = WSP(bf16, WS_XB); bf16* const CAT = WSP(bf16, WS_CAT); float* const SS = WSP(float, WS_SS); bf16* const R1 = WSP(bf16, WS_R1);
        switch (p) {
        case 0: if (PH_ON(0)) p0_prologue(F); break;
        case 1:
#pragma unroll 1
            for (int s = 0; s < 2 * PH_ON(1); ++s) {
                Gemm g = s ? Gemm{WSP(bf16, WS_MEMB), WSP(bf16, WS_WM), MROWS, 2048, D, D} : Gemm{XB, WSP(bf16, WS_WA), M, NPA, D, D};
                StaticOrder S; S.init(g.M, g.N, F.G, s ? (bx + 128) % F.G : bx);
                pg8::EpiScaleBf16 E = s ? pg8::EpiScaleBf16{WSP(bf16, WS_MKV), 2048, WSP(float, WS_SSM), 0, 0, 1.0f} : pg8::EpiScaleBf16{R1, NPA, SS, PA_MQ / 256, PA_MQ / 256 + 2, MEM_QSCALE};
                pg8::gemm_phase<pg8::EpiScaleBf16, StaticOrder, true, true>(F.lds, g, S, E);
            }
            if (PH_ON(1) && F.G == 256 && bx >= 160) tr_items(F, (LAS float*)(F.lds + F.wave * 16384), (bx - 160) * NWAVES + F.wave, 96 * NWAVES, TR_NP0, TR_NITEMS, F.lane);
            if (PH_ON(1) && bx == F.G - 1) bias1_reduce(F);
            break;
        case 2: if (PH_ON(2)) { ph_gla_local(F); ph_memattn_mfma(F, R1, NPA, PA_MQ, 0, bx, F.G); } break;
        case 3: if (PH_ON(3)) ph_gla_scan(F); break;
        case 4: if (PH_ON(4)) ph_gla_out(F); break;
        case 5: case 8: case 13: case 16: if (PH_ON(5)) {
            const bool ffn = (p == 8 || p == 16); const int layer = p > 8 ? 1 : 0;
            Gemm g = ffn ? Gemm{R1, WSP(bf16, WS_WD) + (size_t)layer * D * FF, M, D, FF, FF} : Gemm{CAT, WSP(bf16, layer ? WS_WOB : WS_WOA), M, D, D, D};
            StaticOrder S; S.init(M, D, F.G, bx);
            if (p == 16 && F.G == 256) {
                pg8::EpiFinal E{XB, SS, F.out, in_ptr(I_GFINAL), (unsigned*)(F.ctl + CW_PANEL)};
                pg8::gemm_phase<pg8::EpiFinal, StaticOrder, true, true>(F.lds, g, S, E);
                break; }
            pg8::EpiResid E{XB, SS};
            pg8::gemm_phase<pg8::EpiResid, StaticOrder, true, true>(F.lds, g, S, E);
            break; }
        case 6: case 14: if (PH_ON(6)) {
            const int layer = p == 14 ? 1 : 0;
            Gemm g{XB, WSP(bf16, WS_WU) + (size_t)layer * 2 * FF * D, M, 2 * FF, D, D}; StaticOrder S; S.init(M, 2 * FF, F.G, bx);
            pg8::EpiUp E{R1, SS, in_ptr(I_CONVW) + (size_t)layer * 3 * FF, in_ptr(I_CONVB) + (size_t)layer * FF, WSP(float, WS_BND), WSP(float, WS_BND + BND_ONE), WSP(float, WS_BND + 2 * BND_ONE)};
            pg8::gemm_phase<pg8::EpiUp, StaticOrder, true, true>(F.lds, g, S, E);
            break; }
        case 7: case 15: if (PH_ON(7)) ph_ffn_fix(F, p == 15 ? 1 : 0); break;
        case 9: if (PH_ON(9)) {
            Gemm g{XB, WSP(bf16, WS_WB), M, NG5, D, D}; StaticOrder S; S.init(M, NG5, F.G, bx); pg8::EpiProjB E{WSP(bf16, WS_KVC), R1, SS};
            pg8::gemm_phase<pg8::EpiProjB, StaticOrder, true, true>(F.lds, g, S, E);
            break; }
        case 10:
#pragma unroll 1
            for (int s = 0; s < 2 * PH_ON(10); ++s) {
                Gemm g{WSP(bf16, WS_KVC) + (size_t)s * KVSTRIDE, WSP(bf16, WS_WC1) + (size_t)s * 256 * 2048, 4096, 256, 2048, 1024};
                StaticOrder S; S.init(4096, 256, F.G, s ? (bx + 240) % F.G : bx);
                pg8::EpiGelu E{WSP(bf16, WS_CH) + (size_t)s * 4096 * 256, WSP(float, WS_BIAS1) + s * 256};
                pg8::gemm_phase<pg8::EpiGelu, StaticOrder, true, true>(F.lds, g, S, E);
            }
            __syncthreads();
            if (PH_ON(10)) { if (F.G > 64) { if (bx >= 32) ph_memattn_mfma(F, R1, NPB, PB_MQ, 1, bx - 32, F.G - 32); }
                             else ph_memattn_mfma(F, R1, NPB, PB_MQ, 1, bx, F.G); }
            break;
        case 11: if (PH_ON(11)) ph_cmp2(F); break;
        case 12: if (PH_ON(12)) ph_nsa_mfma(F); break;
        case 17: if (PH_ON(17) && F.G != 256) ph_final(F, F.out); break;
        default: break;
        }
        if (p + 1 < args.ph_hi && !(p == 16 && F.G == 256)) xcd_barrier(bar);
    }
}

extern "C" void kernel_launch(void* const* d_in, const int* in_sizes, int n_in, void* d_out, int out_size, void* d_ws, size_t ws_size, hipStream_t stream) {
    static int grid = 0;
    if (grid == 0) {
        if (n_in != 26 || in_sizes[0] != M * D || out_size != M * D || ws_size < WS_END) { fprintf(stderr, "kernel_launch: unexpected shapes (n_in %d, in0 %d, out %d, ws %zu); nothing launched\n", n_in, n_in > 0 ? in_sizes[0] : -1, out_size, ws_size); grid = -1; return; }
        int dev = 0, cus = 0, per_cu = 0;
        if (hipGetDevice(&dev) != hipSuccess || hipDeviceGetAttribute(&cus, hipDeviceAttributeMultiprocessorCount, dev) != hipSuccess) { grid = -1; return; }
        if (hipFuncSetAttribute((const void*)yoco_fwd, hipFuncAttributeMaxDynamicSharedMemorySize, LDS_BYTES) != hipSuccess) { fprintf(stderr, "kernel_launch: hipFuncSetAttribute failed\n"); grid = -1; return; }
        if (hipOccupancyMaxActiveBlocksPerMultiprocessor(&per_cu, (const void*)yoco_fwd, NWAVES * 64, LDS_BYTES) != hipSuccess || per_cu < 1) { fprintf(stderr, "kernel_launch: occupancy query reports %d blocks per CU\n", per_cu); (void)hipGetLastError(); grid = -1; return; }
        grid = cus;
        if (grid > 256) grid = 256;
    }
    if (grid < 0) return;
    (void)hipMemsetAsync((char*)d_ws + WS_CTL, 0, CTL_ZERO_BYTES, stream);
    Args a{};
    for (int i = 0; i < 26; ++i) a.in[i] = (const float*)d_in[i];
    a.out = (float*)d_out; a.ws = (unsigned char*)d_ws;
#if MK_PHASE_LAUNCHES
    for (int p = 0; p < N_PHASES; ++p) { a.ph_lo = p; a.ph_hi = p + 1; hipLaunchKernelGGL(yoco_fwd, dim3(grid), dim3(NWAVES * 64), LDS_BYTES, stream, a); }
#else
    a.ph_lo = 0; a.ph_hi = N_PHASES;
    hipLaunchKernelGGL(yoco_fwd, dim3(grid), dim3(NWAVES * 64), LDS_BYTES, stream, a);
#endif
    const hipError_t le = hipPeekAtLastError();
    if (le != hipSuccess) fprintf(stderr, "kernel_launch: launch failed: %s\n", hipGetErrorName(le));
}
```

```cpp
#include <hip/hip_runtime.h>
#include <cstdio>
#include <cstdint>
namespace pg8 {
#define PG8_LAS __attribute__((address_space(3)))
typedef unsigned short bf16_t;
typedef short bf16x8 __attribute__((ext_vector_type(8)));
typedef float f32x4 __attribute__((ext_vector_type(4)));
typedef unsigned u32x4 __attribute__((ext_vector_type(4)));
typedef unsigned u32x2 __attribute__((ext_vector_type(2)));
constexpr int BM = 256, BK = 64, HALF = 128, HTB = HALF * BK * 2  , STAGE_BYTES = 8 * HTB, NXCD = 8, WGM = 8;

__host__ __device__ __forceinline__ int lds_byte(int r, int c) { const int st = (r >> 4) * 2 + (c >> 5), rr = r & 15, cc = c & 31, ob = rr * 64 + cc * 2; return st * 1024 + (ob ^ (((ob >> 9) & 1) << 5)); }
__host__ __device__ __forceinline__ void stage_rc(int b, int& R, int& C) { const int st = b / 1024, sb = b % 1024, swz = sb ^ (((sb >> 9) & 1) << 5); R = (st >> 1) * 16 + swz / 64; C = (st & 1) * 32 + (swz % 64) / 2; }
__host__ __device__ __forceinline__ int perm32(int rho) { const int n = rho >> 4, i = rho & 15; return 8 * (i >> 2) + 4 * n + (i & 3); }

struct Unit { int pm, pn; };
struct Gemm { const bf16_t* A; const bf16_t* Bt; int M, N, K, lda; };

struct StaticOrder {
    int nM, nN, nwg, G, c;
    __host__ __device__ void init(int M, int N, int G_, int c_) { nM = M / BM; nN = N / BM; nwg = nM * nN; G = G_; c = c_; }
    __host__ __device__ bool next(int i, Unit& u) const {
        const long L = (long)i * G + c; if (L >= nwg) return false;
        int wgid = (int)L; { const int q = nwg / NXCD, r = nwg % NXCD, xcd = wgid % NXCD, off = wgid / NXCD; wgid = (xcd < r ? xcd * (q + 1) : r * (q + 1) + (xcd - r) * q) + off; }
        const int nig = WGM * nN, gid = wgid / nig, fm = gid * WGM, gsz = (nM - fm) < WGM ? (nM - fm) : WGM;
        u.pm = fm + ((wgid % nig) % gsz); u.pn = (wgid % nig) / gsz; return true;
    }
    __device__ __forceinline__ void a_ready(const Unit&) const {}
    __device__ __forceinline__ void done(const Unit&) const {}
};


typedef float f32x2c __attribute__((ext_vector_type(2))); typedef __bf16 bf16x2c __attribute__((ext_vector_type(2)));
__device__ __forceinline__ unsigned cvt_pk_bf16(float lo, float hi) { const f32x2c v = {lo, hi}; return __builtin_bit_cast(unsigned, __builtin_convertvector(v, bf16x2c)); }
constexpr float RMS_EPS = 1e-6f;
__device__ __forceinline__ float rstd_row(const float* SS, int row) {
    const f32x4* p = (const f32x4*)(SS + (size_t)row * 16); const f32x4 a = p[0], b = p[1], c = p[2], d = p[3];
    const float s = (((a.x + a.y) + (a.z + a.w)) + ((b.x + b.y) + (b.z + b.w))) + (((c.x + c.y) + (c.z + c.w)) + ((d.x + d.y) + (d.z + d.w)));
    return 1.0f / sqrtf(s * (1.0f / 1024.0f) + RMS_EPS);
}
__device__ __forceinline__ float sigmoid_f(float x) { return __builtin_amdgcn_rcpf(1.0f + __expf(-x)); }

__device__ __forceinline__ void rstd8(float (&rs)[2][4], const char* ssb0  , unsigned ls  , int lane) {
    f32x4 a[8];
#pragma unroll
    for (int i = 0; i < 8; ++i) a[i] = *(const f32x4*)(ssb0 + (size_t)((i >> 2) * HALF + (i & 3) * 16) * 64 + ls);
    float sv[8], tv[8];
#pragma unroll
    for (int i = 0; i < 8; ++i) sv[i] = (a[i].x + a[i].y) + (a[i].z + a[i].w);
    const int x16 = (lane ^ 16) * 4, x32 = (lane ^ 32) * 4;
#pragma unroll
    for (int i = 0; i < 8; ++i) tv[i] = __int_as_float(__builtin_amdgcn_ds_bpermute(x16, __float_as_int(sv[i])));
#pragma unroll
    for (int i = 0; i < 8; ++i) sv[i] += tv[i];
#pragma unroll
    for (int i = 0; i < 8; ++i) tv[i] = __int_as_float(__builtin_amdgcn_ds_bpermute(x32, __float_as_int(sv[i])));
#pragma unroll
    for (int i = 0; i < 8; ++i) rs[i >> 2][i & 3] = __builtin_amdgcn_rsqf((sv[i] + tv[i]) * (1.0f / 1024.0f) + RMS_EPS);
}
__device__ __forceinline__ u32x4 pack8(const f32x4 v0, const f32x4 v1) { u32x4 w; w.x = cvt_pk_bf16(v0[0], v0[1]); w.y = cvt_pk_bf16(v0[2], v0[3]); w.z = cvt_pk_bf16(v1[0], v1[1]); w.w = cvt_pk_bf16(v1[2], v1[3]); return w; }

struct EpiScaleBf16 {
    static constexpr bool PERM = true, AFTER_DRAIN = false;
    bf16_t* O; int ldc; const float* SS; int sc_from, sc_to; float sc;
    __device__ __forceinline__ void operator()(f32x4 (&acc)[2][2][4][2], const Unit& u, int wr, int wc, int fr, int fq) const {
        asm volatile("" : "+v"(fr), "+v"(fq));
        const unsigned lrow = wr * 64 + fr; const unsigned lo = lrow * (unsigned)ldc * 2u + (unsigned)(wc * 32 + 8 * fq) * 2u, ls = lrow * 64u + (unsigned)fq * 16u;
        float rs[2][4]; rstd8(rs, (const char*)SS + (size_t)(u.pm * BM) * 64, ls, fr + 16 * fq);
        const float xs = (u.pn >= sc_from && u.pn < sc_to) ? sc : 1.0f;
#pragma unroll
        for (int ai = 0; ai < 2; ++ai)
#pragma unroll
            for (int m = 0; m < 4; ++m) { const int urow = u.pm * BM + ai * HALF + m * 16; char* ob = (char*)O + ((size_t)urow * ldc + u.pn * BM) * 2; const float r_ = rs[ai][m] * xs;
#pragma unroll
                for (int bj = 0; bj < 2; ++bj) *(u32x4*)(ob + lo + bj * HALF * 2) = pack8(acc[ai][bj][m][0] * r_, acc[ai][bj][m][1] * r_); }
    }
};

struct EpiResid {
    static constexpr bool PERM = true, AFTER_DRAIN = false;
    bf16_t* xb; float* SS;
    __device__ __forceinline__ void operator()(f32x4 (&acc)[2][2][4][2], const Unit& u, int wr, int wc, int fr, int fq) const {
        asm volatile("" : "+v"(fr), "+v"(fq));
        const unsigned lrow = wr * 64 + fr; const unsigned lo = lrow * 2048u + (unsigned)(wc * 32 + 8 * fq) * 2u, ls = lrow * 64u + (unsigned)wc * 4u;
        char* const xb0 = (char*)xb + (size_t)(u.pm * BM) * 2048 + (size_t)u.pn * 512;
        u32x4 rw[2][4][2];
#pragma unroll
        for (int ai = 0; ai < 2; ++ai)
#pragma unroll
            for (int m = 0; m < 4; ++m)
#pragma unroll
                for (int bj = 0; bj < 2; ++bj) rw[ai][m][bj] = *(const u32x4*)(xb0 + (size_t)(ai * HALF + m * 16) * 2048 + lo + bj * 256);
#pragma unroll
        for (int ai = 0; ai < 2; ++ai)
#pragma unroll
            for (int m = 0; m < 4; ++m) { const int urow = u.pm * BM + ai * HALF + m * 16; float ssq = 0.f;
#pragma unroll
                for (int bj = 0; bj < 2; ++bj) { const u32x4 r = rw[ai][m][bj];
                    f32x4 o0 = acc[ai][bj][m][0], o1 = acc[ai][bj][m][1];
                    o0[0] += __uint_as_float(r.x << 16); o0[1] += __uint_as_float(r.x & 0xffff0000u); o0[2] += __uint_as_float(r.y << 16); o0[3] += __uint_as_float(r.y & 0xffff0000u);
                    o1[0] += __uint_as_float(r.z << 16); o1[1] += __uint_as_float(r.z & 0xffff0000u); o1[2] += __uint_as_float(r.w << 16); o1[3] += __uint_as_float(r.w & 0xffff0000u);
                    ssq += ((o0[0] * o0[0] + o0[1] * o0[1]) + (o0[2] * o0[2] + o0[3] * o0[3])) + ((o1[0] * o1[0] + o1[1] * o1[1]) + (o1[2] * o1[2] + o1[3] * o1[3]));
                    *(u32x4*)(xb0 + (size_t)(ai * HALF + m * 16) * 2048 + lo + bj * 256) = pack8(o0, o1); }
                ssq += __shfl_xor(ssq, 16); ssq += __shfl_xor(ssq, 32);
                if (fq == 0) *(float*)((char*)SS + (size_t)urow * 64 + u.pn * 16 + ls) = ssq; }
    }
};

struct EpiFinal {
    static constexpr bool PERM = true, AFTER_DRAIN = false;
    const bf16_t* xb; float* SS; float* out; const float* gf; unsigned* cnt;
    __device__ __forceinline__ void operator()(f32x4 (&acc)[2][2][4][2], const Unit& u, int wr, int wc, int fr, int fq) const {
        asm volatile("" : "+v"(fr), "+v"(fq));
        const unsigned lrow = wr * 64 + fr; const unsigned lo = lrow * 2048u + (unsigned)(wc * 32 + 8 * fq) * 2u, ls = lrow * 64u + (unsigned)wc * 4u;
        const char* const xb0 = (const char*)xb + (size_t)(u.pm * BM) * 2048 + (size_t)u.pn * 512;
        u32x4 rw[2][4][2];
#pragma unroll
        for (int ai = 0; ai < 2; ++ai)
#pragma unroll
            for (int m = 0; m < 4; ++m)
#pragma unroll
                for (int bj = 0; bj < 2; ++bj) rw[ai][m][bj] = *(const u32x4*)(xb0 + (size_t)(ai * HALF + m * 16) * 2048 + lo + bj * 256);
#pragma unroll
        for (int ai = 0; ai < 2; ++ai)
#pragma unroll
            for (int m = 0; m < 4; ++m) { const int urow = u.pm * BM + ai * HALF + m * 16; float ssq = 0.f;
#pragma unroll
                for (int bj = 0; bj < 2; ++bj) { const u32x4 r = rw[ai][m][bj];
                    f32x4 o0 = acc[ai][bj][m][0], o1 = acc[ai][bj][m][1];
                    o0[0] += __uint_as_float(r.x << 16); o0[1] += __uint_as_float(r.x & 0xffff0000u); o0[2] += __uint_as_float(r.y << 16); o0[3] += __uint_as_float(r.y & 0xffff0000u);
                    o1[0] += __uint_as_float(r.z << 16); o1[1] += __uint_as_float(r.z & 0xffff0000u); o1[2] += __uint_as_float(r.w << 16); o1[3] += __uint_as_float(r.w & 0xffff0000u);
                    ssq += ((o0[0] * o0[0] + o0[1] * o0[1]) + (o0[2] * o0[2] + o0[3] * o0[3])) + ((o1[0] * o1[0] + o1[1] * o1[1]) + (o1[2] * o1[2] + o1[3] * o1[3]));
                    acc[ai][bj][m][0] = o0; acc[ai][bj][m][1] = o1; }
                ssq += __shfl_xor(ssq, 16); ssq += __shfl_xor(ssq, 32);
                if (fq == 0) __hip_atomic_store((float*)((char*)SS + (size_t)urow * 64 + u.pn * 16 + ls), ssq, __ATOMIC_RELAXED, __HIP_MEMORY_SCOPE_AGENT); }
        asm volatile("s_waitcnt vmcnt(0)" ::: "memory");
        __builtin_amdgcn_s_barrier();
        if ((fr | fq | wr | wc) == 0) { unsigned* c = cnt + u.pm * 16; __hip_atomic_fetch_add(c, 1u, __ATOMIC_RELAXED, __HIP_MEMORY_SCOPE_AGENT);
            for (int spin = 0; spin < (1 << 22) && __hip_atomic_load(c, __ATOMIC_RELAXED, __HIP_MEMORY_SCOPE_AGENT) < 4u; ++spin) __builtin_amdgcn_s_sleep(1); }
        __builtin_amdgcn_s_barrier();
        asm volatile("" ::: "memory");
        const unsigned lq = lrow * 64u + (unsigned)fq * 16u;
        const char* const ssb0 = (const char*)SS + (size_t)(u.pm * BM) * 64;
        unsigned long long pa[8][2];
#pragma unroll
        for (int i = 0; i < 8; ++i) { const unsigned long long* p = (const unsigned long long*)(ssb0 + (size_t)((i >> 2) * HALF + (i & 3) * 16) * 64 + lq);
            pa[i][0] = __hip_atomic_load(p, __ATOMIC_RELAXED, __HIP_MEMORY_SCOPE_AGENT); pa[i][1] = __hip_atomic_load(p + 1, __ATOMIC_RELAXED, __HIP_MEMORY_SCOPE_AGENT); }
        f32x4 gv[2][2];
#pragma unroll
        for (int bj = 0; bj < 2; ++bj) { const char* gp = (const char*)gf + (size_t)u.pn * 1024 + bj * 512 + (unsigned)(wc * 32 + 8 * fq) * 4u; gv[bj][0] = *(const f32x4*)gp; gv[bj][1] = *(const f32x4*)(gp + 16); }
        float sv[8], tv[8];
#pragma unroll
        for (int i = 0; i < 8; ++i) sv[i] = (__uint_as_float((unsigned)pa[i][0]) + __uint_as_float((unsigned)(pa[i][0] >> 32))) + (__uint_as_float((unsigned)pa[i][1]) + __uint_as_float((unsigned)(pa[i][1] >> 32)));
        const int lane = fr + 16 * fq, x16 = (lane ^ 16) * 4, x32 = (lane ^ 32) * 4;
#pragma unroll
        for (int i = 0; i < 8; ++i) tv[i] = __int_as_float(__builtin_amdgcn_ds_bpermute(x16, __float_as_int(sv[i])));
#pragma unroll
        for (int i = 0; i < 8; ++i) sv[i] += tv[i];
#pragma unroll
        for (int i = 0; i < 8; ++i) tv[i] = __int_as_float(__builtin_amdgcn_ds_bpermute(x32, __float_as_int(sv[i])));
        char* const ob0 = (char*)out + (size_t)(u.pm * BM) * 4096 + (size_t)u.pn * 1024;
        const unsigned loo = lrow * 4096u + (unsigned)(wc * 32 + 8 * fq) * 4u;
#pragma unroll
        for (int ai = 0; ai < 2; ++ai)
#pragma unroll
            for (int m = 0; m < 4; ++m) { const float rs = __builtin_amdgcn_rsqf((sv[ai * 4 + m] + tv[ai * 4 + m]) * (1.0f / 1024.0f) + RMS_EPS);
#pragma unroll
                for (int bj = 0; bj < 2; ++bj) { char* op = ob0 + (size_t)(ai * HALF + m * 16) * 4096 + loo + bj * 512;
                    *(f32x4*)op = acc[ai][bj][m][0] * rs * gv[bj][0]; *(f32x4*)(op + 16) = acc[ai][bj][m][1] * rs * gv[bj][1]; } }
    }
};

struct EpiUp {
    static constexpr bool PERM = true, AFTER_DRAIN = false;
    bf16_t* H; const float* SS; const float* cw; const float* cb; float* bndA; float* bndHA; float* bndHB;
    __device__ __forceinline__ static f32x4 ror1(const f32x4 v) { f32x4 r;
#pragma unroll
        for (int e = 0; e < 4; ++e) r[e] = __int_as_float(__builtin_amdgcn_update_dpp(0, __float_as_int(v[e]), 0x121, 0xf, 0xf, false)); return r; }
    __device__ __forceinline__ static f32x4 ror2(const f32x4 v) { f32x4 r;
#pragma unroll
        for (int e = 0; e < 4; ++e) r[e] = __int_as_float(__builtin_amdgcn_update_dpp(0, __float_as_int(v[e]), 0x122, 0xf, 0xf, false)); return r; }
    __device__ __forceinline__ void operator()(f32x4 (&acc)[2][2][4][2], const Unit& u, int wr, int wc, int fr, int fq) const {
        asm volatile("" : "+v"(fr), "+v"(fq));
        constexpr int FF = 2816;
        const unsigned lch = (unsigned)(wc * 32 + 8 * fq);
        const unsigned lrow = wr * 64 + fr, ls = lrow * 64u + (unsigned)fq * 16u, lh = lrow * (unsigned)(FF * 2) + lch * 2u;
        const unsigned lb = (unsigned)(fr & 1) * (unsigned)(FF * 4) + lch * 4u;
        const char* cwb = (const char*)cw + (size_t)u.pn * 512; const char* cbb = (const char*)cb + (size_t)u.pn * 512;
        const bool f1 = fr >= 1, f2 = fr >= 2;
        float rsa[2][4]; f32x4 cwv[2][4];
        rstd8(rsa, (const char*)SS + (size_t)(u.pm * BM) * 64, ls, fr + 16 * fq);
#pragma unroll
        for (int n = 0; n < 2; ++n) { cwv[n][0] = *(const f32x4*)(cwb + lch * 4u + n * 16); cwv[n][1] = *(const f32x4*)(cwb + lch * 4u + FF * 4 + n * 16); cwv[n][2] = *(const f32x4*)(cwb + lch * 4u + 2 * FF * 4 + n * 16); cwv[n][3] = *(const f32x4*)(cbb + lch * 4u + n * 16); }
#pragma unroll
        for (int ai = 0; ai < 2; ++ai) {
            const int urow = u.pm * BM + ai * HALF; const int G = (urow >> 6) + wr;
            float rs[4];
#pragma unroll
            for (int m = 0; m < 4; ++m) rs[m] = rsa[ai][m];
            const size_t ub = ((size_t)G * 2 * FF + (size_t)u.pn * 128) * 4;
            char* const pA = (char*)bndA + ub; char* const pHA = (char*)bndHA + ub; char* const pHB = (char*)bndHB + ub;
            if (fr >= 14) { *(f32x4*)(pA + lb) = acc[ai][0][3][0] * rs[3]; *(f32x4*)(pA + lb + 16) = acc[ai][0][3][1] * rs[3]; }
            if (fr < 2) { *(f32x4*)(pHA + lb) = acc[ai][0][0][0] * rs[0]; *(f32x4*)(pHA + lb + 16) = acc[ai][0][0][1] * rs[0]; *(f32x4*)(pHB + lb) = acc[ai][1][0][0] * rs[0]; *(f32x4*)(pHB + lb + 16) = acc[ai][1][0][1] * rs[0]; }
#pragma unroll
            for (int n = 0; n < 2; ++n) {
                const f32x4 w0 = cwv[n][0], w1 = cwv[n][1], w2 = cwv[n][2], cbv = cwv[n][3];
                f32x4 r1p = (f32x4){0.f, 0.f, 0.f, 0.f}, r2p = r1p;
#pragma unroll
                for (int m = 0; m < 4; ++m) {
                    const f32x4 am = acc[ai][0][m][n] * rs[m], bm = acc[ai][1][m][n] * rs[m];
                    const f32x4 r1 = ror1(am), r2 = ror2(am); f32x4 p1, p2;
#pragma unroll
                    for (int e = 0; e < 4; ++e) { p1[e] = f1 ? r1[e] : r1p[e]; p2[e] = f2 ? r2[e] : r2p[e]; }
                    const f32x4 cv = w0 * p2 + w1 * p1 + w2 * am + cbv; f32x4 hv;
#pragma unroll
                    for (int e = 0; e < 4; ++e) hv[e] = cv[e] * sigmoid_f(cv[e]) * bm[e];
                    acc[ai][0][m][n] = hv; r1p = r1; r2p = r2; }
                asm volatile("" : "+v"(acc[ai][0][0][n]), "+v"(acc[ai][0][1][n]), "+v"(acc[ai][0][2][n]), "+v"(acc[ai][0][3][n]) :: "memory");
            }
            char* const hb = (char*)H + ((size_t)urow * FF + (size_t)u.pn * 128) * 2;
#pragma unroll
            for (int m = 0; m < 4; ++m) { if (m == 0 && fr < 2) continue;
                *(u32x4*)(hb + lh + m * 16 * FF * 2) = pack8(acc[ai][0][m][0], acc[ai][0][m][1]); }
            asm volatile("" ::: "memory");
        }
    }
};

struct EpiProjB {
    static constexpr bool PERM = true, AFTER_DRAIN = false;
    bf16_t* kvc; bf16_t* PB; const float* SS;
    __device__ __forceinline__ void operator()(f32x4 (&acc)[2][2][4][2], const Unit& u, int wr, int wc, int fr, int fq) const {
        asm volatile("" : "+v"(fr), "+v"(fq));
        constexpr size_t KVSTRIDE = (size_t)8 * 8192 * 64;
        const unsigned lrow = wr * 64 + fr, ls = lrow * 64u + (unsigned)fq * 16u;
        const unsigned lkv = lrow * 128u + (unsigned)((wc & 1) * 32 + 8 * fq) * 2u, lpb = lrow * 2560u + (unsigned)(wc * 32 + 8 * fq) * 2u;
        const int g = wc >> 1, b = u.pm >> 5;
        float rsa[2][4]; rstd8(rsa, (const char*)SS + (size_t)(u.pm * BM) * 64, ls, fr + 16 * fq);
        const float xs = (u.pn == 3 || u.pn == 4) ? 0.125f * 1.4426950408889634f : ((u.pn == 5 || u.pn == 6) ? 0.08838834764831845f * 1.4426950408889634f : 1.0f);
#pragma unroll
        for (int ai = 0; ai < 2; ++ai)
#pragma unroll
            for (int m = 0; m < 4; ++m) { const int urow = u.pm * BM + ai * HALF + m * 16; const float rs = rsa[ai][m] * xs;
#pragma unroll
                for (int bj = 0; bj < 2; ++bj) { const u32x4 w = pack8(acc[ai][bj][m][0] * rs, acc[ai][bj][m][1] * rs);
                    if (u.pn < 3) *(u32x4*)((char*)kvc + ((size_t)(u.pn * 2 + bj) * KVSTRIDE + ((size_t)urow + (size_t)(b + g) * 8192) * 64) * 2 + lkv) = w;
                    else *(u32x4*)((char*)PB + ((size_t)urow * 1280 + (size_t)(u.pn - 3) * 256 + bj * HALF) * 2 + lpb) = w; } }
    }
};

struct EpiGelu {
    static constexpr bool PERM = true, AFTER_DRAIN = false;
    bf16_t* O; const float* bias;
    __device__ __forceinline__ static float gelu_t(float x) { const float u2 = 1.5957691216f * (x + 0.044715f * x * x * x); return x * sigmoid_f(u2); }
    __device__ __forceinline__ void operator()(f32x4 (&acc)[2][2][4][2], const Unit& u, int wr, int wc, int fr, int fq) const {
        asm volatile("" : "+v"(fr), "+v"(fq));
        const unsigned lrow = wr * 64 + fr, lc = (unsigned)(wc * 32 + 8 * fq), lo = lrow * 512u + lc * 2u;
        f32x4 bv[2][2];
#pragma unroll
        for (int bj = 0; bj < 2; ++bj) { bv[bj][0] = *(const f32x4*)((const char*)bias + lc * 4u + bj * 512); bv[bj][1] = *(const f32x4*)((const char*)bias + lc * 4u + bj * 512 + 16); }
#pragma unroll
        for (int ai = 0; ai < 2; ++ai)
#pragma unroll
            for (int m = 0; m < 4; ++m) { char* ob = (char*)O + (size_t)(u.pm * BM + ai * HALF + m * 16) * 512;
#pragma unroll
                for (int bj = 0; bj < 2; ++bj) { f32x4 v0 = acc[ai][bj][m][0] + bv[bj][0], v1 = acc[ai][bj][m][1] + bv[bj][1];
#pragma unroll
                    for (int e = 0; e < 4; ++e) { v0[e] = gelu_t(v0[e]); v1[e] = gelu_t(v1[e]); }
                    *(u32x4*)(ob + lo + bj * HALF * 2) = pack8(v0, v1); } }
    }
};

template <class Epi, class Sched, bool ALIGN_EPI = false, bool SP2 = false>
__device__ __forceinline__ void gemm_phase(PG8_LAS unsigned char* lds, const Gemm g, const Sched& S, const Epi& E) {
    int tid_ = threadIdx.x; asm volatile("" : "+v"(tid_));
    const int tid = tid_, wid = __builtin_amdgcn_readfirstlane(tid >> 6), lane = tid & 63, wr = wid >> 2, wc = wid & 3, fr = lane & 15, fq = lane >> 4;
    const int K = g.K, nt = K / BK;
    unsigned voffA[2], voffB[2];
#pragma unroll
    for (int i = 0; i < 2; ++i) { int R, C; stage_rc(tid * 16 + i * 8192, R, C); const int Rb = Epi::PERM ? ((R & ~31) + perm32(R & 31)) : R;
        voffA[i] = (unsigned)(R * g.lda + C) * 2u; voffB[i] = (unsigned)(Rb * K + C) * 2u; }
    const size_t kstep = (size_t)(BK * 2);
    const size_t hsA = (size_t)HALF * g.lda * 2, hsB = (size_t)HALF * K * 2;
    const size_t tsA = 2 * hsA, tsB = 2 * hsB;
    const unsigned ldsw = (unsigned)wid * 1024u;
    const int aoff = lds_byte(wr * 64 + fr, fq * 8), boff = lds_byte(wc * 32 + fr, fq * 8);
#define PG8_SA(b, h) (((b) * 2 + (h)) * HTB)
#define PG8_SB(b, h) ((4 + (b) * 2 + (h)) * HTB)
#define PG8_STAGE(bufoff, gbase, voff) do { _Pragma("unroll") for (int _i = 0; _i < 2; ++_i) \
        __builtin_amdgcn_global_load_lds((const unsigned*)((const char*)(gbase) + (voff)[_i]), (PG8_LAS unsigned*)(lds + (bufoff) + ldsw + _i * 8192), 16, 0, 0); } while (0)
#define PG8_LDA(dst, b, h) do { _Pragma("unroll") for (int m = 0; m < 4; ++m) _Pragma("unroll") for (int k = 0; k < 2; ++k) dst[m][k] = *(const PG8_LAS bf16x8*)(lds + PG8_SA(b, h) + aoff + m * 2048 + k * 1024); } while (0)
#define PG8_LDB(dst, b, h) do { _Pragma("unroll") for (int n = 0; n < 2; ++n) _Pragma("unroll") for (int k = 0; k < 2; ++k) dst[n][k] = *(const PG8_LAS bf16x8*)(lds + PG8_SB(b, h) + boff + n * 2048 + k * 1024); } while (0)
#define PG8_MMA(ai, bj, At, Bt) do { __builtin_amdgcn_s_setprio(1); _Pragma("unroll") for (int m = 0; m < 4; ++m) _Pragma("unroll") for (int n = 0; n < 2; ++n) _Pragma("unroll") for (int k = 0; k < 2; ++k) \
        acc[ai][bj][m][n] = __builtin_amdgcn_mfma_f32_16x16x32_bf16(Bt[n][k], At[m][k], acc[ai][bj][m][n], 0, 0, 0); __builtin_amdgcn_s_setprio(0); } while (0)
#define PG8_WAIT_V(n) asm volatile("s_waitcnt vmcnt(" #n ")" ::: "memory")
#define PG8_WAIT_L(n) asm volatile("s_waitcnt lgkmcnt(" #n ")" ::: "memory")
#define PG8_BAR __builtin_amdgcn_s_barrier()
#define PG8_SCHED __builtin_amdgcn_sched_barrier(0)
    Unit cur, nxt; int ui = 0;
    if (!S.next(0, cur)) return;
    f32x4 acc[2][2][4][2];
#pragma unroll
    for (int a = 0; a < 2; ++a)
#pragma unroll
        for (int b = 0; b < 2; ++b)
#pragma unroll
            for (int m = 0; m < 4; ++m)
#pragma unroll
                for (int n = 0; n < 2; ++n) acc[a][b][m][n] = (f32x4){0.f, 0.f, 0.f, 0.f};
    bf16x8 At[4][2], B0[2][2], B1[2][2];
    const char* cA = (const char*)g.A + (size_t)cur.pm * tsA; const char* cB = (const char*)g.Bt + (size_t)cur.pn * tsB;
    S.a_ready(cur);
    if constexpr (SP2) {
        PG8_STAGE(PG8_SB(0, 0), cB, voffB); PG8_STAGE(PG8_SB(0, 1), cB + hsB, voffB); PG8_STAGE(PG8_SA(0, 0), cA, voffA); PG8_STAGE(PG8_SA(0, 1), cA + hsA, voffA);
        if (wr == 1) PG8_BAR;
        PG8_WAIT_V(2); PG8_BAR;
        PG8_STAGE(PG8_SB(1, 0), cB + kstep, voffB); PG8_STAGE(PG8_SA(1, 0), cA + kstep, voffA); PG8_STAGE(PG8_SB(1, 1), cB + hsB + kstep, voffB);
        PG8_WAIT_V(6); PG8_BAR;
    } else {
        PG8_STAGE(PG8_SB(0, 0), cB, voffB); PG8_STAGE(PG8_SA(0, 0), cA, voffA); PG8_STAGE(PG8_SB(0, 1), cB + hsB, voffB); PG8_STAGE(PG8_SA(0, 1), cA + hsA, voffA);
        if (wr == 1) PG8_BAR;
        PG8_WAIT_V(4); PG8_BAR;
        PG8_STAGE(PG8_SB(1, 0), cB + kstep, voffB); PG8_STAGE(PG8_SA(1, 0), cA + kstep, voffA); PG8_STAGE(PG8_SB(1, 1), cB + hsB + kstep, voffB);
        PG8_WAIT_V(6); PG8_BAR;
    }
    for (;;) {
        const bool has_next = S.next(ui + 1, nxt);
        const char* nA = has_next ? (const char*)g.A + (size_t)nxt.pm * tsA : cA; const char* nB = has_next ? (const char*)g.Bt + (size_t)nxt.pn * tsB : cB;
        for (int t = 0; t < nt; t += 2) {
            const bool last = (t == nt - 2);
            const char* a1 = cA + (size_t)(t + 1) * kstep;
            const char* a2 = last ? nA : cA + (size_t)(t + 2) * kstep; const char* b2 = last ? nB : cB + (size_t)(t + 2) * kstep;
            const char* a3 = a2 + kstep; const char* b3 = b2 + kstep;
            if (last && has_next) S.a_ready(nxt);
            if constexpr (SP2) {
            PG8_LDB(B0, 0, 0); PG8_LDB(B1, 0, 1); PG8_SCHED; PG8_LDA(At, 0, 0); PG8_STAGE(PG8_SA(1, 1), a1 + hsA, voffA);
            PG8_WAIT_V(8); PG8_WAIT_L(0); PG8_BAR; PG8_MMA(0, 0, At, B0); PG8_MMA(0, 1, At, B1); PG8_BAR; PG8_SCHED;
            PG8_LDA(At, 0, 1); PG8_STAGE(PG8_SB(0, 0), b2, voffB); PG8_STAGE(PG8_SB(0, 1), b2 + hsB, voffB); PG8_STAGE(PG8_SA(0, 0), a2, voffA);
            PG8_WAIT_V(8); PG8_WAIT_L(0); PG8_BAR; PG8_MMA(1, 0, At, B0); PG8_MMA(1, 1, At, B1); PG8_BAR; PG8_SCHED;
            PG8_LDB(B0, 1, 0); PG8_LDB(B1, 1, 1); PG8_SCHED; PG8_LDA(At, 1, 0); PG8_STAGE(PG8_SA(0, 1), a2 + hsA, voffA);
            PG8_WAIT_V(8); PG8_WAIT_L(0); PG8_BAR; PG8_MMA(0, 0, At, B0); PG8_MMA(0, 1, At, B1); PG8_BAR; PG8_SCHED;
            PG8_LDA(At, 1, 1); PG8_STAGE(PG8_SB(1, 0), b3, voffB); PG8_STAGE(PG8_SB(1, 1), b3 + hsB, voffB); PG8_STAGE(PG8_SA(1, 0), a3, voffA);
            PG8_WAIT_V(8); PG8_WAIT_L(0); PG8_BAR; PG8_MMA(1, 0, At, B0); PG8_MMA(1, 1, At, B1); PG8_BAR; PG8_SCHED;
            } else {
            PG8_LDB(B0, 0, 0); PG8_SCHED; PG8_LDA(At, 0, 0); PG8_STAGE(PG8_SA(1, 1), a1 + hsA, voffA);
            PG8_WAIT_L(8); PG8_BAR; PG8_WAIT_L(0); PG8_MMA(0, 0, At, B0); PG8_BAR; PG8_SCHED;
            PG8_LDB(B1, 0, 1); PG8_STAGE(PG8_SB(0, 0), b2, voffB);
            PG8_BAR; PG8_WAIT_L(0); PG8_MMA(0, 1, At, B1); PG8_BAR;
            PG8_LDA(At, 0, 1); PG8_STAGE(PG8_SA(0, 0), a2, voffA);
            PG8_BAR; PG8_WAIT_L(0); PG8_MMA(1, 0, At, B0); PG8_BAR; PG8_SCHED;
            PG8_STAGE(PG8_SB(0, 1), b2 + hsB, voffB);
            PG8_WAIT_V(6); PG8_BAR; PG8_MMA(1, 1, At, B1); PG8_BAR;
            PG8_LDB(B0, 1, 0); PG8_SCHED; PG8_LDA(At, 1, 0); PG8_STAGE(PG8_SA(0, 1), a2 + hsA, voffA);
            PG8_WAIT_L(8); PG8_BAR; PG8_WAIT_L(0); PG8_MMA(0, 0, At, B0); PG8_BAR; PG8_SCHED;
            PG8_LDB(B1, 1, 1); PG8_STAGE(PG8_SB(1, 0), b3, voffB);
            PG8_BAR; PG8_WAIT_L(0); PG8_MMA(0, 1, At, B1); PG8_BAR;
            PG8_LDA(At, 1, 1); PG8_STAGE(PG8_SA(1, 0), a3, voffA);
            PG8_BAR; PG8_WAIT_L(0); PG8_MMA(1, 0, At, B0); PG8_BAR; PG8_SCHED;
            PG8_STAGE(PG8_SB(1, 1), b3 + hsB, voffB);
            PG8_WAIT_V(6); PG8_BAR; PG8_MMA(1, 1, At, B1); PG8_BAR;
            }
        }
        if constexpr (ALIGN_EPI) { if (wr == 0) PG8_BAR; }
        if constexpr (!Epi::AFTER_DRAIN) { E(acc, cur, wr, wc, fr, fq); S.done(cur); }
        if (!has_next) break;
#pragma unroll
        for (int a = 0; a < 2; ++a)
#pragma unroll
            for (int b = 0; b < 2; ++b)
#pragma unroll
                for (int m = 0; m < 4; ++m)
#pragma unroll
                    for (int n = 0; n < 2; ++n) acc[a][b][m][n] = (f32x4){0.f, 0.f, 0.f, 0.f};
        cur = nxt; cA = nA; cB = nB; ++ui;
        if constexpr (ALIGN_EPI) { if (wr == 1) PG8_BAR; }
    }
    PG8_WAIT_V(0);
    if constexpr (!ALIGN_EPI) { if (wr == 0) PG8_BAR; }
    PG8_BAR;
    if constexpr (Epi::AFTER_DRAIN) { E.fused(acc, cur, wr, wc, fr, fq, lds, wid, lane); S.done(cur); }
#undef PG8_SA
#undef PG8_SB
#undef PG8_STAGE
#undef PG8_LDA
#undef PG8_LDB
#undef PG8_MMA
#undef PG8_WAIT_V
#undef PG8_WAIT_L
#undef PG8_BAR
#undef PG8_SCHED
}
}

#define LAS __attribute__((address_space(3)))
#define XB_TMO      128
#define XB_XCNT(j)  (256  + 64 * (j))
#define XB_XSUB(j)  (1280 + 64 * (j))
#define XB_XGEN(j)  (2304 + 64 * (j))
#define XB_TOP      3328
#define XB_TOPGEN   3392
#define XCD_BAR_WORDS 3456
#define XB_SPIN_CAP (1u << 18)

__device__ __forceinline__ unsigned xb_ld(unsigned* p)              { return __hip_atomic_load(p, __ATOMIC_RELAXED, __HIP_MEMORY_SCOPE_AGENT); }
__device__ __forceinline__ unsigned xb_add(unsigned* p, unsigned v) { return __hip_atomic_fetch_add(p, v, __ATOMIC_RELAXED, __HIP_MEMORY_SCOPE_AGENT); }
__device__ __forceinline__ unsigned xb_xcc_id() { return (unsigned)__builtin_amdgcn_s_getreg((3 << 11) | 20) & 0xFu; }
#define XB_SPIN(cond, bar) do { unsigned _sp = 0; while (cond) { __builtin_amdgcn_s_sleep(1); \
    if ((++_sp & 255u) == 0u) { if (xb_ld(&(bar)[XB_TMO])) break; if (_sp > XB_SPIN_CAP) { atomicAdd(&(bar)[XB_TMO], 1u); break; } } } } while (0)

struct XcdBarrier {
    unsigned* bar; unsigned x;
    volatile LAS unsigned* st;
};

__device__ __forceinline__ XcdBarrier xcd_barrier_post(unsigned* bar, volatile LAS unsigned* st) {
    XcdBarrier b; b.bar = bar; b.x = xb_xcc_id(); b.st = st;
    if (threadIdx.x == 0) (void)xb_add(&bar[XB_XCNT(b.x)], 1u);
    return b;
}
__device__ __forceinline__ void xcd_barrier_complete(unsigned* bar, unsigned x, unsigned& nloc, unsigned& nx) {
    const unsigned G = gridDim.x * gridDim.y * gridDim.z;
    unsigned sum, cnt, mine, sp = 0u;
    for (;;) {
        sum = 0u; cnt = 0u; mine = 0u;
#pragma unroll
        for (unsigned j = 0; j < 16; ++j) { const unsigned c = xb_ld(&bar[XB_XCNT(j)]); sum += c; cnt += (c > 0u) ? 1u : 0u; mine = (j == x) ? c : mine; }
        if (sum == G) break;
        __builtin_amdgcn_s_sleep(1);
        if ((++sp & 255u) == 0u) { if (xb_ld(&bar[XB_TMO])) break; if (sp > XB_SPIN_CAP) { atomicAdd(&bar[XB_TMO], 1u); break; } }
    }
    nloc = mine > 0u ? mine : 1u; nx = cnt > 0u ? cnt : 1u;
}

__device__ __forceinline__ void xcd_barrier(const XcdBarrier& b) {
    asm volatile("s_waitcnt vmcnt(0)" ::: "memory");
    __syncthreads();
    if (threadIdx.x == 0) {
        unsigned* bar = b.bar;
        __builtin_amdgcn_s_waitcnt(0);
        unsigned nloc = b.st[0], nx = b.st[1];
        if (nloc == 0u) { xcd_barrier_complete(bar, b.x, nloc, nx); b.st[0] = nloc; b.st[1] = nx; }
        const unsigned old = xb_add(&bar[XB_XSUB(b.x)], 1u);
        const unsigned gen = old / nloc;
        if (old + 1u == (gen + 1u) * nloc) {
            __builtin_amdgcn_fence(__ATOMIC_RELEASE, "agent");
            asm volatile("s_waitcnt vmcnt(0)" ::: "memory");
            const unsigned og = xb_add(&bar[XB_TOP], 1u);
            const unsigned tg = og / nx;
            if (og + 1u == (tg + 1u) * nx) xb_add(&bar[XB_TOPGEN], 1u);
            else XB_SPIN(xb_ld(&bar[XB_TOPGEN]) == tg, bar);
            __builtin_amdgcn_fence(__ATOMIC_ACQUIRE, "agent");
            xb_add(&bar[XB_XGEN(b.x)], 1u);
            asm volatile("s_waitcnt vmcnt(0)" ::: "memory");
        } else {
            XB_SPIN(xb_ld(&bar[XB_XGEN(b.x)]) == gen, bar);
            __builtin_amdgcn_fence(__ATOMIC_ACQUIRE, "agent");
            asm volatile("s_waitcnt vmcnt(0)" ::: "memory");
        }
    }
    __syncthreads();
}

constexpr int NWAVES = 8;
constexpr int NB = 4, T = 8192, D = 1024, M = NB * T;
constexpr int MEML = 256, MROWS = NB * MEML;
constexpr int FF = 2816;
constexpr int NPA = 2304;
constexpr int PA_Q = 0, PA_K = 256, PA_V = 512, PA_R = 1024, PA_MQ = 1536, PA_ALR = 2048;
constexpr int NPB = 1280;
constexpr int PB_Q = 0, PB_MQ = 512, PB_GL = 1024;
constexpr int NG5 = 2048;
constexpr float MEM_QSCALE = 0.08838834764831845f * 1.4426950408889634f;
constexpr int NCMP = 511, NCMPP = 512;
constexpr size_t MiB = 1u << 20;
constexpr size_t WS_CTL = 0, CTL_ZERO_BYTES = 1 * MiB;
constexpr size_t WS_SS = 1 * MiB;
constexpr size_t WS_SSM = 3 * MiB;
constexpr size_t WS_BIAS1 = 3 * MiB + 256 * 1024;
constexpr size_t WS_BPART = 3 * MiB + 512 * 1024;
constexpr size_t WS_WA = 4 * MiB;
constexpr size_t WS_WM = 9 * MiB;
constexpr size_t WS_WOA = 13 * MiB, WS_WOB = 15 * MiB;
constexpr size_t WS_WU = 17 * MiB;
constexpr size_t WS_WD = 39 * MiB;
constexpr size_t WS_WB = 50 * MiB;
constexpr size_t WS_WC1 = 54 * MiB;
constexpr size_t WS_WC2 = 56 * MiB;
constexpr size_t WS_XB = 64 * MiB;
constexpr size_t WS_CAT = 128 * MiB;
constexpr size_t WS_R1 = 192 * MiB;
constexpr size_t WS_R2 = 368 * MiB;
constexpr size_t WS_OG = WS_R2;
constexpr size_t WS_LA = WS_R2 + 64 * MiB;
constexpr size_t WS_KVC = WS_R2;
constexpr size_t WS_CH = WS_R2 + 50 * MiB;
constexpr size_t WS_KCMP = WS_R2 + 54 * MiB;
constexpr size_t WS_BND = WS_R2 + 102 * MiB;
constexpr size_t BND_ONE = (size_t)512 * 2 * FF * 4;
constexpr size_t WS_MKV = WS_R2 + 138 * MiB;
constexpr size_t WS_MEMB = WS_R2 + 142 * MiB;
constexpr size_t WS_END = 512 * MiB;
static_assert(WS_BND + 3 * BND_ONE <= WS_MKV && WS_LA + 32 * MiB <= WS_BND && WS_R1 + (size_t)M * FF * 2 <= WS_R2, "ws map");
constexpr size_t KVSTRIDE = (size_t)8 * 8192 * 64;
constexpr int CW_BAR = 4096, CW_PANEL = 1024;
constexpr int RING_BYTES = 131072;
constexpr int WSCR_BYTES = 17408;
constexpr int BLIST_OFF = 8 * WSCR_BYTES;
constexpr int LDSCTL_OFF = BLIST_OFF + 512, MISC_OFF = LDSCTL_OFF + 320;
constexpr int LDS_BYTES = 147456;
static_assert(MISC_OFF + 128 <= LDS_BYTES, "LDS map");

#define GAS __attribute__((address_space(1)))
#define LAS __attribute__((address_space(3)))
typedef unsigned short bf16;
typedef unsigned v4u __attribute__((ext_vector_type(4)));
typedef unsigned v2u __attribute__((ext_vector_type(2)));
typedef float f32x4 __attribute__((ext_vector_type(4)));
typedef GAS unsigned gu32;
#define LDS_WAIT() asm volatile("s_waitcnt lgkmcnt(0)" ::: "memory")
#define VM_WAIT() asm volatile("s_waitcnt vmcnt(0)" ::: "memory")
__device__ __forceinline__ unsigned f2bf(float f) { unsigned u = __builtin_bit_cast(unsigned, f); return (u + 0x7fffu + ((u >> 16) & 1u)) >> 16; }
__device__ __forceinline__ unsigned pk2(float lo, float hi) { return f2bf(lo) | (f2bf(hi) << 16); }
__device__ __forceinline__ float bf2f(unsigned short b) { return __uint_as_float((unsigned)b << 16); }
__device__ __forceinline__ float bflo(unsigned w) { return __uint_as_float(w << 16); }
__device__ __forceinline__ float bfhi(unsigned w) { return __uint_as_float(w & 0xffff0000u); }

struct Frame {
    LAS unsigned char* lds;
    volatile LAS unsigned* MISC;
    gu32* ctl;
    int tid, lane, wave, G;
    float* out; unsigned char* ws;
};
__device__ __forceinline__ const float* in_ptr(int i) { return ((const float* const __attribute__((address_space(4)))*)__builtin_amdgcn_kernarg_segment_ptr())[i]; }
enum { I_X = 0, I_MEM, I_GMIX, I_GFFN, I_GMEM, I_WMEMKV, I_WUP, I_CONVW, I_CONVB, I_WDOWN, I_AWIN, I_AWALPHA, I_ABALPHA, I_AGHEAD, I_AWOUT, I_GKV, I_WKV, I_PEK, I_PEV,
       I_WCK1, I_WCK2, I_WCV1, I_WCV2, I_BWIN, I_BWOUT, I_GFINAL };
#define WSP(T_, off) ((T_*)(F.ws + (off)))

__device__ __forceinline__ float wave_sum(float v) {
#pragma unroll
    for (int o = 1; o < 64; o <<= 1) v += __shfl_xor(v, o);
    return v;
}
__device__ __forceinline__ float wave_max(float v) {
#pragma unroll
    for (int o = 1; o < 64; o <<= 1) v = fmaxf(v, __shfl_xor(v, o));
    return v;
}

template <int MAP> __device__ __forceinline__ int map_row(int n) {
    if (MAP == 1) { return n < 1536 ? n : (n < 1552 ? n + 512 : n - 16); }
    if (MAP == 2) { return 768 + (n < 512 ? n : (n < 536 ? n + 512 : n - 24)); }
    if (MAP == 3) { const int half = n >= FF ? 1 : 0, f = n - half * FF; return 256 * (f >> 7) + 128 * half + (f & 127); }
    return n;
}
struct TrD { const float* W; const float* gain; bf16* WT; int K, N, row_off, map, item; };
__device__ __forceinline__ int map_row_rt(int map, int n) {
    if (map == 1) return map_row<1>(n);
    if (map == 2) return map_row<2>(n);
    if (map == 3) return map_row<3>(n);
    return n;
}
__device__ __forceinline__ void tr_load(float (&vv)[32], f32x4& ga, f32x4& gb, const TrD& d, int lane) {
    const int nblk = (d.N + 31) >> 5, kb = d.item / nblk, nb = d.item - kb * nblk, k0 = 64 * kb, n0 = 32 * nb;
    const int nn = n0 + (lane & 31);
    const float* wp = d.W + (size_t)(k0 + (lane >> 5)) * d.N + (nn < d.N ? nn : 0);
#pragma unroll
    for (int i = 0; i < 32; ++i) vv[i] = wp[(size_t)(2 * i) * d.N];
    ga = (f32x4){1.f, 1.f, 1.f, 1.f}; gb = ga;
    if (d.gain) { const f32x4* gp = (const f32x4*)(d.gain + k0 + 8 * (lane & 7)); ga = gp[0]; gb = gp[1]; }
}
__device__ __forceinline__ void tr_store(const float (&vv)[32], const f32x4 ga, const f32x4 gb, const TrD& d, LAS float* scr, int lane) {
    const int nblk = (d.N + 31) >> 5, kb = d.item / nblk, nb = d.item - kb * nblk, k0 = 64 * kb, n0 = 32 * nb;
#pragma unroll
    for (int i = 0; i < 32; ++i) scr[(2 * i + (lane >> 5)) * 33 + (lane & 31)] = vv[i];
    LDS_WAIT(); asm volatile("" ::: "memory");
    const int c = lane & 7;
#pragma unroll
    for (int j = 0; j < 4; ++j) { const int n = (lane >> 3) + 8 * j; const LAS float* s = scr + (8 * c) * 33 + n;
        v4u o; o.x = pg8::cvt_pk_bf16(s[0 * 33] * ga.x, s[1 * 33] * ga.y); o.y = pg8::cvt_pk_bf16(s[2 * 33] * ga.z, s[3 * 33] * ga.w); o.z = pg8::cvt_pk_bf16(s[4 * 33] * gb.x, s[5 * 33] * gb.y); o.w = pg8::cvt_pk_bf16(s[6 * 33] * gb.z, s[7 * 33] * gb.w);
        if (n0 + n < d.N) *(GAS v4u*)(d.WT + (size_t)(d.row_off + map_row_rt(d.map, n0 + n)) * d.K + k0 + 8 * c) = o; }
    LDS_WAIT(); asm volatile("" ::: "memory");
}
__device__ __forceinline__ void row_to_bf16_ss(const float* xrow, bf16* orow, float* ss, int lane) {
    const GAS f32x4* xr = (const GAS f32x4*)xrow + lane;
    f32x4 v[4]; float s = 0.f;
#pragma unroll
    for (int j = 0; j < 4; ++j) { v[j] = xr[64 * j]; s += (v[j].x * v[j].x + v[j].y * v[j].y) + (v[j].z * v[j].z + v[j].w * v[j].w); }
    s = wave_sum(s);
    GAS unsigned long long* o8 = (GAS unsigned long long*)orow + lane;
#pragma unroll
    for (int j = 0; j < 4; ++j) o8[64 * j] = (unsigned long long)pk2(v[j].x, v[j].y) | ((unsigned long long)pk2(v[j].z, v[j].w) << 32);
    if (lane < 16) ss[lane] = (lane == 0) ? s : 0.f;
}
constexpr int TR_I0 = 16 * 65, TR_I1 = 16 * 32, TR_I4 = 16 * 176, TR_I6 = 44 * 32, TR_I8 = 16 * 24, TR_I9 = 16 * 33, TR_I11 = 32 * 8, TR_I13 = 4 * 2;
constexpr int TR_NP0 = TR_I0 + 4 * TR_I1 + TR_I4 + TR_I6 + TR_I8 + TR_I9 + 2 * TR_I11 + 2 * TR_I13, TR_NITEMS = TR_NP0 + TR_I4 + TR_I6;
__device__ __forceinline__ TrD tr_decode(Frame& F, int r) {
    if (r < TR_I0) return TrD{in_ptr(I_AWIN), in_ptr(I_GMIX), WSP(bf16, WS_WA), 1024, 2064, 0, 1, r}; r -= TR_I0;
    if (r < TR_I1) return TrD{in_ptr(I_WMEMKV), in_ptr(I_GMEM), WSP(bf16, WS_WM), 1024, 1024, 0, 0, r}; r -= TR_I1;
    if (r < TR_I1) return TrD{in_ptr(I_WMEMKV) + 1024 * 1024, in_ptr(I_GMEM) + 1024, WSP(bf16, WS_WM), 1024, 1024, 1024, 0, r}; r -= TR_I1;
    if (r < TR_I1) return TrD{in_ptr(I_AWOUT), nullptr, WSP(bf16, WS_WOA), 1024, 1024, 0, 0, r}; r -= TR_I1;
    if (r < TR_I4) return TrD{in_ptr(I_WUP), in_ptr(I_GFFN), WSP(bf16, WS_WU), 1024, 2 * FF, 0, 3, r}; r -= TR_I4;
    if (r < TR_I6) return TrD{in_ptr(I_WDOWN), nullptr, WSP(bf16, WS_WD), FF, 1024, 0, 0, r}; r -= TR_I6;
    if (r < TR_I8) return TrD{in_ptr(I_WKV), in_ptr(I_GKV), WSP(bf16, WS_WB), 1024, 768, 0, 0, r}; r -= TR_I8;
    if (r < TR_I9) return TrD{in_ptr(I_BWIN), in_ptr(I_GMIX) + 1024, WSP(bf16, WS_WB), 1024, 1048, 0, 2, r}; r -= TR_I9;
    if (r < TR_I11) return TrD{in_ptr(I_WCK1), nullptr, WSP(bf16, WS_WC1), 2048, 256, 0, 0, r}; r -= TR_I11;
    if (r < TR_I11) return TrD{in_ptr(I_WCV1), nullptr, WSP(bf16, WS_WC1) + (size_t)256 * 2048, 2048, 256, 0, 0, r}; r -= TR_I11;
    if (r < TR_I13) return TrD{in_ptr(I_WCK2), nullptr, WSP(bf16, WS_WC2), 256, 64, 0, 0, r}; r -= TR_I13;
    if (r < TR_I13) return TrD{in_ptr(I_WCV2), nullptr, WSP(bf16, WS_WC2) + 64 * 256, 256, 64, 0, 0, r}; r -= TR_I13;
    if (r < TR_I1) return TrD{in_ptr(I_BWOUT), nullptr, WSP(bf16, WS_WOB), 1024, 1024, 0, 0, r}; r -= TR_I1;
    if (r < TR_I4) return TrD{in_ptr(I_WUP) + (size_t)1024 * 2 * FF, in_ptr(I_GFFN) + 1024, WSP(bf16, WS_WU) + (size_t)2 * FF * 1024, 1024, 2 * FF, 0, 3, r}; r -= TR_I4;
    return TrD{in_ptr(I_WDOWN) + (size_t)FF * 1024, nullptr, WSP(bf16, WS_WD) + (size_t)1024 * FF, FF, 1024, 0, 0, r};
}
__device__ __forceinline__ void tr_items(Frame& F, LAS float* scr, int w, int nw, int lo, int hi, int lane) {
    int it = lo + w;
    if (it >= hi) return;
    TrD d0 = tr_decode(F, it); float v0[32]; f32x4 g0a, g0b; tr_load(v0, g0a, g0b, d0, lane);
    TrD d1 = tr_decode(F, (it + nw < hi) ? it + nw : it); float v1[32]; f32x4 g1a, g1b; tr_load(v1, g1a, g1b, d1, lane);
#pragma unroll 1
    for (;;) {
        const int it2 = it + 2 * nw;
        const TrD d2 = tr_decode(F, (it2 < hi) ? it2 : it); float v2[32]; f32x4 g2a, g2b; tr_load(v2, g2a, g2b, d2, lane);
        tr_store(v0, g0a, g0b, d0, scr, lane);
        if (it + nw >= hi) break;
        it += nw; d0 = d1; g0a = g1a; g0b = g1b; d1 = d2; g1a = g2a; g1b = g2b;
#pragma unroll
        for (int i = 0; i < 32; ++i) { v0[i] = v1[i]; v1[i] = v2[i]; }
    }
}
__device__ __forceinline__ void p0_prologue(Frame& F) {
    LAS float* scr = (LAS float*)(F.lds + F.wave * 16384);
    const int gw = blockIdx.x * NWAVES + F.wave, NGW = F.G * NWAVES, lane = F.lane;
    for (int m = gw; m < MROWS; m += NGW) row_to_bf16_ss(in_ptr(I_MEM) + (size_t)m * D, WSP(bf16, WS_MEMB) + (size_t)m * D, WSP(float, WS_SSM) + (size_t)m * 16, lane);
    for (int o = gw; o < 512; o += NGW) { const int task = o >> 2, mlp = task >> 6, gi = task & 63, j = (o & 3) * 64 + lane; const float* pe = in_ptr(mlp ? I_PEV : I_PEK) + 32 * gi; const float* w1 = in_ptr(mlp ? I_WCV1 : I_WCK1) + (size_t)(32 * gi) * 256 + j;
        float wv[32];
#pragma unroll
        for (int kk = 0; kk < 32; ++kk) wv[kk] = w1[kk * 256];
        float s_ = 0.f;
#pragma unroll
        for (int kk = 0; kk < 32; ++kk) s_ += pe[kk] * wv[kk];
        WSP(float, WS_BPART)[(size_t)task * 256 + j] = s_; }
    tr_items(F, scr, gw, NGW, 0, (F.G == 256) ? TR_NP0 : TR_NITEMS, lane);
    { const int gt = blockIdx.x * 512 + F.tid, NT = F.G * 512; const v4u z = {0u, 0u, 0u, 0u};
      for (int i = gt; i < 240 * 128; i += NT) *(GAS v4u*)(WSP(bf16, WS_WA) + (size_t)2064 * 1024 + (size_t)i * 8) = z;
      for (int i = gt; i < 232 * 128; i += NT) *(GAS v4u*)(WSP(bf16, WS_WB) + (size_t)1816 * 1024 + (size_t)i * 8) = z; }
    { const float* xin = in_ptr(I_X); bf16* xbp = WSP(bf16, WS_XB); float* ssp = WSP(float, WS_SS);
      f32x4 v[8][4];
#pragma unroll
      for (int q = 0; q < 8; ++q) { const int mq = gw + q * NGW;
#pragma unroll
          for (int j = 0; j < 4; ++j) v[q][j] = ((const GAS f32x4*)(xin + (size_t)(mq < M ? mq : (M - 1)) * D) + lane)[64 * j]; }
#pragma unroll 1
      for (int m = gw; m < M; m += 8 * NGW) {
#pragma unroll
          for (int q = 0; q < 8; ++q) { const int mm = m + q * NGW; if (mm >= M) break;
              float s_ = 0.f;
#pragma unroll
              for (int j = 0; j < 4; ++j) s_ += (v[q][j].x * v[q][j].x + v[q][j].y * v[q][j].y) + (v[q][j].z * v[q][j].z + v[q][j].w * v[q][j].w);
              s_ += __int_as_float(__builtin_amdgcn_mov_dpp(__float_as_int(s_), 0xB1, 0xf, 0xf, true)); s_ += __int_as_float(__builtin_amdgcn_mov_dpp(__float_as_int(s_), 0x4E, 0xf, 0xf, true));
              GAS v2u* o8 = (GAS v2u*)(xbp + (size_t)mm * D) + lane;
#pragma unroll
              for (int j = 0; j < 4; ++j) { v2u w; w.x = pg8::cvt_pk_bf16(v[q][j].x, v[q][j].y); w.y = pg8::cvt_pk_bf16(v[q][j].z, v[q][j].w); o8[64 * j] = w; }
              if ((lane & 3) == 0) ssp[(size_t)mm * 16 + (lane >> 2)] = s_;
              const int mn = mm + 8 * NGW;
              if (mn < M) {
#pragma unroll
                  for (int j = 0; j < 4; ++j) v[q][j] = ((const GAS f32x4*)(xin + (size_t)mn * D) + lane)[64 * j]; } } } }
}
__device__ __forceinline__ void bias1_reduce(Frame& F) {
    const float* bp = WSP(float, WS_BPART) + (size_t)(F.tid >> 8) * 64 * 256 + (F.tid & 255);
    float v[64];
#pragma unroll
    for (int gi = 0; gi < 64; ++gi) v[gi] = bp[gi * 256];
    float s_ = 0.f;
#pragma unroll
    for (int gi = 0; gi < 64; ++gi) s_ += v[gi];
    WSP(float, WS_BIAS1)[F.tid] = s_;
}


typedef short bf16x8 __attribute__((ext_vector_type(8)));
typedef short s16x4 __attribute__((ext_vector_type(4)));
typedef float f32x16 __attribute__((ext_vector_type(16)));
__device__ __forceinline__ int crow(int r, int hi) { return (r & 3) + 8 * (r >> 2) + 4 * hi; }
typedef float f32x2_t __attribute__((ext_vector_type(2))); typedef __bf16 bf16x2_t __attribute__((ext_vector_type(2)));
__device__ __forceinline__ unsigned cvtpk(float lo, float hi) { const f32x2_t v = {lo, hi}; return __builtin_bit_cast(unsigned, __builtin_convertvector(v, bf16x2_t)); }
__device__ __forceinline__ void st_pair16(bf16* p0, int hi, v2u a, v2u b) {
    const auto r0 = __builtin_amdgcn_permlane32_swap(a.x, b.x, false, false); const auto r1 = __builtin_amdgcn_permlane32_swap(a.y, b.y, false, false);
    v4u w; w.x = r0[0]; w.y = r1[0]; w.z = r0[1]; w.w = r1[1];
    *(v4u*)(p0 + 8 * hi) = w;
}
__device__ __forceinline__ void dma16(const void* gsrc, LAS unsigned char* ldst) { __builtin_amdgcn_global_load_lds((const unsigned*)gsrc, (LAS unsigned*)ldst, 16, 0, 0); }
template <int NK16> __device__ __forceinline__ void qkt(f32x16& p0, f32x16& p1, const LAS unsigned char* Kt, const bf16x8* qr, int r32, int hi) {
    const LAS unsigned char* kb = Kt + hi * 1024 + r32 * 16;
    bf16x8 kf[2 * NK16];
#pragma unroll
    for (int d0 = 0; d0 < NK16; ++d0) { kf[2 * d0] = *(const LAS bf16x8*)(kb + d0 * 2048); kf[2 * d0 + 1] = *(const LAS bf16x8*)(kb + d0 * 2048 + 512); }
    __builtin_amdgcn_sched_barrier(0);
#pragma unroll
    for (int d0 = 0; d0 < NK16; ++d0) { p0 = __builtin_amdgcn_mfma_f32_32x32x16_bf16(kf[2 * d0], qr[d0], p0, 0, 0, 0); p1 = __builtin_amdgcn_mfma_f32_32x32x16_bf16(kf[2 * d0 + 1], qr[d0], p1, 0, 0, 0); }
    __builtin_amdgcn_sched_barrier(0);
}
__device__ __forceinline__ s16x4 vtr(const LAS unsigned char* p) { typedef short v4i16_t __attribute__((ext_vector_type(4))); return __builtin_bit_cast(s16x4, __builtin_amdgcn_ds_read_tr16_b64_v4i16((LAS v4i16_t*)p)); }
__device__ __forceinline__ void pack_p(bf16x8 (&pa)[4], const f32x16& p0, const f32x16& p1) {
    typedef unsigned u32x4_t __attribute__((ext_vector_type(4)));
    const u32x4_t w0 = {cvtpk(p0[0], p0[1]), cvtpk(p0[2], p0[3]), cvtpk(p0[4], p0[5]), cvtpk(p0[6], p0[7])}, w1 = {cvtpk(p0[8], p0[9]), cvtpk(p0[10], p0[11]), cvtpk(p0[12], p0[13]), cvtpk(p0[14], p0[15])};
    const u32x4_t w2 = {cvtpk(p1[0], p1[1]), cvtpk(p1[2], p1[3]), cvtpk(p1[4], p1[5]), cvtpk(p1[6], p1[7])}, w3 = {cvtpk(p1[8], p1[9]), cvtpk(p1[10], p1[11]), cvtpk(p1[12], p1[13]), cvtpk(p1[14], p1[15])};
    pa[0] = __builtin_bit_cast(bf16x8, w0); pa[1] = __builtin_bit_cast(bf16x8, w1); pa[2] = __builtin_bit_cast(bf16x8, w2); pa[3] = __builtin_bit_cast(bf16x8, w3);
}
template <int NDB> __device__ __forceinline__ void vfrag_issue(s16x4 (&vl)[NDB][4], s16x4 (&vh)[NDB][4], const LAS unsigned char* Vt, int lane) {
    const unsigned vb = (unsigned)(uintptr_t)(Vt + ((lane >> 4) & 1) * 32 + (lane & 3) * 8 + (4 * (lane >> 5) + ((lane & 15) >> 2)) * 64);
    asm volatile("s_waitcnt lgkmcnt(0)" ::: "memory");
#pragma unroll
    for (int db = 0; db < NDB; ++db)
#pragma unroll
        for (int ks = 0; ks < 4; ++ks) {
            asm volatile("ds_read_b64_tr_b16 %0, %1 offset:%c2" : "=&v"(vl[db][ks]) : "v"(vb), "i"(db * 4096 + ks * 1024) : "memory");
            asm volatile("ds_read_b64_tr_b16 %0, %1 offset:%c2" : "=&v"(vh[db][ks]) : "v"(vb), "i"(db * 4096 + ks * 1024 + 512) : "memory"); }
}
template <int NDB> __device__ __forceinline__ void pv_frag(f32x16* o, s16x4 (&vl)[NDB][4], s16x4 (&vh)[NDB][4], const bf16x8 (&pa)[4]) {
    asm volatile("s_waitcnt lgkmcnt(0)" ::: "memory");
#pragma unroll
    for (int db = 0; db < NDB; ++db)
#pragma unroll
        for (int ks = 0; ks < 4; ++ks) { asm volatile("" : "+v"(vl[db][ks]), "+v"(vh[db][ks]));
            const bf16x8 vf = {vl[db][ks][0], vl[db][ks][1], vl[db][ks][2], vl[db][ks][3], vh[db][ks][0], vh[db][ks][1], vh[db][ks][2], vh[db][ks][3]};
            o[db] = __builtin_amdgcn_mfma_f32_32x32x16_bf16(vf, pa[ks], o[db], 0, 0, 0); }
}
__device__ __forceinline__ float max3f(float a, float b, float c) { return __builtin_fmaxf(__builtin_fmaxf(a, b), c); }
__device__ __forceinline__ float max32(const f32x16& p0, const f32x16& p1) {
    float a = max3f(p0[0], p0[1], p1[0]), b = max3f(p0[2], p0[3], p1[1]); a = max3f(a, p1[2], p1[3]);
#pragma unroll
    for (int r = 4; r < 16; r += 4) { a = max3f(a, p0[r], p0[r + 1]); b = max3f(b, p0[r + 2], p0[r + 3]); a = max3f(a, p1[r], p1[r + 1]); b = max3f(b, p1[r + 2], p1[r + 3]); }
    const float m = fmaxf(a, b);
    const auto rr = __builtin_amdgcn_permlane32_swap(__float_as_uint(m), __float_as_uint(m), false, false);
    return fmaxf(__uint_as_float(rr[0]), __uint_as_float(rr[1]));
}
template <int NDB> __device__ __forceinline__ void softmax_step(f32x16& p0, f32x16& p1, float& m, float& l, f32x16* o) {
    const float mn = fmaxf(m, max32(p0, p1)); const float mu = (mn == -INFINITY) ? 0.f : mn; const float alpha = __builtin_amdgcn_exp2f(m - mu);
    float s = 0.f;
#pragma unroll
    for (int r = 0; r < 16; ++r) { p0[r] = __builtin_amdgcn_exp2f(p0[r] - mu); p1[r] = __builtin_amdgcn_exp2f(p1[r] - mu); s += p0[r] + p1[r]; }
    l = l * alpha + s; m = mn;
#pragma unroll
    for (int db = 0; db < NDB; ++db)
#pragma unroll
        for (int r = 0; r < 16; ++r) o[db][r] *= alpha;
}

__device__ __forceinline__ void ph_memattn_mfma(Frame& F, const bf16* Qb, int ldq, int qcol0, int layer, int vb, int VG) {
    const bf16* MKV = WSP(bf16, WS_MKV); bf16* CAT = WSP(bf16, WS_CAT);
    const int lane = F.lane, wave = F.wave, r32 = lane & 31, hi = lane >> 5;
    LAS unsigned char* Kl = F.lds; LAS unsigned char* Vl = F.lds + 65536;
    const int vlo = (vb * 512) / VG, vhi = ((vb + 1) * 512) / VG;
    int cur_bh = -1;
#pragma unroll 1
    for (int v = vlo; v < vhi; ++v) {
        const int bh = v >> 5, b = bh >> 2, h = bh & 3, q0 = (v & 31) * 256 + wave * 32;
        const size_t row = (size_t)b * T + q0 + r32;
        bf16x8 qr[8];
#pragma unroll
        for (int d0 = 0; d0 < 8; ++d0) qr[d0] = *(const bf16x8*)(Qb + row * ldq + qcol0 + h * 128 + d0 * 16 + hi * 8);
        if (bh != cur_bh) {
            __syncthreads();
            const char* kg = (const char*)(MKV + (size_t)(b * 256) * 2048 + layer * 1024 + h * 128); const char* vg = kg + 1024;
#pragma unroll
            for (int j = 0; j < 8; ++j) { const int pc = wave * 8 + j;
                dma16(kg + (size_t)((pc >> 4) * 64 + lane) * 4096 + (pc & 15) * 16, Kl + (pc >> 4) * 16384 + (pc & 15) * 1024);
                dma16(vg + (size_t)((pc >> 4) * 64 + (pc & 3) * 16 + (lane >> 2)) * 4096 + ((pc >> 2) & 3) * 64 + (lane & 3) * 16, Vl + (pc >> 4) * 16384 + ((pc >> 2) & 3) * 4096 + (pc & 3) * 1024); }
            cur_bh = bh;
            asm volatile("s_waitcnt vmcnt(0)" ::: "memory");
            __syncthreads();
        }
        f32x16 o[4]; o[0] = (f32x16){}; o[1] = (f32x16){}; o[2] = (f32x16){}; o[3] = (f32x16){};
        float m = -INFINITY, l = 0.f;
#pragma unroll 1
        for (int kt = 0; kt < 4; ++kt) {
            f32x16 p0 = (f32x16){}, p1 = (f32x16){}; qkt<8>(p0, p1, Kl + kt * 16384, qr, r32, hi);
            s16x4 vl[2][4], vh[2][4]; vfrag_issue<2>(vl, vh, Vl + kt * 16384, lane);
            softmax_step<4>(p0, p1, m, l, o);
            bf16x8 pa[4]; pack_p(pa, p0, p1);
            pv_frag<2>(o, vl, vh, pa);
            s16x4 vl2[2][4], vh2[2][4]; vfrag_issue<2>(vl2, vh2, Vl + kt * 16384 + 8192, lane);
            pv_frag<2>(o + 2, vl2, vh2, pa);
        }
        l += __shfl_xor(l, 32); const float inv = 1.0f / l;
        bf16* op = CAT + row * 1024 + 512 + h * 128;
#pragma unroll
        for (int db = 0; db < 4; ++db)
#pragma unroll
            for (int rg = 0; rg < 4; rg += 2) { v2u w, w2; w.x = cvtpk(o[db][4 * rg] * inv, o[db][4 * rg + 1] * inv); w.y = cvtpk(o[db][4 * rg + 2] * inv, o[db][4 * rg + 3] * inv);
                w2.x = cvtpk(o[db][4 * rg + 4] * inv, o[db][4 * rg + 5] * inv); w2.y = cvtpk(o[db][4 * rg + 6] * inv, o[db][4 * rg + 7] * inv);
                st_pair16(op + 32 * db + 8 * rg, hi, w, w2); }
    }
    __syncthreads();
}

constexpr int NS_K = 0, NS_V = 32768, NS_MAIN = 65536, NS_PITCH = 129, NS_SPILL = NS_MAIN + 64 * NS_PITCH * 4, NS_MASK = NS_SPILL + 64 * NS_PITCH * 4, NS_UNION = NS_MASK + 1024, NS_BLIST = NS_UNION + 16, NS_END = NS_BLIST + 512;
static_assert(NS_END <= LDSCTL_OFF, "NSA LDS map");
__device__ __forceinline__ void nsa_dma(const bf16* Kb, const bf16* Vb, int row0, LAS unsigned char* lds, int buf, int wave, int lane) {
    dma16((const char*)Kb + (size_t)(row0 + lane) * 128 + wave * 16, lds + NS_K + buf * 8192 + wave * 1024);
    if (Vb) dma16((const char*)Vb + (size_t)(row0 + (wave & 3) * 16 + (lane >> 2)) * 128 + (wave >> 2) * 64 + (lane & 3) * 16, lds + NS_V + buf * 8192 + (wave >> 2) * 4096 + (wave & 3) * 1024);
}
#define NSA_STAGE_BAR() asm volatile("s_waitcnt vmcnt(0) lgkmcnt(0)\n\ts_barrier" ::: "memory")
template <int KSTEP> __device__ __forceinline__ void nsa_bias(f32x16& p0, f32x16& p1, int base, float sl, float mref, bool lanevalid = true) {
    const float A = lanevalid ? (-sl * (float)base - mref) : -INFINITY, slk = sl * (float)KSTEP, C = slk * 32.0f;
#pragma unroll
    for (int r = 0; r < 16; ++r) { const float tr = fmaf(slk, (float)((r & 3) + 8 * (r >> 2)), A); p0[r] = tr; p1[r] = tr + C; }
}
template <int KSTEP, bool WINDOW> __device__ __forceinline__ void nsa_mask(f32x16& p0, f32x16& p1, int base) {
#pragma unroll
    for (int r = 0; r < 16; ++r) { const int d0 = base - KSTEP * ((r & 3) + 8 * (r >> 2)), d1 = d0 - 32 * KSTEP;
        const bool v0 = WINDOW ? (d0 >= 0 && d0 < 512) : (d0 >= 0), v1 = WINDOW ? (d1 >= 0 && d1 < 512) : (d1 >= 0);
        p0[r] = v0 ? p0[r] : -INFINITY; p1[r] = v1 ? p1[r] : -INFINITY; }
}
template <int NDB> __device__ __forceinline__ void nsa_softmax(f32x16& p0, f32x16& p1, float& m, float& l, f32x16* o) {
    const float mx = max32(p0, p1);
    if (__any(mx > 8.0f)) { const float dl = (mx > 8.0f) ? mx : 0.f; m += dl; const float ef = __builtin_amdgcn_exp2f(-dl); l *= ef;
#pragma unroll
        for (int r = 0; r < 16; ++r) { p0[r] -= dl; p1[r] -= dl; }
#pragma unroll
        for (int db = 0; db < NDB; ++db)
#pragma unroll
            for (int r = 0; r < 16; ++r) o[db][r] *= ef; }
    float s = 0.f;
#pragma unroll
    for (int r = 0; r < 16; ++r) { p0[r] = __builtin_amdgcn_exp2f(p0[r]); p1[r] = __builtin_amdgcn_exp2f(p1[r]); s += p0[r] + p1[r]; }
    l += s;
}
__device__ __forceinline__ float dpp_xor1(float v) { return __int_as_float(__builtin_amdgcn_mov_dpp(__float_as_int(v), 0xB1, 0xf, 0xf, true)); }
__device__ __forceinline__ float dpp_xor2(float v) { return __int_as_float(__builtin_amdgcn_mov_dpp(__float_as_int(v), 0x4E, 0xf, 0xf, true)); }
__device__ __forceinline__ void ph_nsa_mfma(Frame& F) {
    const bf16* PB = WSP(bf16, WS_R1); const bf16* KVC = WSP(bf16, WS_KVC); const bf16* KCMP = WSP(bf16, WS_KCMP); bf16* CAT = WSP(bf16, WS_CAT);
    const int lane = F.lane, wave = F.wave, tid = F.tid, r32 = lane & 31, hi = lane >> 5, hp = r32 & 3, q8 = r32 >> 2, ql = 8 * wave + q8;
    LAS unsigned char* lds = F.lds;
    LAS float* Lmain = (LAS float*)(lds + NS_MAIN); LAS float* Lspill = (LAS float*)(lds + NS_SPILL); LAS unsigned* Lmask = (LAS unsigned*)(lds + NS_MASK); LAS unsigned* Lunion = (LAS unsigned*)(lds + NS_UNION); LAS int* Lblist = (LAS int*)(lds + NS_BLIST);
    const int nunits = 1024, per = (nunits + F.G - 1) / F.G;
#define NSA_UNIT(ui_, bg_, qt_, ok_) do { if (F.G == 256) { const int s_ = blockIdx.x & 31; bg_ = blockIdx.x >> 5; qt_ = ((ui_) == 0) ? s_ : ((ui_) == 1) ? 63 - s_ : ((ui_) == 2) ? 64 + s_ : 127 - s_; ok_ = (ui_) < 4; } \
        else { const int u_ = blockIdx.x + (ui_) * F.G; ok_ = (ui_) < per && u_ < nunits; bg_ = u_ >> 7; qt_ = u_ & 127; } } while (0)
    int sp = 0;
    if (wave >= 4) __builtin_amdgcn_s_setprio(1);
    { int bg0, qt0; bool ok0; NSA_UNIT(0, bg0, qt0, ok0);
      if (ok0) { const int nt0 = (4 * qt0 + 3 + 63) >> 6; const bf16* kc0 = KCMP + (size_t)(bg0 * NCMPP) * 64; nsa_dma(kc0, nullptr, (nt0 - 1) * 64, lds, 0, wave, lane); if (nt0 > 1) nsa_dma(kc0, nullptr, (nt0 - 2) * 64, lds, 1, wave, lane); } }
    bf16x8 qnx[4]; unsigned short gnx[3];
    { int bg0, qt0; bool ok0; NSA_UNIT(0, bg0, qt0, ok0); if (!ok0) { bg0 = 0; qt0 = 0; }
      const size_t row0_ = (size_t)(bg0 >> 1) * T + qt0 * 64 + ql; const int head0_ = (bg0 & 1) * 4 + hp;
#pragma unroll
      for (int d0 = 0; d0 < 4; ++d0) qnx[d0] = *(const bf16x8*)(PB + row0_ * NPB + PB_Q + head0_ * 64 + d0 * 16 + hi * 8);
#pragma unroll
      for (int i = 0; i < 3; ++i) gnx[i] = PB[row0_ * NPB + PB_GL + head0_ * 3 + i]; }
#pragma unroll 1
    for (int ui = 0; ui < per; ++ui) {
        int bg, qt; bool ok_u; NSA_UNIT(ui, bg, qt, ok_u); if (!ok_u) break;
        int bgn, qtn; bool ok_n; NSA_UNIT(ui + 1, bgn, qtn, ok_n);
        const int b = bg >> 1, g = bg & 1, t0 = qt * 64, t = t0 + ql, cur = qt, tmin = t0 + 8 * wave;
        const size_t row = (size_t)b * T + t; const int head = g * 4 + hp;
        const float slope2 = exp2f(-(float)(head + 1)) * 1.4426950408889634f;
        bf16x8 qr[4];
#pragma unroll
        for (int d0 = 0; d0 < 4; ++d0) qr[d0] = qnx[d0];
        float gate[3];
#pragma unroll
        for (int i = 0; i < 3; ++i) gate[i] = pg8::sigmoid_f(bf2f(gnx[i]));
        if (tid < 4) Lunion[tid] = 0u;
        LAS float* Ltot = (LAS float*)(lds + NS_MAIN) + tid;
        const bf16* kcb = KCMP + (size_t)(bg * NCMPP) * 64; const bf16* vcb = KCMP + (size_t)(4096 + bg * NCMPP) * 64;
        const int nt = (4 * qt + 3 + 63) >> 6;
        float m = 0.f, l = 0.f;
#pragma unroll 1
        for (int st = 0; 2 * st < nt; ++st) {
            NSA_STAGE_BAR();
            { const int i2 = 2 * st + 2, sb = ((sp + st + 1) & 1) * 2; if (i2 < nt) { nsa_dma(kcb, nullptr, (nt - 1 - i2) * 64, lds, sb, wave, lane); if (i2 + 1 < nt) nsa_dma(kcb, nullptr, (nt - 2 - i2) * 64, lds, sb + 1, wave, lane); }
              else { nsa_dma(kcb, vcb, (nt - 1) * 64, lds, sb, wave, lane); if (nt > 1) nsa_dma(kcb, vcb, (nt - 2) * 64, lds, sb + 1, wave, lane); } }
#pragma unroll 1
            for (int h2 = 0; h2 < 2; ++h2) { const int it = 2 * st + h2; if (it >= nt) break; const int kt = nt - 1 - it, buf = ((sp + st) & 1) * 2 + h2;
                const int base = t - 31 - 16 * (64 * kt + 4 * hi);
                f32x16 p0, p1; nsa_bias<16>(p0, p1, base, slope2, m); qkt<4>(p0, p1, lds + NS_K + buf * 8192, qr, r32, hi);
                if (1024 * kt + 1039 > tmin) nsa_mask<16, false>(p0, p1, base);
                nsa_softmax<0>(p0, p1, m, l, nullptr); }
        }
        sp = (sp + ((nt + 1) >> 1)) & 1;
        l += __shfl_xor(l, 32);
        const float invl = 1.0f / fmaxf(l, 1e-30f);
        f32x16 o[2]; o[0] = (f32x16){}; o[1] = (f32x16){};
        const bf16* ksb = KVC + 2 * KVSTRIDE + (size_t)bg * 8192 * 64; const bf16* vsb = KVC + 3 * KVSTRIDE + (size_t)bg * 8192 * 64;
#pragma unroll 1
        for (int st = 0; 2 * st < nt; ++st) {
            NSA_STAGE_BAR();
            { const int i2 = 2 * st + 2, sb = ((sp + st + 1) & 1) * 2; if (i2 < nt) { nsa_dma(kcb, vcb, (nt - 1 - i2) * 64, lds, sb, wave, lane); if (i2 + 1 < nt) nsa_dma(kcb, vcb, (nt - 2 - i2) * 64, lds, sb + 1, wave, lane); }
              else { nsa_dma(ksb, vsb, cur * 64, lds, sb, wave, lane); if (cur > 0) nsa_dma(ksb, vsb, (cur - 1) * 64, lds, sb + 1, wave, lane); } }
#pragma unroll 1
            for (int h2 = 0; h2 < 2; ++h2) { const int it = 2 * st + h2; if (it >= nt) break; const int kt = nt - 1 - it, buf = ((sp + st) & 1) * 2 + h2;
                const int base = t - 31 - 16 * (64 * kt + 4 * hi);
                f32x16 p0, p1; nsa_bias<16>(p0, p1, base, slope2, m); qkt<4>(p0, p1, lds + NS_K + buf * 8192, qr, r32, hi);
                s16x4 vl[2][4], vh[2][4]; vfrag_issue<2>(vl, vh, lds + NS_V + buf * 8192, lane);
                if (1024 * kt + 1039 > tmin) nsa_mask<16, false>(p0, p1, base);
#pragma unroll
                for (int r = 0; r < 16; ++r) { p0[r] = __builtin_amdgcn_exp2f(p0[r]) * invl; p1[r] = __builtin_amdgcn_exp2f(p1[r]) * invl; }
#pragma unroll
                for (int pi = 0; pi < 2; ++pi)
#pragma unroll
                    for (int rg = 0; rg < 4; ++rg) { const f32x16& pp = pi ? p1 : p0; float v3 = 0.5f * pp[4 * rg + 3]; float vm = (pp[4 * rg] + pp[4 * rg + 1]) + (pp[4 * rg + 2] + v3);
                        vm += dpp_xor1(vm); vm += dpp_xor2(vm); v3 += dpp_xor1(v3); v3 += dpp_xor2(v3);
                        const int a = 16 * kt + 8 * pi + 2 * rg + hi;
                        if (hp == 0) { Lmain[ql * NS_PITCH + a] = vm; Lspill[ql * NS_PITCH + a] = v3; } }
                bf16x8 pa[4]; pack_p(pa, p0, p1);
                pv_frag<2>(o, vl, vh, pa); }
        }
        sp = (sp + ((nt + 1) >> 1)) & 1;
        __syncthreads();
#pragma unroll
        for (int db = 0; db < 2; ++db)
#pragma unroll
            for (int r = 0; r < 16; ++r) o[db][r] *= gate[0];
        {
            int q = tid >> 3, s8 = tid & 7; asm volatile("" : "+v"(q), "+v"(s8));
            unsigned mw0 = 0u, mw1 = 0u, mw2 = 0u, mw3 = 0u;
            if (cur < 16) { mw0 = (1u << (cur + 1)) - 1u; }
            else {
                float val[16];
#pragma unroll
                for (int k = 0; k < 16; ++k) { const int j = s8 + 8 * k;
                    val[k] = (j > cur) ? -INFINITY : ((j == 0 || j >= cur - 1) ? INFINITY : Lmain[q * NS_PITCH + j] + Lspill[q * NS_PITCH + j - 1]); }
#pragma unroll 1
                for (int round = 0; round < 16; ++round) {
                    float bv = val[0]; int bj = s8;
#pragma unroll
                    for (int k = 1; k < 16; ++k) { const bool gt = val[k] > bv; bv = gt ? val[k] : bv; bj = gt ? (s8 + 8 * k) : bj; }
#pragma unroll
                    for (int stp = 0; stp < 3; ++stp) {
                        const float ov = __int_as_float(stp == 0 ? __builtin_amdgcn_mov_dpp(__float_as_int(bv), 0xB1, 0xf, 0xf, true) : stp == 1 ? __builtin_amdgcn_mov_dpp(__float_as_int(bv), 0x4E, 0xf, 0xf, true) : __builtin_amdgcn_mov_dpp(__float_as_int(bv), 0x141, 0xf, 0xf, true));
                        const int oj = stp == 0 ? __builtin_amdgcn_mov_dpp(bj, 0xB1, 0xf, 0xf, true) : stp == 1 ? __builtin_amdgcn_mov_dpp(bj, 0x4E, 0xf, 0xf, true) : __builtin_amdgcn_mov_dpp(bj, 0x141, 0xf, 0xf, true);
                        const bool tk = (ov > bv) || (ov == bv && oj < bj); bv = tk ? ov : bv; bj = tk ? oj : bj; }
#pragma unroll
                    for (int k = 0; k < 16; ++k) val[k] = (bj == s8 + 8 * k) ? -INFINITY : val[k];
                    const unsigned bit = 1u << (bj & 31); const int wsel = bj >> 5;
                    mw0 |= (wsel == 0) ? bit : 0u; mw1 |= (wsel == 1) ? bit : 0u; mw2 |= (wsel == 2) ? bit : 0u; mw3 |= (wsel == 3) ? bit : 0u;
                }
            }
            if (s8 == 0) { Lmask[q * 4 + 0] = mw0; Lmask[q * 4 + 1] = mw1; Lmask[q * 4 + 2] = mw2; Lmask[q * 4 + 3] = mw3;
                atomicOr((unsigned*)&Lunion[0], mw0); atomicOr((unsigned*)&Lunion[1], mw1); atomicOr((unsigned*)&Lunion[2], mw2); atomicOr((unsigned*)&Lunion[3], mw3); }
        }
        __syncthreads();
        int nsel;
        { const unsigned u0 = Lunion[0], u1 = Lunion[1], u2 = Lunion[2], u3 = Lunion[3];
          nsel = __builtin_amdgcn_readfirstlane(__popc(u0) + __popc(u1) + __popc(u2) + __popc(u3));
          if (tid < 128) { const unsigned uw = (tid < 32) ? u0 : (tid < 64) ? u1 : (tid < 96) ? u2 : u3; const int bp = tid & 31;
              if ((uw >> bp) & 1u) { int pos = __popc(uw & ((1u << bp) - 1u)); if (tid >= 32) pos += __popc(u0); if (tid >= 64) pos += __popc(u1); if (tid >= 96) pos += __popc(u2); Lblist[pos] = tid; } } }
        const unsigned mq0 = Lmask[ql * 4 + 0], mq1 = Lmask[ql * 4 + 1], mq2 = Lmask[ql * 4 + 2], mq3 = Lmask[ql * 4 + 3];
        __syncthreads();
#pragma unroll
        for (int db = 0; db < 2; ++db)
#pragma unroll
            for (int r = 0; r < 16; ++r) Ltot[(db * 16 + r) * 512] = o[db][r];
        const bf16* kwb = KVC + 4 * KVSTRIDE + (size_t)bg * 8192 * 64; const bf16* vwb = KVC + 5 * KVSTRIDE + (size_t)bg * 8192 * 64;
        o[0] = (f32x16){}; o[1] = (f32x16){}; m = 0.f; l = 0.f;
#pragma unroll 1
        for (int st = 0; 2 * st < nsel; ++st) {
            NSA_STAGE_BAR();
            { const int i2 = 2 * st + 2, sb = ((sp + st + 1) & 1) * 2; if (i2 < nsel) { nsa_dma(ksb, vsb, __builtin_amdgcn_readfirstlane(Lblist[nsel - 1 - i2]) * 64, lds, sb, wave, lane); if (i2 + 1 < nsel) nsa_dma(ksb, vsb, __builtin_amdgcn_readfirstlane(Lblist[nsel - 2 - i2]) * 64, lds, sb + 1, wave, lane); }
              else { nsa_dma(kwb, vwb, qt * 64, lds, sb, wave, lane); if (qt > 0) nsa_dma(kwb, vwb, (qt - 1) * 64, lds, sb + 1, wave, lane); } }
#pragma unroll 1
            for (int h2 = 0; h2 < 2; ++h2) { const int i = 2 * st + h2; if (i >= nsel) break; const int j = __builtin_amdgcn_readfirstlane(Lblist[nsel - 1 - i]), buf = ((sp + st) & 1) * 2 + h2;
                const unsigned wj = (j < 32) ? mq0 : (j < 64) ? mq1 : (j < 96) ? mq2 : mq3; const bool selq = (wj >> (j & 31)) & 1u;
                const int base = t - (64 * j + 4 * hi);
                f32x16 p0, p1; nsa_bias<1>(p0, p1, base, slope2, m, selq);
                qkt<4>(p0, p1, lds + NS_K + buf * 8192, qr, r32, hi);
                s16x4 vl[2][4], vh[2][4]; vfrag_issue<2>(vl, vh, lds + NS_V + buf * 8192, lane);
                if (j == cur) nsa_mask<1, false>(p0, p1, base);
                nsa_softmax<2>(p0, p1, m, l, o);
                bf16x8 pa[4]; pack_p(pa, p0, p1);
                pv_frag<2>(o, vl, vh, pa); }
        }
        sp = (sp + ((nsel + 1) >> 1)) & 1;
        { l += __shfl_xor(l, 32); const float sc = gate[1] / fmaxf(l, 1e-30f);
#pragma unroll
          for (int db = 0; db < 2; ++db)
#pragma unroll
            for (int r = 0; r < 16; ++r) Ltot[(db * 16 + r) * 512] += sc * o[db][r]; }
        o[0] = (f32x16){}; o[1] = (f32x16){}; m = 0.f; l = 0.f;
        const int j0 = qt >= 8 ? qt - 8 : 0, nw = qt - j0 + 1;
#pragma unroll 1
        for (int st = 0; 2 * st < nw; ++st) {
            NSA_STAGE_BAR();
            if (st == 0 && ok_n) { const size_t rown_ = (size_t)(bgn >> 1) * T + qtn * 64 + ql; const int headn_ = (bgn & 1) * 4 + hp;
#pragma unroll
                for (int d0 = 0; d0 < 4; ++d0) qnx[d0] = *(const bf16x8*)(PB + rown_ * NPB + PB_Q + headn_ * 64 + d0 * 16 + hi * 8);
#pragma unroll
                for (int i = 0; i < 3; ++i) gnx[i] = PB[rown_ * NPB + PB_GL + headn_ * 3 + i]; }
            { const int i2 = 2 * st + 2, sb = ((sp + st + 1) & 1) * 2; if (i2 < nw) { nsa_dma(kwb, vwb, (qt - i2) * 64, lds, sb, wave, lane); if (i2 + 1 < nw) nsa_dma(kwb, vwb, (qt - i2 - 1) * 64, lds, sb + 1, wave, lane); }
              else if (ok_n) { const int ntn = (4 * qtn + 3 + 63) >> 6; const bf16* kcn = KCMP + (size_t)(bgn * NCMPP) * 64; nsa_dma(kcn, nullptr, (ntn - 1) * 64, lds, sb, wave, lane); if (ntn > 1) nsa_dma(kcn, nullptr, (ntn - 2) * 64, lds, sb + 1, wave, lane); } }
#pragma unroll 1
            for (int h2 = 0; h2 < 2; ++h2) { const int i = 2 * st + h2; if (i >= nw) break; const int j = qt - i, buf = ((sp + st) & 1) * 2 + h2;
                const int base = t - (64 * j + 4 * hi);
                f32x16 p0, p1; nsa_bias<1>(p0, p1, base, slope2, m); qkt<4>(p0, p1, lds + NS_K + buf * 8192, qr, r32, hi);
                s16x4 vl[2][4], vh[2][4]; vfrag_issue<2>(vl, vh, lds + NS_V + buf * 8192, lane);
                if (j == qt || j + 8 == qt) nsa_mask<1, true>(p0, p1, base);
                nsa_softmax<2>(p0, p1, m, l, o);
                bf16x8 pa[4]; pack_p(pa, p0, p1);
                pv_frag<2>(o, vl, vh, pa); }
        }
        sp = (sp + ((nw + 1) >> 1)) & 1;
        { l += __shfl_xor(l, 32); const float sc = gate[2] / fmaxf(l, 1e-30f);
          bf16* op = CAT + row * 1024 + head * 64;
#pragma unroll
          for (int db = 0; db < 2; ++db)
#pragma unroll
            for (int rg = 0; rg < 4; rg += 2) { v2u wp[2];
#pragma unroll
                for (int k = 0; k < 2; ++k) { const int r_ = 4 * (rg + k); const float v0 = Ltot[(db * 16 + r_) * 512] + sc * o[db][r_], v1 = Ltot[(db * 16 + r_ + 1) * 512] + sc * o[db][r_ + 1], v2 = Ltot[(db * 16 + r_ + 2) * 512] + sc * o[db][r_ + 2], v3 = Ltot[(db * 16 + r_ + 3) * 512] + sc * o[db][r_ + 3];
                    wp[k].x = cvtpk(v0, v1); wp[k].y = cvtpk(v2, v3); }
                st_pair16(op + 32 * db + 8 * rg, hi, wp[0], wp[1]); } }
    }
#undef NSA_UNIT
    __builtin_amdgcn_s_setprio(0);
    asm volatile("s_waitcnt vmcnt(0)" ::: "memory"); __syncthreads();
}
constexpr size_t WS_DS = WS_OG, WS_SP = WS_LA, WS_DEC = WS_R2 + 96 * MiB;
constexpr int GL_ALR = 0, GL_TOT = 4096  , GL_KE = 8192, GL_V = 40960;
static_assert(GL_V + 65536 <= LDSCTL_OFF, "GLA LDS map");
__device__ __forceinline__ void gla_dma_v(const bf16* PA, int row0, LAS unsigned char* lds, int wave, int lane) {
#pragma unroll
    for (int j = 0; j < 8; ++j) { const int pc = wave * 8 + j, h = pc >> 4, db = (pc >> 2) & 3, kg4 = pc & 3;
        dma16((const char*)(PA + (size_t)(row0 + kg4 * 16 + (lane >> 2)) * NPA + PA_V + h * 128 + db * 32) + (lane & 3) * 16, lds + GL_V + h * 16384 + db * 4096 + kg4 * 1024); }
}
__device__ __forceinline__ void ph_gla_local(Frame& F) {
    bf16* PA = WSP(bf16, WS_R1); bf16* DS = WSP(bf16, WS_DS); float* DEC = WSP(float, WS_DEC);
    const float* wa = in_ptr(I_AWALPHA); const float* ba = in_ptr(I_ABALPHA);
    const int lane = F.lane, wave = F.wave, tid = F.tid, r32 = lane & 31, hi = lane >> 5;
    LAS unsigned char* lds = F.lds; LAS float* Lalr = (LAS float*)(lds + GL_ALR); LAS float* Ltot = (LAS float*)(lds + GL_TOT);
    typedef float f32x2_ __attribute__((ext_vector_type(2)));
    const int cp = tid & 127, qtr = tid >> 7, ch = 2 * cp, h = ch >> 6, d = ch & 63;
    float w0[16], w1[16];
#pragma unroll
    for (int j = 0; j < 16; ++j) { const f32x2_ t_ = *(const f32x2_*)(wa + j * 256 + ch); w0[j] = t_.x; w1[j] = t_.y; }
    const f32x2_ bias2 = *(const f32x2_*)(ba + ch);
#pragma unroll 1
    for (int u = blockIdx.x; u < 512; u += F.G) {
        const int b = u >> 7, c = u & 127, row0 = b * T + c * 64;
        gla_dma_v(PA, row0, lds, wave, lane);
#pragma unroll
        for (int k = 0; k < 2; ++k) { const int idx = tid + 512 * k; Lalr[idx] = bf2f(PA[(size_t)(row0 + (idx >> 4)) * NPA + PA_ALR + (idx & 15)]); }
        unsigned kraw[16];
#pragma unroll
        for (int i = 0; i < 16; ++i) kraw[i] = *(const unsigned*)(PA + (size_t)(row0 + qtr * 16 + i) * NPA + PA_K + ch);
        unsigned qraw[16];
#pragma unroll
        for (int i = 0; i < 16; ++i) qraw[i] = *(const unsigned*)(PA + (size_t)(row0 + qtr * 16 + i) * NPA + PA_Q + ch);
        LDS_WAIT(); __syncthreads();
        float b0[16], b1[16]; float run0 = 0.f, run1 = 0.f;
#pragma unroll
        for (int i = 0; i < 16; ++i) { const LAS f32x4* ap = (const LAS f32x4*)(Lalr + (qtr * 16 + i) * 16); const f32x4 a0 = ap[0], a1 = ap[1], a2 = ap[2], a3 = ap[3];
            const float z0 = bias2.x + a0.x * w0[0] + a0.y * w0[1] + a0.z * w0[2] + a0.w * w0[3] + a1.x * w0[4] + a1.y * w0[5] + a1.z * w0[6] + a1.w * w0[7] + a2.x * w0[8] + a2.y * w0[9] + a2.z * w0[10] + a2.w * w0[11] + a3.x * w0[12] + a3.y * w0[13] + a3.z * w0[14] + a3.w * w0[15];
            const float z1 = bias2.y + a0.x * w1[0] + a0.y * w1[1] + a0.z * w1[2] + a0.w * w1[3] + a1.x * w1[4] + a1.y * w1[5] + a1.z * w1[6] + a1.w * w1[7] + a2.x * w1[8] + a2.y * w1[9] + a2.z * w1[10] + a2.w * w1[11] + a3.x * w1[12] + a3.y * w1[13] + a3.z * w1[14] + a3.w * w1[15];
            const float ls0 = fminf(z0, 0.f) - __logf(1.0f + __expf(-fabsf(z0))), ls1 = fminf(z1, 0.f) - __logf(1.0f + __expf(-fabsf(z1)));
            run0 += ls0 * (1.0f / 16.0f); b0[i] = run0; run1 += ls1 * (1.0f / 16.0f); b1[i] = run1; }
        { f32x2_ t_; t_.x = run0; t_.y = run1; ((LAS f32x2_*)Ltot)[qtr * 128 + cp] = t_; }
        LDS_WAIT(); __syncthreads();
        float bl0, bl1;
        { const f32x2_ t0 = ((const LAS f32x2_*)Ltot)[cp], t1 = ((const LAS f32x2_*)Ltot)[128 + cp], t2 = ((const LAS f32x2_*)Ltot)[256 + cp], t3 = ((const LAS f32x2_*)Ltot)[384 + cp];
          const float o1x = t0.x, o2x = t0.x + t1.x, o3x = o2x + t2.x, o1y = t0.y, o2y = t0.y + t1.y, o3y = o2y + t2.y;
          bl0 = o3x + t3.x; bl1 = o3y + t3.y;
          const float off0 = qtr == 0 ? 0.f : qtr == 1 ? o1x : qtr == 2 ? o2x : o3x, off1 = qtr == 0 ? 0.f : qtr == 1 ? o1y : qtr == 2 ? o2y : o3y;
#pragma unroll
          for (int i = 0; i < 16; ++i) { b0[i] = off0 + b0[i]; b1[i] = off1 + b1[i]; } }
        LAS unsigned* ke = (LAS unsigned*)(lds + GL_KE + h * 8192 + (d >> 5) * 4096 + (d & 31) * 2);
        {
#pragma unroll
          for (int i = 0; i < 16; ++i) { const int t = qtr * 16 + i; ke[t * 16] = pk2(bflo(kraw[i]) * __expf(bl0 - b0[i]), bfhi(kraw[i]) * __expf(bl1 - b1[i])); }
#pragma unroll
          for (int i = 0; i < 16; ++i) { bf16* rowp = PA + (size_t)(row0 + qtr * 16 + i) * NPA + ch;
              *(unsigned*)(rowp + PA_K) = pg8::cvt_pk_bf16(bflo(kraw[i]) * __expf(-b0[i]), bfhi(kraw[i]) * __expf(-b1[i]));
              *(unsigned*)(rowp + PA_Q) = pg8::cvt_pk_bf16(bflo(qraw[i]) * 0.125f * __expf(b0[i]), bfhi(qraw[i]) * 0.125f * __expf(b1[i])); } }
        if (qtr == 3) { f32x2_ t_; t_.x = __expf(bl0); t_.y = __expf(bl1); *(f32x2_*)(DEC + ((size_t)(b * 4 + h) * 128 + c) * 64 + d) = t_; }
        asm volatile("s_waitcnt vmcnt(0)" ::: "memory"); LDS_WAIT(); __syncthreads();
        { const int hw = wave >> 1, nb = wave & 1;
          const unsigned lo_ = ((lane >> 4) & 1) * 32 + (lane & 3) * 8 + (8 * hi + ((lane & 15) >> 2)) * 64;
          const LAS unsigned char* kb = lds + GL_KE + hw * 8192 + nb * 4096 + lo_; const LAS unsigned char* vb = lds + GL_V + hw * 16384 + lo_;
          bf16x8 kf[4];
#pragma unroll
          for (int ks = 0; ks < 4; ++ks) { const s16x4 a = vtr(kb + ks * 1024), bq = vtr(kb + ks * 1024 + 256); kf[ks] = (bf16x8){a[0], a[1], a[2], a[3], bq[0], bq[1], bq[2], bq[3]}; }
          bf16* dsb = DS + ((size_t)(b * 4 + hw) * 128 + c) * 8192 + (size_t)r32 * 64 + nb * 32;
#pragma unroll
          for (int mb = 0; mb < 4; ++mb) { f32x16 acc = (f32x16){};
#pragma unroll
              for (int ks = 0; ks < 4; ++ks) { const s16x4 a = vtr(vb + mb * 4096 + ks * 1024), bq = vtr(vb + mb * 4096 + ks * 1024 + 256); const bf16x8 vf = {a[0], a[1], a[2], a[3], bq[0], bq[1], bq[2], bq[3]};
                  acc = __builtin_amdgcn_mfma_f32_32x32x16_bf16(kf[ks], vf, acc, 0, 0, 0); }
#pragma unroll
              for (int rg = 0; rg < 4; rg += 2) { v2u w, w2; w.x = cvtpk(acc[4 * rg], acc[4 * rg + 1]); w.y = cvtpk(acc[4 * rg + 2], acc[4 * rg + 3]); w2.x = cvtpk(acc[4 * rg + 4], acc[4 * rg + 5]); w2.y = cvtpk(acc[4 * rg + 6], acc[4 * rg + 7]);
                  st_pair16(dsb + (size_t)mb * 32 * 64 + 8 * rg, hi, w, w2); } } }
        __syncthreads();
    }
}
__device__ __forceinline__ void ph_gla_scan(Frame& F) {
    const bf16* __restrict__ DS = WSP(bf16, WS_DS); const float* __restrict__ DEC = WSP(float, WS_DEC); bf16* __restrict__ SP = WSP(bf16, WS_SP);
    typedef float f32x2_ __attribute__((ext_vector_type(2)));
    constexpr int NB_ = 32;
    if (F.tid >= 256) return;
#pragma unroll 1
    for (int i = blockIdx.x * 256 + F.tid; i < 16 * 128 * 32; i += F.G * 256) { const int dp = i & 31, e = (i >> 5) & 127, bh = i >> 12;
        const bf16* dsp = DS + (size_t)bh * 128 * 8192 + e * 64 + 2 * dp; const float* dcp = DEC + (size_t)bh * 128 * 64 + 2 * dp; bf16* spp = SP + (size_t)bh * 128 * 8192 + e * 64 + 2 * dp;
        float S0 = 0.f, S1 = 0.f; unsigned ds[NB_]; f32x2_ dc[NB_];
#pragma unroll
        for (int k = 0; k < NB_; ++k) { ds[k] = *(const unsigned*)(dsp + (size_t)k * 8192); dc[k] = *(const f32x2_*)(dcp + k * 64); }
#pragma unroll 1
        for (int c0 = 0; c0 < 128; c0 += NB_) { unsigned dn[NB_]; f32x2_ cn[NB_]; const int cn0 = c0 + NB_ < 128 ? c0 + NB_ : c0;
#pragma unroll
            for (int k = 0; k < NB_; ++k) { dn[k] = *(const unsigned*)(dsp + (size_t)(cn0 + k) * 8192); cn[k] = *(const f32x2_*)(dcp + (cn0 + k) * 64); }
#pragma unroll
            for (int k = 0; k < NB_; ++k) { *(unsigned*)(spp + (size_t)(c0 + k) * 8192) = pg8::cvt_pk_bf16(S0, S1); S0 = dc[k].x * S0 + bflo(ds[k]); S1 = dc[k].y * S1 + bfhi(ds[k]); }
#pragma unroll
            for (int k = 0; k < NB_; ++k) { ds[k] = dn[k]; dc[k] = cn[k]; } } }
}
__device__ __forceinline__ void ph_gla_out(Frame& F) {
    const bf16* __restrict__ PA = WSP(bf16, WS_R1); const bf16* __restrict__ SP = WSP(bf16, WS_SP); bf16* __restrict__ CAT = WSP(bf16, WS_CAT); const float* __restrict__ gh = in_ptr(I_AGHEAD);
    const int lane = F.lane, wave = F.wave, r32 = lane & 31, hi = lane >> 5;
    LAS unsigned char* lds = F.lds;
    typedef unsigned u32x4_t __attribute__((ext_vector_type(4)));
#pragma unroll 1
    for (int u = blockIdx.x; u < 512; u += F.G) {
        const int b = u >> 7, c = u & 127, row0 = b * T + c * 64, h = wave >> 1, tb = wave & 1, t = 32 * tb + r32;
        gla_dma_v(PA, row0, lds, wave, lane);
        bf16x8 qr[4], kf0[4];
#pragma unroll
        for (int ks = 0; ks < 4; ++ks) { qr[ks] = *(const bf16x8*)(PA + (size_t)(row0 + t) * NPA + PA_Q + h * 64 + 16 * ks + 8 * hi); kf0[ks] = *(const bf16x8*)(PA + (size_t)(row0 + r32) * NPA + PA_K + h * 64 + 16 * ks + 8 * hi); }
        f32x16 pT[2]; pT[0] = (f32x16){}; pT[1] = (f32x16){};
        if (tb == 1) { bf16x8 kf1[4];
#pragma unroll
            for (int ks = 0; ks < 4; ++ks) kf1[ks] = *(const bf16x8*)(PA + (size_t)(row0 + 32 + r32) * NPA + PA_K + h * 64 + 16 * ks + 8 * hi);
#pragma unroll
            for (int ks = 0; ks < 4; ++ks) pT[0] = __builtin_amdgcn_mfma_f32_32x32x16_bf16(kf0[ks], qr[ks], pT[0], 0, 0, 0);
#pragma unroll
            for (int ks = 0; ks < 4; ++ks) pT[1] = __builtin_amdgcn_mfma_f32_32x32x16_bf16(kf1[ks], qr[ks], pT[1], 0, 0, 0);
#pragma unroll
            for (int r = 0; r < 16; ++r) pT[1][r] = (crow(r, hi) <= r32) ? pT[1][r] : 0.f;
        } else {
#pragma unroll
            for (int ks = 0; ks < 4; ++ks) pT[0] = __builtin_amdgcn_mfma_f32_32x32x16_bf16(kf0[ks], qr[ks], pT[0], 0, 0, 0);
#pragma unroll
            for (int r = 0; r < 16; ++r) pT[0][r] = (crow(r, hi) <= r32) ? pT[0][r] : 0.f; }
        bf16x8 pa[4]; pack_p(pa, pT[0], pT[1]);
        f32x16 o[4];
        const bf16* spb = SP + ((size_t)(b * 4 + h) * 128 + c) * 8192 + (size_t)r32 * 64 + 8 * hi;
        { bf16x8 sf[4][4];
#pragma unroll
          for (int eb = 0; eb < 4; ++eb)
#pragma unroll
            for (int ks = 0; ks < 4; ++ks) sf[eb][ks] = *(const bf16x8*)(spb + (size_t)eb * 32 * 64 + 16 * ks);
#pragma unroll
          for (int eb = 0; eb < 4; ++eb) { o[eb] = (f32x16){};
#pragma unroll
            for (int ks = 0; ks < 4; ++ks) o[eb] = __builtin_amdgcn_mfma_f32_32x32x16_bf16(sf[eb][ks], qr[ks], o[eb], 0, 0, 0); } }
        const bf16* rp = PA + (size_t)(row0 + t) * NPA + PA_R + h * 128;
        v4u rw4[4][2];
#pragma unroll
        for (int eb = 0; eb < 4; ++eb)
#pragma unroll
            for (int rp2 = 0; rp2 < 2; ++rp2) rw4[eb][rp2] = *(const v4u*)(rp + 32 * eb + 16 * rp2 + 8 * hi);
        asm volatile("s_waitcnt vmcnt(0)" ::: "memory"); __syncthreads();
        { s16x4 vl[2][4], vh[2][4]; vfrag_issue<2>(vl, vh, lds + GL_V + h * 16384, lane); pv_frag<2>(o, vl, vh, pa);
          s16x4 vl2[2][4], vh2[2][4]; vfrag_issue<2>(vl2, vh2, lds + GL_V + h * 16384 + 8192, lane); pv_frag<2>(o + 2, vl2, vh2, pa); }
        float ss = 0.f;
#pragma unroll
        for (int eb = 0; eb < 4; ++eb)
#pragma unroll
            for (int r = 0; r < 16; ++r) ss += o[eb][r] * o[eb][r];
        ss += __shfl_xor(ss, 32);
        const float rs = __builtin_amdgcn_rsqf(ss * (1.0f / 128.0f) + 1e-6f);
        bf16* op = CAT + (size_t)(row0 + t) * 1024 + h * 128;
        v2u rw[4][4];
#pragma unroll
        for (int eb = 0; eb < 4; ++eb)
#pragma unroll
            for (int rp2 = 0; rp2 < 2; ++rp2) { const v4u w4 = rw4[eb][rp2];
                const auto r0 = __builtin_amdgcn_permlane32_swap(w4.x, w4.z, false, false); const auto r1 = __builtin_amdgcn_permlane32_swap(w4.y, w4.w, false, false);
                rw[eb][2 * rp2].x = r0[0]; rw[eb][2 * rp2].y = r1[0]; rw[eb][2 * rp2 + 1].x = r0[1]; rw[eb][2 * rp2 + 1].y = r1[1]; }
        f32x4 gv[4][4];
#pragma unroll
        for (int eb = 0; eb < 4; ++eb)
#pragma unroll
            for (int rg = 0; rg < 4; ++rg) gv[eb][rg] = *(const f32x4*)(gh + 32 * eb + 8 * rg + 4 * hi);
#pragma unroll
        for (int eb = 0; eb < 4; ++eb)
#pragma unroll
            for (int rg = 0; rg < 4; rg += 2) { v2u wp[2];
#pragma unroll
                for (int k = 0; k < 2; ++k) { const v2u w_ = rw[eb][rg + k]; const f32x4 g_ = gv[eb][rg + k]; const int r_ = 4 * (rg + k);
                    const float r0 = bflo(w_.x), r1 = bfhi(w_.x), r2 = bflo(w_.y), r3 = bfhi(w_.y);
                    const float y0 = o[eb][r_] * rs * g_.x * (r0 * pg8::sigmoid_f(r0)), y1 = o[eb][r_ + 1] * rs * g_.y * (r1 * pg8::sigmoid_f(r1)), y2 = o[eb][r_ + 2] * rs * g_.z * (r2 * pg8::sigmoid_f(r2)), y3 = o[eb][r_ + 3] * rs * g_.w * (r3 * pg8::sigmoid_f(r3));
                    wp[k].x = cvtpk(y0, y1); wp[k].y = cvtpk(y2, y3); }
                st_pair16(op + 32 * eb + 8 * rg, hi, wp[0], wp[1]); }
        __syncthreads();
    }
}
__device__ __forceinline__ void ph_ffn_fix(Frame& F, int layer) {
    typedef float f32x2_ __attribute__((ext_vector_type(2)));
    const float* __restrict__ bndA = WSP(float, WS_BND); const float* __restrict__ bndHA = WSP(float, WS_BND + BND_ONE); const float* __restrict__ bndHB = WSP(float, WS_BND + 2 * BND_ONE); bf16* __restrict__ H = WSP(bf16, WS_R1);
    const float* __restrict__ cw = in_ptr(I_CONVW) + (size_t)layer * 3 * FF; const float* __restrict__ cb = in_ptr(I_CONVB) + (size_t)layer * FF;
    const int gt = blockIdx.x * 512 + F.tid, NT = F.G * 512; constexpr int FP = FF / 2, NE = 512 * 2 * FP;
#pragma unroll 1
    for (int i0 = gt; i0 < NE; i0 += 4 * NT) {
        f32x2_ a0[4], pm1[4], pm2[4], h0[4], hb[4], w0[4], w1[4], w2[4], c0[4]; int fr_[4], G_[4], f_[4]; bool ok[4], first[4];
#pragma unroll
        for (int j = 0; j < 4; ++j) { const int idx = i0 + j * NT; ok[j] = idx < NE; const int id = ok[j] ? idx : 0; const int f = 2 * (id % FP), gr = id / FP, G = gr >> 1, fr = gr & 1; f_[j] = f; G_[j] = G; fr_[j] = fr; first[j] = (G & 127) == 0;
            const int Gp = first[j] ? G : G - 1; const size_t e = (size_t)gr * FF + f;
            a0[j] = *(const f32x2_*)(bndHA + e); hb[j] = *(const f32x2_*)(bndHB + e); pm1[j] = *(const f32x2_*)(bndA + ((size_t)Gp * 2 + 1) * FF + f); pm2[j] = *(const f32x2_*)(bndA + ((size_t)Gp * 2 + 0) * FF + f); h0[j] = *(const f32x2_*)(bndHA + ((size_t)G * 2) * FF + f);
            w0[j] = *(const f32x2_*)(cw + f); w1[j] = *(const f32x2_*)(cw + FF + f); w2[j] = *(const f32x2_*)(cw + 2 * FF + f); c0[j] = *(const f32x2_*)(cb + f); }
#pragma unroll
        for (int j = 0; j < 4; ++j) { if (!ok[j]) continue; float hv[2];
#pragma unroll
            for (int e = 0; e < 2; ++e) { const float p1 = first[j] ? 0.f : pm1[j][e], p2 = first[j] ? 0.f : pm2[j][e];
                const float a1 = fr_[j] ? h0[j][e] : p1, a2 = fr_[j] ? p1 : p2;
                const float cv = w0[j][e] * a2 + w1[j][e] * a1 + w2[j][e] * a0[j][e] + c0[j][e];
                hv[e] = cv / (1.0f + __expf(-cv)) * hb[j][e]; }
            *(unsigned*)(H + (size_t)(G_[j] * 64 + fr_[j]) * FF + f_[j]) = pk2(hv[0], hv[1]); }
    }
}
__device__ __forceinline__ void ph_cmp2(Frame& F) {
    const bf16* CH = WSP(bf16, WS_CH); bf16* KC = WSP(bf16, WS_KCMP); const bf16* W2 = WSP(bf16, WS_WC2);
    const int gw = blockIdx.x * NWAVES + F.wave, NGW = F.G * NWAVES, lane = F.lane, r32 = lane & 31, hi = lane >> 5;
#pragma unroll 1
    for (int u = gw; u < 512; u += NGW) { const int cb = u & 1, rb = (u >> 1) & 127, mlp = u >> 8;
        const bf16* ap = W2 + (size_t)(mlp * 64 + 32 * cb + r32) * 256 + 8 * hi; const bf16* bp = CH + ((size_t)mlp * 4096 + 32 * rb + r32) * 256 + 8 * hi;
        f32x16 acc = (f32x16){};
#pragma unroll
        for (int ks = 0; ks < 16; ++ks) acc = __builtin_amdgcn_mfma_f32_32x32x16_bf16(*(const bf16x8*)(ap + 16 * ks), *(const bf16x8*)(bp + 16 * ks), acc, 0, 0, 0);
        bf16* op = KC + ((size_t)mlp * 4096 + 32 * rb + r32) * 64 + 32 * cb;
#pragma unroll
        for (int rg = 0; rg < 4; rg += 2) { v2u w, w2; w.x = cvtpk(acc[4 * rg], acc[4 * rg + 1]); w.y = cvtpk(acc[4 * rg + 2], acc[4 * rg + 3]); w2.x = cvtpk(acc[4 * rg + 4], acc[4 * rg + 5]); w2.y = cvtpk(acc[4 * rg + 6], acc[4 * rg + 7]);
            st_pair16(op + 8 * rg, hi, w, w2); } }
}
__device__ __forceinline__ void ph_final(Frame& F, float* dst) {
    const float* __restrict__ SS = WSP(float, WS_SS); const float* gf = in_ptr(I_GFINAL);
    const int gw = blockIdx.x * NWAVES + F.wave, NGW = F.G * NWAVES, lane = F.lane;
    const bf16* __restrict__ XBp = WSP(bf16, WS_XB);
    f32x4 g[4];
#pragma unroll
    for (int j = 0; j < 4; ++j) g[j] = *((const f32x4*)gf + lane + 64 * j);
#pragma unroll 1
    for (int m0 = gw; m0 < M; m0 += 4 * NGW) {
        v2u xw[4][4]; f32x4 sv[4];
#pragma unroll
        for (int q = 0; q < 4; ++q) { const int m = (m0 + q * NGW) < M ? (m0 + q * NGW) : (M - 1); sv[q] = *(const f32x4*)(SS + (size_t)m * 16 + 4 * (lane & 3));
#pragma unroll
            for (int j = 0; j < 4; ++j) xw[q][j] = *((const GAS v2u*)(XBp + (size_t)m * D) + lane + 64 * j); }
#pragma unroll
        for (int q = 0; q < 4; ++q) { const int m = m0 + q * NGW; if (m >= M) break;
            float ssum = (sv[q].x + sv[q].y) + (sv[q].z + sv[q].w); ssum += __shfl_xor(ssum, 1); ssum += __shfl_xor(ssum, 2);
            const float rs = __builtin_amdgcn_rsqf(ssum * (1.0f / 1024.0f) + pg8::RMS_EPS);
#pragma unroll
            for (int j = 0; j < 4; ++j) { f32x4 o; o.x = bflo(xw[q][j].x) * rs * g[j].x; o.y = bfhi(xw[q][j].x) * rs * g[j].y; o.z = bflo(xw[q][j].y) * rs * g[j].z; o.w = bfhi(xw[q][j].y) * rs * g[j].w;
                ((GAS f32x4*)(dst + (size_t)m * D) + lane)[64 * j] = o; } }
    }
}

#ifndef MK_PHASE_LAUNCHES
#define MK_PHASE_LAUNCHES 0
#endif
constexpr int N_PHASES = 18;
#ifndef PH_MASK
#define PH_MASK 0x3ffff
#endif
#define PH_ON(k) (((PH_MASK) >> (k)) & 1)
struct Args { const float* in[26]; float* out; unsigned char* ws; int ph_lo, ph_hi; };
__global__ void __launch_bounds__(NWAVES * 64, 2) yoco_fwd(Args args) {
    extern __shared__ __attribute__((aligned(16))) unsigned char lds[];
    Frame F;
    F.lds = (LAS unsigned char*)lds;
    F.MISC = (volatile LAS unsigned*)(F.lds + MISC_OFF);
    F.tid = threadIdx.x; F.lane = F.tid & 63; F.wave = __builtin_amdgcn_readfirstlane(F.tid >> 6);
    F.G = gridDim.x;
    F.out = args.out; F.ws = args.ws; F.ctl = (gu32*)(args.ws + WS_CTL);
    for (int u = F.tid; u < (LDS_BYTES - LDSCTL_OFF) / 4; u += NWAVES * 64) ((LAS unsigned*)(F.lds + LDSCTL_OFF))[u] = 0u;
    __syncthreads();
    XcdBarrier bar; bar.bar = (unsigned*)(F.ctl + CW_BAR); bar.x = 0; bar.st = nullptr;
    if (!MK_PHASE_LAUNCHES) bar = xcd_barrier_post((unsigned*)(F.ctl + CW_BAR), F.MISC + 8);
    using pg8::Gemm; using pg8::StaticOrder;
    const int bx = (int)blockIdx.x;
#pragma unroll 1
    for (int p = args.ph_lo; p < args.ph_hi; ++p) {
        { int t_ = threadIdx.x; asm volatile("" : "+v"(t_)); F.tid = t_; F.lane = t_ & 63; F.wave = __builtin_amdgcn_readfirstlane(t_ >> 6); }
        { GAS unsigned char* w_ = (GAS unsigned char*)args.ws; int g_ = gridDim.x; asm volatile("" : "+s"(w_), "+s"(g_)); F.ws = (unsigned char*)w_; F.G = g_; }
        bf16* const XB = WSP(bf16, WS_XB); bf16* const CAT = WSP(bf16, WS_CAT); float* const SS = WSP(float, WS_SS); bf16* const R1 = WSP(bf16, WS_R1);
        switch (p) {
        case 0: if (PH_ON(0)) p0_prologue(F); break;
        case 1:
#pragma unroll 1
            for (int s = 0; s < 2 * PH_ON(1); ++s) {
                Gemm g = s ? Gemm{WSP(bf16, WS_MEMB), WSP(bf16, WS_WM), MROWS, 2048, D, D} : Gemm{XB, WSP(bf16, WS_WA), M, NPA, D, D};
                StaticOrder S; S.init(g.M, g.N, F.G, s ? (bx + 128) % F.G : bx);
                pg8::EpiScaleBf16 E = s ? pg8::EpiScaleBf16{WSP(bf16, WS_MKV), 2048, WSP(float, WS_SSM), 0, 0, 1.0f} : pg8::EpiScaleBf16{R1, NPA, SS, PA_MQ / 256, PA_MQ / 256 + 2, MEM_QSCALE};
                pg8::gemm_phase<pg8::EpiScaleBf16, StaticOrder, true, true>(F.lds, g, S, E);
            }
            if (PH_ON(1) && F.G == 256 && bx >= 160) tr_items(F, (LAS float*)(F.lds + F.wave * 16384), (bx - 160) * NWAVES + F.wave, 96 * NWAVES, TR_NP0, TR_NITEMS, F.lane);
            if (PH_ON(1) && bx == F.G - 1) bias1_reduce(F);
            break;
        case 2: if (PH_ON(2)) { ph_gla_local(F); ph_memattn_mfma(F, R1, NPA, PA_MQ, 0, bx, F.G); } break;
        case 3: if (PH_ON(3)) ph_gla_scan(F); break;
        case 4: if (PH_ON(4)) ph_gla_out(F); break;
        case 5: case 8: case 13: case 16: if (PH_ON(5)) {
            const bool ffn = (p == 8 || p == 16); const int layer = p > 8 ? 1 : 0;
            Gemm g = ffn ? Gemm{R1, WSP(bf16, WS_WD) + (size_t)layer * D * FF, M, D, FF, FF} : Gemm{CAT, WSP(bf16, layer ? WS_WOB : WS_WOA), M, D, D, D};
            StaticOrder S; S.init(M, D, F.G, bx);
            if (p == 16 && F.G == 256) {
                pg8::EpiFinal E{XB, SS, F.out, in_ptr(I_GFINAL), (unsigned*)(F.ctl + CW_PANEL)};
                pg8::gemm_phase<pg8::EpiFinal, StaticOrder, true, true>(F.lds, g, S, E);
                break; }
            pg8::EpiResid E{XB, SS};
            pg8::gemm_phase<pg8::EpiResid, StaticOrder, true, true>(F.lds, g, S, E);
            break; }
        case 6: case 14: if (PH_ON(6)) {
            const int layer = p == 14 ? 1 : 0;
            Gemm g{XB, WSP(bf16, WS_WU) + (size_t)layer * 2 * FF * D, M, 2 * FF, D, D}; StaticOrder S; S.init(M, 2 * FF, F.G, bx);
            pg8::EpiUp E{R1, SS, in_ptr(I_CONVW) + (size_t)layer * 3 * FF, in_ptr(I_CONVB) + (size_t)layer * FF, WSP(float, WS_BND), WSP(float, WS_BND + BND_ONE), WSP(float, WS_BND + 2 * BND_ONE)};
            pg8::gemm_phase<pg8::EpiUp, StaticOrder, true, true>(F.lds, g, S, E);
            break; }
        case 7: case 15: if (PH_ON(7)) ph_ffn_fix(F, p == 15 ? 1 : 0); break;
        case 9: if (PH_ON(9)) {
            Gemm g{XB, WSP(bf16, WS_WB), M, NG5, D, D}; StaticOrder S; S.init(M, NG5, F.G, bx); pg8::EpiProjB E{WSP(bf16, WS_KVC), R1, SS};
            pg8::gemm_phase<pg8::EpiProjB, StaticOrder, true, true>(F.lds, g, S, E);
            break; }
        case 10:
#pragma unroll 1
            for (int s = 0; s < 2 * PH_ON(10); ++s) {
                Gemm g{WSP(bf16, WS_KVC) + (size_t)s * KVSTRIDE, WSP(bf16, WS_WC1) + (size_t)s * 256 * 2048, 4096, 256, 2048, 1024};
                StaticOrder S; S.init(4096, 256, F.G, s ? (bx + 240) % F.G : bx);
                pg8::EpiGelu E{WSP(bf16, WS_CH) + (size_t)s * 4096 * 256, WSP(float, WS_BIAS1) + s * 256};
                pg8::gemm_phase<pg8::EpiGelu, StaticOrder, true, true>(F.lds, g, S, E);
            }
            __syncthreads();
            if (PH_ON(10)) { if (F.G > 64) { if (bx >= 32) ph_memattn_mfma(F, R1, NPB, PB_MQ, 1, bx - 32, F.G - 32); }
                             else ph_memattn_mfma(F, R1, NPB, PB_MQ, 1, bx, F.G); }
            break;
        case 11: if (PH_ON(11)) ph_cmp2(F); break;
        case 12: if (PH_ON(12)) ph_nsa_mfma(F); break;
        case 17: if (PH_ON(17) && F.G != 256) ph_final(F, F.out); break;
        default: break;
        }
        if (p + 1 < args.ph_hi && !(p == 16 && F.G == 256)) xcd_barrier(bar);
    }
}

extern "C" void kernel_launch(void* const* d_in, const int* in_sizes, int n_in, void* d_out, int out_size, void* d_ws, size_t ws_size, hipStream_t stream) {
    static int grid = 0;
    if (grid == 0) {
        if (n_in != 26 || in_sizes[0] != M * D || out_size != M * D || ws_size < WS_END) { fprintf(stderr, "kernel_launch: unexpected shapes (n_in %d, in0 %d, out %d, ws %zu); nothing launched\n", n_in, n_in > 0 ? in_sizes[0] : -1, out_size, ws_size); grid = -1; return; }
        int dev = 0, cus = 0, per_cu = 0;
        if (hipGetDevice(&dev) != hipSuccess || hipDeviceGetAttribute(&cus, hipDeviceAttributeMultiprocessorCount, dev) != hipSuccess) { grid = -1; return; }
        if (hipFuncSetAttribute((const void*)yoco_fwd, hipFuncAttributeMaxDynamicSharedMemorySize, LDS_BYTES) != hipSuccess) { fprintf(stderr, "kernel_launch: hipFuncSetAttribute failed\n"); grid = -1; return; }
        if (hipOccupancyMaxActiveBlocksPerMultiprocessor(&per_cu, (const void*)yoco_fwd, NWAVES * 64, LDS_BYTES) != hipSuccess || per_cu < 1) { fprintf(stderr, "kernel_launch: occupancy query reports %d blocks per CU\n", per_cu); (void)hipGetLastError(); grid = -1; return; }
        grid = cus;
        if (grid > 256) grid = 256;
    }
    if (grid < 0) return;
    (void)hipMemsetAsync((char*)d_ws + WS_CTL, 0, CTL_ZERO_BYTES, stream);
    Args a{};
    for (int i = 0; i < 26; ++i) a.in[i] = (const float*)d_in[i];
    a.out = (float*)d_out; a.ws = (unsigned char*)d_ws;
#if MK_PHASE_LAUNCHES
    for (int p = 0; p < N_PHASES; ++p) { a.ph_lo = p; a.ph_hi = p + 1; hipLaunchKernelGGL(yoco_fwd, dim3(grid), dim3(NWAVES * 64), LDS_BYTES, stream, a); }
#else
    a.ph_lo = 0; a.ph_hi = N_PHASES;
    hipLaunchKernelGGL(yoco_fwd, dim3(grid), dim3(NWAVES * 64), LDS_BYTES, stream, a);
#endif
    const hipError_t le = hipPeekAtLastError();
    if (le != hipSuccess) fprintf(stderr, "kernel_launch: launch failed: %s\n", hipGetErrorName(le));
}
```

```cpp
#include <hip/hip_runtime.h>
#include <cstdio>
#include <cstdint>
namespace pg8 {
#define PG8_LAS __attribute__((address_space(3)))
typedef unsigned short bf16_t;
typedef short bf16x8 __attribute__((ext_vector_type(8)));
typedef float f32x4 __attribute__((ext_vector_type(4)));
typedef unsigned u32x4 __attribute__((ext_vector_type(4)));
typedef unsigned u32x2 __attribute__((ext_vector_type(2)));
constexpr int BM = 256, BK = 64, HALF = 128, HTB = HALF * BK * 2  , STAGE_BYTES = 8 * HTB, NXCD = 8, WGM = 8;

__host__ __device__ __forceinline__ int lds_byte(int r, int c) { const int st = (r >> 4) * 2 + (c >> 5), rr = r & 15, cc = c & 31, ob = rr * 64 + cc * 2; return st * 1024 + (ob ^ (((ob >> 9) & 1) << 5)); }
__host__ __device__ __forceinline__ void stage_rc(int b, int& R, int& C) { const int st = b / 1024, sb = b % 1024, swz = sb ^ (((sb >> 9) & 1) << 5); R = (st >> 1) * 16 + swz / 64; C = (st & 1) * 32 + (swz % 64) / 2; }
__host__ __device__ __forceinline__ int perm32(int rho) { const int n = rho >> 4, i = rho & 15; return 8 * (i >> 2) + 4 * n + (i & 3); }

struct Unit { int pm, pn; };
struct Gemm { const bf16_t* A; const bf16_t* Bt; int M, N, K, lda; };

struct StaticOrder {
    int nM, nN, nwg, G, c;
    __host__ __device__ void init(int M, int N, int G_, int c_) { nM = M / BM; nN = N / BM; nwg = nM * nN; G = G_; c = c_; }
    __host__ __device__ bool next(int i, Unit& u) const {
        const long L = (long)i * G + c; if (L >= nwg) return false;
        int wgid = (int)L; { const int q = nwg / NXCD, r = nwg % NXCD, xcd = wgid % NXCD, off = wgid / NXCD; wgid = (xcd < r ? xcd * (q + 1) : r * (q + 1) + (xcd - r) * q) + off; }
        const int nig = WGM * nN, gid = wgid / nig, fm = gid * WGM, gsz = (nM - fm) < WGM ? (nM - fm) : WGM;
        u.pm = fm + ((wgid % nig) % gsz); u.pn = (wgid % nig) / gsz; return true;
    }
    __device__ __forceinline__ void a_ready(const Unit&) const {}
    __device__ __forceinline__ void done(const Unit&) const {}
};


typedef float f32x2c __attribute__((ext_vector_type(2))); typedef __bf16 bf16x2c __attribute__((ext_vector_type(2)));
__device__ __forceinline__ unsigned cvt_pk_bf16(float lo, float hi) { const f32x2c v = {lo, hi}; return __builtin_bit_cast(unsigned, __builtin_convertvector(v, bf16x2c)); }
constexpr float RMS_EPS = 1e-6f;
__device__ __forceinline__ float rstd_row(const float* SS, int row) {
    const f32x4* p = (const f32x4*)(SS + (size_t)row * 16); const f32x4 a = p[0], b = p[1], c = p[2], d = p[3];
    const float s = (((a.x + a.y) + (a.z + a.w)) + ((b.x + b.y) + (b.z + b.w))) + (((c.x + c.y) + (c.z + c.w)) + ((d.x + d.y) + (d.z + d.w)));
    return 1.0f / sqrtf(s * (1.0f / 1024.0f) + RMS_EPS);
}
__device__ __forceinline__ float sigmoid_f(float x) { return __builtin_amdgcn_rcpf(1.0f + __expf(-x)); }

__device__ __forceinline__ void rstd8(float (&rs)[2][4], const char* ssb0  , unsigned ls  , int lane) {
    f32x4 a[8];
#pragma unroll
    for (int i = 0; i < 8; ++i) a[i] = *(const f32x4*)(ssb0 + (size_t)((i >> 2) * HALF + (i & 3) * 16) * 64 + ls);
    float sv[8], tv[8];
#pragma unroll
    for (int i = 0; i < 8; ++i) sv[i] = (a[i].x + a[i].y) + (a[i].z + a[i].w);
    const int x16 = (lane ^ 16) * 4, x32 = (lane ^ 32) * 4;
#pragma unroll
    for (int i = 0; i < 8; ++i) tv[i] = __int_as_float(__builtin_amdgcn_ds_bpermute(x16, __float_as_int(sv[i])));
#pragma unroll
    for (int i = 0; i < 8; ++i) sv[i] += tv[i];
#pragma unroll
    for (int i = 0; i < 8; ++i) tv[i] = __int_as_float(__builtin_amdgcn_ds_bpermute(x32, __float_as_int(sv[i])));
#pragma unroll
    for (int i = 0; i < 8; ++i) rs[i >> 2][i & 3] = __builtin_amdgcn_rsqf((sv[i] + tv[i]) * (1.0f / 1024.0f) + RMS_EPS);
}
__device__ __forceinline__ u32x4 pack8(const f32x4 v0, const f32x4 v1) { u32x4 w; w.x = cvt_pk_bf16(v0[0], v0[1]); w.y = cvt_pk_bf16(v0[2], v0[3]); w.z = cvt_pk_bf16(v1[0], v1[1]); w.w = cvt_pk_bf16(v1[2], v1[3]); return w; }

struct EpiScaleBf16 {
    static constexpr bool PERM = true, AFTER_DRAIN = false;
    bf16_t* O; int ldc; const float* SS; int sc_from, sc_to; float sc;
    int pad_pn, pad_cols;
    __device__ __forceinline__ void operator()(f32x4 (&acc)[2][2][4][2], const Unit& u, int wr, int wc, int fr, int fq) const {
        asm volatile("" : "+v"(fr), "+v"(fq));
        const unsigned lrow = wr * 64 + fr; const unsigned lo = lrow * (unsigned)ldc * 2u + (unsigned)(wc * 32 + 8 * fq) * 2u, ls = lrow * 64u + (unsigned)fq * 16u;
        float rs[2][4]; rstd8(rs, (const char*)SS + (size_t)(u.pm * BM) * 64, ls, fr + 16 * fq);
        const float xs = (u.pn >= sc_from && u.pn < sc_to) ? sc : 1.0f;
        const int ncol = (u.pn == pad_pn) ? pad_cols : BM;
#pragma unroll
        for (int ai = 0; ai < 2; ++ai)
#pragma unroll
            for (int m = 0; m < 4; ++m) { const int urow = u.pm * BM + ai * HALF + m * 16; char* ob = (char*)O + ((size_t)urow * ldc + u.pn * BM) * 2; const float r_ = rs[ai][m] * xs;
#pragma unroll
                for (int bj = 0; bj < 2; ++bj) if (bj * HALF + wc * 32 + 8 * fq < ncol) *(u32x4*)(ob + lo + bj * HALF * 2) = pack8(acc[ai][bj][m][0] * r_, acc[ai][bj][m][1] * r_); }
    }
};

struct EpiResid {
    static constexpr bool PERM = true, AFTER_DRAIN = false;
    bf16_t* xb; float* SS;
    __device__ __forceinline__ void operator()(f32x4 (&acc)[2][2][4][2], const Unit& u, int wr, int wc, int fr, int fq) const {
        asm volatile("" : "+v"(fr), "+v"(fq));
        const unsigned lrow = wr * 64 + fr; const unsigned lo = lrow * 2048u + (unsigned)(wc * 32 + 8 * fq) * 2u, ls = lrow * 64u + (unsigned)wc * 4u;
        char* const xb0 = (char*)xb + (size_t)(u.pm * BM) * 2048 + (size_t)u.pn * 512;
        u32x4 rw[2][4][2];
#pragma unroll
        for (int ai = 0; ai < 2; ++ai)
#pragma unroll
            for (int m = 0; m < 4; ++m)
#pragma unroll
                for (int bj = 0; bj < 2; ++bj) rw[ai][m][bj] = *(const u32x4*)(xb0 + (size_t)(ai * HALF + m * 16) * 2048 + lo + bj * 256);
#pragma unroll
        for (int ai = 0; ai < 2; ++ai)
#pragma unroll
            for (int m = 0; m < 4; ++m) { const int urow = u.pm * BM + ai * HALF + m * 16; float ssq = 0.f;
#pragma unroll
                for (int bj = 0; bj < 2; ++bj) { const u32x4 r = rw[ai][m][bj];
                    f32x4 o0 = acc[ai][bj][m][0], o1 = acc[ai][bj][m][1];
                    o0[0] += __uint_as_float(r.x << 16); o0[1] += __uint_as_float(r.x & 0xffff0000u); o0[2] += __uint_as_float(r.y << 16); o0[3] += __uint_as_float(r.y & 0xffff0000u);
                    o1[0] += __uint_as_float(r.z << 16); o1[1] += __uint_as_float(r.z & 0xffff0000u); o1[2] += __uint_as_float(r.w << 16); o1[3] += __uint_as_float(r.w & 0xffff0000u);
                    ssq += ((o0[0] * o0[0] + o0[1] * o0[1]) + (o0[2] * o0[2] + o0[3] * o0[3])) + ((o1[0] * o1[0] + o1[1] * o1[1]) + (o1[2] * o1[2] + o1[3] * o1[3]));
                    *(u32x4*)(xb0 + (size_t)(ai * HALF + m * 16) * 2048 + lo + bj * 256) = pack8(o0, o1); }
                ssq += __shfl_xor(ssq, 16); ssq += __shfl_xor(ssq, 32);
                if (fq == 0) *(float*)((char*)SS + (size_t)urow * 64 + u.pn * 16 + ls) = ssq; }
    }
};

struct EpiFinal {
    static constexpr bool PERM = true, AFTER_DRAIN = false;
    const bf16_t* xb; float* SS; float* out; const float* gf; unsigned* cnt;
    __device__ __forceinline__ void operator()(f32x4 (&acc)[2][2][4][2], const Unit& u, int wr, int wc, int fr, int fq) const {
        asm volatile("" : "+v"(fr), "+v"(fq));
        const unsigned lrow = wr * 64 + fr; const unsigned lo = lrow * 2048u + (unsigned)(wc * 32 + 8 * fq) * 2u, ls = lrow * 64u + (unsigned)wc * 4u;
        const char* const xb0 = (const char*)xb + (size_t)(u.pm * BM) * 2048 + (size_t)u.pn * 512;
        u32x4 rw[2][4][2];
#pragma unroll
        for (int ai = 0; ai < 2; ++ai)
#pragma unroll
            for (int m = 0; m < 4; ++m)
#pragma unroll
                for (int bj = 0; bj < 2; ++bj) rw[ai][m][bj] = *(const u32x4*)(xb0 + (size_t)(ai * HALF + m * 16) * 2048 + lo + bj * 256);
#pragma unroll
        for (int ai = 0; ai < 2; ++ai)
#pragma unroll
            for (int m = 0; m < 4; ++m) { const int urow = u.pm * BM + ai * HALF + m * 16; float ssq = 0.f;
#pragma unroll
                for (int bj = 0; bj < 2; ++bj) { const u32x4 r = rw[ai][m][bj];
                    f32x4 o0 = acc[ai][bj][m][0], o1 = acc[ai][bj][m][1];
                    o0[0] += __uint_as_float(r.x << 16); o0[1] += __uint_as_float(r.x & 0xffff0000u); o0[2] += __uint_as_float(r.y << 16); o0[3] += __uint_as_float(r.y & 0xffff0000u);
                    o1[0] += __uint_as_float(r.z << 16); o1[1] += __uint_as_float(r.z & 0xffff0000u); o1[2] += __uint_as_float(r.w << 16); o1[3] += __uint_as_float(r.w & 0xffff0000u);
                    ssq += ((o0[0] * o0[0] + o0[1] * o0[1]) + (o0[2] * o0[2] + o0[3] * o0[3])) + ((o1[0] * o1[0] + o1[1] * o1[1]) + (o1[2] * o1[2] + o1[3] * o1[3]));
                    acc[ai][bj][m][0] = o0; acc[ai][bj][m][1] = o1; }
                ssq += __shfl_xor(ssq, 16); ssq += __shfl_xor(ssq, 32);
                if (fq == 0) __hip_atomic_store((float*)((char*)SS + (size_t)urow * 64 + u.pn * 16 + ls), ssq, __ATOMIC_RELAXED, __HIP_MEMORY_SCOPE_AGENT); }
        asm volatile("s_waitcnt vmcnt(0)" ::: "memory");
        __builtin_amdgcn_s_barrier();
        if ((fr | fq | wr | wc) == 0) { unsigned* c = cnt + u.pm * 16; __hip_atomic_fetch_add(c, 1u, __ATOMIC_RELAXED, __HIP_MEMORY_SCOPE_AGENT);
            for (int spin = 0; spin < (1 << 22) && __hip_atomic_load(c, __ATOMIC_RELAXED, __HIP_MEMORY_SCOPE_AGENT) < 4u; ++spin) __builtin_amdgcn_s_sleep(1); }
        __builtin_amdgcn_s_barrier();
        asm volatile("" ::: "memory");
        const unsigned lq = lrow * 64u + (unsigned)fq * 16u;
        const char* const ssb0 = (const char*)SS + (size_t)(u.pm * BM) * 64;
        unsigned long long pa[8][2];
#pragma unroll
        for (int i = 0; i < 8; ++i) { const unsigned long long* p = (const unsigned long long*)(ssb0 + (size_t)((i >> 2) * HALF + (i & 3) * 16) * 64 + lq);
            pa[i][0] = __hip_atomic_load(p, __ATOMIC_RELAXED, __HIP_MEMORY_SCOPE_AGENT); pa[i][1] = __hip_atomic_load(p + 1, __ATOMIC_RELAXED, __HIP_MEMORY_SCOPE_AGENT); }
        f32x4 gv[2][2];
#pragma unroll
        for (int bj = 0; bj < 2; ++bj) { const char* gp = (const char*)gf + (size_t)u.pn * 1024 + bj * 512 + (unsigned)(wc * 32 + 8 * fq) * 4u; gv[bj][0] = *(const f32x4*)gp; gv[bj][1] = *(const f32x4*)(gp + 16); }
        float sv[8], tv[8];
#pragma unroll
        for (int i = 0; i < 8; ++i) sv[i] = (__uint_as_float((unsigned)pa[i][0]) + __uint_as_float((unsigned)(pa[i][0] >> 32))) + (__uint_as_float((unsigned)pa[i][1]) + __uint_as_float((unsigned)(pa[i][1] >> 32)));
        const int lane = fr + 16 * fq, x16 = (lane ^ 16) * 4, x32 = (lane ^ 32) * 4;
#pragma unroll
        for (int i = 0; i < 8; ++i) tv[i] = __int_as_float(__builtin_amdgcn_ds_bpermute(x16, __float_as_int(sv[i])));
#pragma unroll
        for (int i = 0; i < 8; ++i) sv[i] += tv[i];
#pragma unroll
        for (int i = 0; i < 8; ++i) tv[i] = __int_as_float(__builtin_amdgcn_ds_bpermute(x32, __float_as_int(sv[i])));
        char* const ob0 = (char*)out + (size_t)(u.pm * BM) * 4096 + (size_t)u.pn * 1024;
        const unsigned loo = lrow * 4096u + (unsigned)(wc * 32 + 8 * fq) * 4u;
#pragma unroll
        for (int ai = 0; ai < 2; ++ai)
#pragma unroll
            for (int m = 0; m < 4; ++m) { const float rs = __builtin_amdgcn_rsqf((sv[ai * 4 + m] + tv[ai * 4 + m]) * (1.0f / 1024.0f) + RMS_EPS);
#pragma unroll
                for (int bj = 0; bj < 2; ++bj) { char* op = ob0 + (size_t)(ai * HALF + m * 16) * 4096 + loo + bj * 512;
                    *(f32x4*)op = acc[ai][bj][m][0] * rs * gv[bj][0]; *(f32x4*)(op + 16) = acc[ai][bj][m][1] * rs * gv[bj][1]; } }
    }
};

struct EpiUp {
    static constexpr bool PERM = true, AFTER_DRAIN = false;
    bf16_t* H; const float* SS; const float* cw; const float* cb; float* bndA; float* bndHA; float* bndHB;
    __device__ __forceinline__ static f32x4 ror1(const f32x4 v) { f32x4 r;
#pragma unroll
        for (int e = 0; e < 4; ++e) r[e] = __int_as_float(__builtin_amdgcn_update_dpp(0, __float_as_int(v[e]), 0x121, 0xf, 0xf, false)); return r; }
    __device__ __forceinline__ static f32x4 ror2(const f32x4 v) { f32x4 r;
#pragma unroll
        for (int e = 0; e < 4; ++e) r[e] = __int_as_float(__builtin_amdgcn_update_dpp(0, __float_as_int(v[e]), 0x122, 0xf, 0xf, false)); return r; }
    __device__ __forceinline__ void operator()(f32x4 (&acc)[2][2][4][2], const Unit& u, int wr, int wc, int fr, int fq) const {
        asm volatile("" : "+v"(fr), "+v"(fq));
        constexpr int FF = 2816;
        const unsigned lch = (unsigned)(wc * 32 + 8 * fq);
        const unsigned lrow = wr * 64 + fr, ls = lrow * 64u + (unsigned)fq * 16u, lh = lrow * (unsigned)(FF * 2) + lch * 2u;
        const unsigned lb = (unsigned)(fr & 1) * (unsigned)(FF * 4) + lch * 4u;
        const char* cwb = (const char*)cw + (size_t)u.pn * 512; const char* cbb = (const char*)cb + (size_t)u.pn * 512;
        const bool f1 = fr >= 1, f2 = fr >= 2;
        float rsa[2][4]; f32x4 cwv[2][4];
        rstd8(rsa, (const char*)SS + (size_t)(u.pm * BM) * 64, ls, fr + 16 * fq);
#pragma unroll
        for (int n = 0; n < 2; ++n) { cwv[n][0] = *(const f32x4*)(cwb + lch * 4u + n * 16); cwv[n][1] = *(const f32x4*)(cwb + lch * 4u + FF * 4 + n * 16); cwv[n][2] = *(const f32x4*)(cwb + lch * 4u + 2 * FF * 4 + n * 16); cwv[n][3] = *(const f32x4*)(cbb + lch * 4u + n * 16); }
#pragma unroll
        for (int ai = 0; ai < 2; ++ai) {
            const int urow = u.pm * BM + ai * HALF; const int G = (urow >> 6) + wr;
            float rs[4];
#pragma unroll
            for (int m = 0; m < 4; ++m) rs[m] = rsa[ai][m];
            const size_t ub = ((size_t)G * 2 * FF + (size_t)u.pn * 128) * 4;
            char* const pA = (char*)bndA + ub; char* const pHA = (char*)bndHA + ub; char* const pHB = (char*)bndHB + ub;
            if (fr >= 14) { *(f32x4*)(pA + lb) = acc[ai][0][3][0] * rs[3]; *(f32x4*)(pA + lb + 16) = acc[ai][0][3][1] * rs[3]; }
            if (fr < 2) { *(f32x4*)(pHA + lb) = acc[ai][0][0][0] * rs[0]; *(f32x4*)(pHA + lb + 16) = acc[ai][0][0][1] * rs[0]; *(f32x4*)(pHB + lb) = acc[ai][1][0][0] * rs[0]; *(f32x4*)(pHB + lb + 16) = acc[ai][1][0][1] * rs[0]; }
#pragma unroll
            for (int n = 0; n < 2; ++n) {
                const f32x4 w0 = cwv[n][0], w1 = cwv[n][1], w2 = cwv[n][2], cbv = cwv[n][3];
                f32x4 r1p = (f32x4){0.f, 0.f, 0.f, 0.f}, r2p = r1p;
#pragma unroll
                for (int m = 0; m < 4; ++m) {
                    const f32x4 am = acc[ai][0][m][n] * rs[m], bm = acc[ai][1][m][n] * rs[m];
                    const f32x4 r1 = ror1(am), r2 = ror2(am); f32x4 p1, p2;
#pragma unroll
                    for (int e = 0; e < 4; ++e) { p1[e] = f1 ? r1[e] : r1p[e]; p2[e] = f2 ? r2[e] : r2p[e]; }
                    const f32x4 cv = w0 * p2 + w1 * p1 + w2 * am + cbv; f32x4 hv;
#pragma unroll
                    for (int e = 0; e < 4; ++e) hv[e] = cv[e] * sigmoid_f(cv[e]) * bm[e];
                    acc[ai][0][m][n] = hv; r1p = r1; r2p = r2; }
                asm volatile("" : "+v"(acc[ai][0][0][n]), "+v"(acc[ai][0][1][n]), "+v"(acc[ai][0][2][n]), "+v"(acc[ai][0][3][n]) :: "memory");
            }
            char* const hb = (char*)H + ((size_t)urow * FF + (size_t)u.pn * 128) * 2;
#pragma unroll
            for (int m = 0; m < 4; ++m) { if (m == 0 && fr < 2) continue;
                *(u32x4*)(hb + lh + m * 16 * FF * 2) = pack8(acc[ai][0][m][0], acc[ai][0][m][1]); }
            asm volatile("" ::: "memory");
        }
    }
};

struct EpiProjB {
    static constexpr bool PERM = true, AFTER_DRAIN = false;
    bf16_t* kvc; bf16_t* PB; const float* SS;
    __device__ __forceinline__ void operator()(f32x4 (&acc)[2][2][4][2], const Unit& u, int wr, int wc, int fr, int fq) const {
        asm volatile("" : "+v"(fr), "+v"(fq));
        constexpr size_t KVSTRIDE = (size_t)8 * 8192 * 64;
        const unsigned lrow = wr * 64 + fr, ls = lrow * 64u + (unsigned)fq * 16u;
        const unsigned lkv = lrow * 128u + (unsigned)((wc & 1) * 32 + 8 * fq) * 2u, lpb = lrow * 2560u + (unsigned)(wc * 32 + 8 * fq) * 2u;
        const int g = wc >> 1, b = u.pm >> 5;
        float rsa[2][4]; rstd8(rsa, (const char*)SS + (size_t)(u.pm * BM) * 64, ls, fr + 16 * fq);
        const float xs = (u.pn == 3 || u.pn == 4) ? 0.125f * 1.4426950408889634f : ((u.pn == 5 || u.pn == 6) ? 0.08838834764831845f * 1.4426950408889634f : 1.0f);
#pragma unroll
        for (int ai = 0; ai < 2; ++ai)
#pragma unroll
            for (int m = 0; m < 4; ++m) { const int urow = u.pm * BM + ai * HALF + m * 16; const float rs = rsa[ai][m] * xs;
#pragma unroll
                for (int bj = 0; bj < 2; ++bj) { const u32x4 w = pack8(acc[ai][bj][m][0] * rs, acc[ai][bj][m][1] * rs);
                    if (u.pn == 7 && bj * HALF + wc * 32 + 8 * fq >= 24) continue;
                    if (u.pn < 3) *(u32x4*)((char*)kvc + ((size_t)(u.pn * 2 + bj) * KVSTRIDE + ((size_t)urow + (size_t)(b + g) * 8192) * 64) * 2 + lkv) = w;
                    else *(u32x4*)((char*)PB + ((size_t)urow * 1280 + (size_t)(u.pn - 3) * 256 + bj * HALF) * 2 + lpb) = w; } }
    }
};

struct EpiGelu {
    static constexpr bool PERM = true, AFTER_DRAIN = false;
    bf16_t* O; const float* bias;
    __device__ __forceinline__ static float gelu_t(float x) { const float u2 = 1.5957691216f * (x + 0.044715f * x * x * x); return x * sigmoid_f(u2); }
    __device__ __forceinline__ void operator()(f32x4 (&acc)[2][2][4][2], const Unit& u, int wr, int wc, int fr, int fq) const {
        asm volatile("" : "+v"(fr), "+v"(fq));
        const unsigned lrow = wr * 64 + fr, lc = (unsigned)(wc * 32 + 8 * fq), lo = lrow * 512u + lc * 2u;
        f32x4 bv[2][2];
#pragma unroll
        for (int bj = 0; bj < 2; ++bj) { bv[bj][0] = *(const f32x4*)((const char*)bias + lc * 4u + bj * 512); bv[bj][1] = *(const f32x4*)((const char*)bias + lc * 4u + bj * 512 + 16); }
#pragma unroll
        for (int ai = 0; ai < 2; ++ai)
#pragma unroll
            for (int m = 0; m < 4; ++m) { char* ob = (char*)O + (size_t)(u.pm * BM + ai * HALF + m * 16) * 512;
#pragma unroll
                for (int bj = 0; bj < 2; ++bj) { f32x4 v0 = acc[ai][bj][m][0] + bv[bj][0], v1 = acc[ai][bj][m][1] + bv[bj][1];
#pragma unroll
                    for (int e = 0; e < 4; ++e) { v0[e] = gelu_t(v0[e]); v1[e] = gelu_t(v1[e]); }
                    *(u32x4*)(ob + lo + bj * HALF * 2) = pack8(v0, v1); } }
    }
};

template <class Epi, class Sched, bool ALIGN_EPI = false, bool SP2 = false>
__device__ __forceinline__ void gemm_phase(PG8_LAS unsigned char* lds, const Gemm g, const Sched& S, const Epi& E) {
    int tid_ = threadIdx.x; asm volatile("" : "+v"(tid_));
    const int tid = tid_, wid = __builtin_amdgcn_readfirstlane(tid >> 6), lane = tid & 63, wr = wid >> 2, wc = wid & 3, fr = lane & 15, fq = lane >> 4;
    const int K = g.K, nt = K / BK;
    unsigned voffA[2], voffB[2];
#pragma unroll
    for (int i = 0; i < 2; ++i) { int R, C; stage_rc(tid * 16 + i * 8192, R, C); const int Rb = Epi::PERM ? ((R & ~31) + perm32(R & 31)) : R;
        voffA[i] = (unsigned)(R * g.lda + C) * 2u; voffB[i] = (unsigned)(Rb * K + C) * 2u; }
    const size_t kstep = (size_t)(BK * 2);
    const size_t hsA = (size_t)HALF * g.lda * 2, hsB = (size_t)HALF * K * 2;
    const size_t tsA = 2 * hsA, tsB = 2 * hsB;
    const unsigned ldsw = (unsigned)wid * 1024u;
    const int aoff = lds_byte(wr * 64 + fr, fq * 8), boff = lds_byte(wc * 32 + fr, fq * 8);
#define PG8_SA(b, h) (((b) * 2 + (h)) * HTB)
#define PG8_SB(b, h) ((4 + (b) * 2 + (h)) * HTB)
#define PG8_STAGE(bufoff, gbase, voff) do { _Pragma("unroll") for (int _i = 0; _i < 2; ++_i) \
        __builtin_amdgcn_global_load_lds((const unsigned*)((const char*)(gbase) + (voff)[_i]), (PG8_LAS unsigned*)(lds + (bufoff) + ldsw + _i * 8192), 16, 0, 0); } while (0)
#define PG8_LDA(dst, b, h) do { _Pragma("unroll") for (int m = 0; m < 4; ++m) _Pragma("unroll") for (int k = 0; k < 2; ++k) dst[m][k] = *(const PG8_LAS bf16x8*)(lds + PG8_SA(b, h) + aoff + m * 2048 + k * 1024); } while (0)
#define PG8_LDB(dst, b, h) do { _Pragma("unroll") for (int n = 0; n < 2; ++n) _Pragma("unroll") for (int k = 0; k < 2; ++k) dst[n][k] = *(const PG8_LAS bf16x8*)(lds + PG8_SB(b, h) + boff + n * 2048 + k * 1024); } while (0)
#define PG8_MMA(ai, bj, At, Bt) do { __builtin_amdgcn_s_setprio(1); _Pragma("unroll") for (int m = 0; m < 4; ++m) _Pragma("unroll") for (int n = 0; n < 2; ++n) _Pragma("unroll") for (int k = 0; k < 2; ++k) \
        acc[ai][bj][m][n] = __builtin_amdgcn_mfma_f32_16x16x32_bf16(Bt[n][k], At[m][k], acc[ai][bj][m][n], 0, 0, 0); __builtin_amdgcn_s_setprio(0); } while (0)
#define PG8_WAIT_V(n) asm volatile("s_waitcnt vmcnt(" #n ")" ::: "memory")
#define PG8_WAIT_L(n) asm volatile("s_waitcnt lgkmcnt(" #n ")" ::: "memory")
#define PG8_BAR __builtin_amdgcn_s_barrier()
#define PG8_SCHED __builtin_amdgcn_sched_barrier(0)
    Unit cur, nxt; int ui = 0;
    if (!S.next(0, cur)) return;
    f32x4 acc[2][2][4][2];
#pragma unroll
    for (int a = 0; a < 2; ++a)
#pragma unroll
        for (int b = 0; b < 2; ++b)
#pragma unroll
            for (int m = 0; m < 4; ++m)
#pragma unroll
                for (int n = 0; n < 2; ++n) acc[a][b][m][n] = (f32x4){0.f, 0.f, 0.f, 0.f};
    bf16x8 At[4][2], B0[2][2], B1[2][2];
    const char* cA = (const char*)g.A + (size_t)cur.pm * tsA; const char* cB = (const char*)g.Bt + (size_t)cur.pn * tsB;
    S.a_ready(cur);
    if constexpr (SP2) {
        PG8_STAGE(PG8_SB(0, 0), cB, voffB); PG8_STAGE(PG8_SB(0, 1), cB + hsB, voffB); PG8_STAGE(PG8_SA(0, 0), cA, voffA); PG8_STAGE(PG8_SA(0, 1), cA + hsA, voffA);
        if (wr == 1) PG8_BAR;
        PG8_WAIT_V(2); PG8_BAR;
        PG8_STAGE(PG8_SB(1, 0), cB + kstep, voffB); PG8_STAGE(PG8_SA(1, 0), cA + kstep, voffA); PG8_STAGE(PG8_SB(1, 1), cB + hsB + kstep, voffB);
        PG8_WAIT_V(6); PG8_BAR;
    } else {
        PG8_STAGE(PG8_SB(0, 0), cB, voffB); PG8_STAGE(PG8_SA(0, 0), cA, voffA); PG8_STAGE(PG8_SB(0, 1), cB + hsB, voffB); PG8_STAGE(PG8_SA(0, 1), cA + hsA, voffA);
        if (wr == 1) PG8_BAR;
        PG8_WAIT_V(4); PG8_BAR;
        PG8_STAGE(PG8_SB(1, 0), cB + kstep, voffB); PG8_STAGE(PG8_SA(1, 0), cA + kstep, voffA); PG8_STAGE(PG8_SB(1, 1), cB + hsB + kstep, voffB);
        PG8_WAIT_V(6); PG8_BAR;
    }
    for (;;) {
        const bool has_next = S.next(ui + 1, nxt);
        const char* nA = has_next ? (const char*)g.A + (size_t)nxt.pm * tsA : cA; const char* nB = has_next ? (const char*)g.Bt + (size_t)nxt.pn * tsB : cB;
        for (int t = 0; t < nt; t += 2) {
            const bool last = (t == nt - 2);
            const char* a1 = cA + (size_t)(t + 1) * kstep;
            const char* a2 = last ? nA : cA + (size_t)(t + 2) * kstep; const char* b2 = last ? nB : cB + (size_t)(t + 2) * kstep;
            const char* a3 = a2 + kstep; const char* b3 = b2 + kstep;
            if (last && has_next) S.a_ready(nxt);
            if constexpr (SP2) {
            PG8_LDB(B0, 0, 0); PG8_LDB(B1, 0, 1); PG8_SCHED; PG8_LDA(At, 0, 0); PG8_STAGE(PG8_SA(1, 1), a1 + hsA, voffA);
            PG8_WAIT_V(8); PG8_WAIT_L(0); PG8_BAR; PG8_MMA(0, 0, At, B0); PG8_MMA(0, 1, At, B1); PG8_BAR; PG8_SCHED;
            PG8_LDA(At, 0, 1); PG8_STAGE(PG8_SB(0, 0), b2, voffB); PG8_STAGE(PG8_SB(0, 1), b2 + hsB, voffB); PG8_STAGE(PG8_SA(0, 0), a2, voffA);
            PG8_WAIT_V(8); PG8_WAIT_L(0); PG8_BAR; PG8_MMA(1, 0, At, B0); PG8_MMA(1, 1, At, B1); PG8_BAR; PG8_SCHED;
            PG8_LDB(B0, 1, 0); PG8_LDB(B1, 1, 1); PG8_SCHED; PG8_LDA(At, 1, 0); PG8_STAGE(PG8_SA(0, 1), a2 + hsA, voffA);
            PG8_WAIT_V(8); PG8_WAIT_L(0); PG8_BAR; PG8_MMA(0, 0, At, B0); PG8_MMA(0, 1, At, B1); PG8_BAR; PG8_SCHED;
            PG8_LDA(At, 1, 1); PG8_STAGE(PG8_SB(1, 0), b3, voffB); PG8_STAGE(PG8_SB(1, 1), b3 + hsB, voffB); PG8_STAGE(PG8_SA(1, 0), a3, voffA);
            PG8_WAIT_V(8); PG8_WAIT_L(0); PG8_BAR; PG8_MMA(1, 0, At, B0); PG8_MMA(1, 1, At, B1); PG8_BAR; PG8_SCHED;
            } else {
            PG8_LDB(B0, 0, 0); PG8_SCHED; PG8_LDA(At, 0, 0); PG8_STAGE(PG8_SA(1, 1), a1 + hsA, voffA);
            PG8_WAIT_L(8); PG8_BAR; PG8_WAIT_L(0); PG8_MMA(0, 0, At, B0); PG8_BAR; PG8_SCHED;
            PG8_LDB(B1, 0, 1); PG8_STAGE(PG8_SB(0, 0), b2, voffB);
            PG8_BAR; PG8_WAIT_L(0); PG8_MMA(0, 1, At, B1); PG8_BAR;
            PG8_LDA(At, 0, 1); PG8_STAGE(PG8_SA(0, 0), a2, voffA);
            PG8_BAR; PG8_WAIT_L(0); PG8_MMA(1, 0, At, B0); PG8_BAR; PG8_SCHED;
            PG8_STAGE(PG8_SB(0, 1), b2 + hsB, voffB);
            PG8_WAIT_V(6); PG8_BAR; PG8_MMA(1, 1, At, B1); PG8_BAR;
            PG8_LDB(B0, 1, 0); PG8_SCHED; PG8_LDA(At, 1, 0); PG8_STAGE(PG8_SA(0, 1), a2 + hsA, voffA);
            PG8_WAIT_L(8); PG8_BAR; PG8_WAIT_L(0); PG8_MMA(0, 0, At, B0); PG8_BAR; PG8_SCHED;
            PG8_LDB(B1, 1, 1); PG8_STAGE(PG8_SB(1, 0), b3, voffB);
            PG8_BAR; PG8_WAIT_L(0); PG8_MMA(0, 1, At, B1); PG8_BAR;
            PG8_LDA(At, 1, 1); PG8_STAGE(PG8_SA(1, 0), a3, voffA);
            PG8_BAR; PG8_WAIT_L(0); PG8_MMA(1, 0, At, B0); PG8_BAR; PG8_SCHED;
            PG8_STAGE(PG8_SB(1, 1), b3 + hsB, voffB);
            PG8_WAIT_V(6); PG8_BAR; PG8_MMA(1, 1, At, B1); PG8_BAR;
            }
        }
        if constexpr (ALIGN_EPI) { if (wr == 0) PG8_BAR; }
        if constexpr (!Epi::AFTER_DRAIN) { E(acc, cur, wr, wc, fr, fq); S.done(cur); }
        if (!has_next) break;
#pragma unroll
        for (int a = 0; a < 2; ++a)
#pragma unroll
            for (int b = 0; b < 2; ++b)
#pragma unroll
                for (int m = 0; m < 4; ++m)
#pragma unroll
                    for (int n = 0; n < 2; ++n) acc[a][b][m][n] = (f32x4){0.f, 0.f, 0.f, 0.f};
        cur = nxt; cA = nA; cB = nB; ++ui;
        if constexpr (ALIGN_EPI) { if (wr == 1) PG8_BAR; }
    }
    PG8_WAIT_V(0);
    if constexpr (!ALIGN_EPI) { if (wr == 0) PG8_BAR; }
    PG8_BAR;
    if constexpr (Epi::AFTER_DRAIN) { E.fused(acc, cur, wr, wc, fr, fq, lds, wid, lane); S.done(cur); }
#undef PG8_SA
#undef PG8_SB
#undef PG8_STAGE
#undef PG8_LDA
#undef PG8_LDB
#undef PG8_MMA
#undef PG8_WAIT_V
#undef PG8_WAIT_L
#undef PG8_BAR
#undef PG8_SCHED
}
}

#define LAS __attribute__((address_space(3)))
#define XB_TMO      128
#define XB_XCNT(j)  (256  + 64 * (j))
#define XB_XSUB(j)  (1280 + 64 * (j))
#define XB_XGEN(j)  (2304 + 64 * (j))
#define XB_TOP      3328
#define XB_TOPGEN   3392
#define XCD_BAR_WORDS 3456
#define XB_SPIN_CAP (1u << 18)

__device__ __forceinline__ unsigned xb_ld(unsigned* p)              { return __hip_atomic_load(p, __ATOMIC_RELAXED, __HIP_MEMORY_SCOPE_AGENT); }
__device__ __forceinline__ unsigned xb_add(unsigned* p, unsigned v) { return __hip_atomic_fetch_add(p, v, __ATOMIC_RELAXED, __HIP_MEMORY_SCOPE_AGENT); }
__device__ __forceinline__ unsigned xb_xcc_id() { return (unsigned)__builtin_amdgcn_s_getreg((3 << 11) | 20) & 0xFu; }
#define XB_SPIN(cond, bar) do { unsigned _sp = 0; while (cond) { __builtin_amdgcn_s_sleep(1); \
    if ((++_sp & 255u) == 0u) { if (xb_ld(&(bar)[XB_TMO])) break; if (_sp > XB_SPIN_CAP) { atomicAdd(&(bar)[XB_TMO], 1u); break; } } } } while (0)

struct XcdBarrier {
    unsigned* bar; unsigned x;
    volatile LAS unsigned* st;
};

__device__ __forceinline__ XcdBarrier xcd_barrier_post(unsigned* bar, volatile LAS unsigned* st) {
    XcdBarrier b; b.bar = bar; b.x = xb_xcc_id(); b.st = st;
    if (threadIdx.x == 0) (void)xb_add(&bar[XB_XCNT(b.x)], 1u);
    return b;
}
__device__ __forceinline__ void xcd_barrier_complete(unsigned* bar, unsigned x, unsigned& nloc, unsigned& nx) {
    const unsigned G = gridDim.x * gridDim.y * gridDim.z;
    unsigned sum, cnt, mine, sp = 0u;
    for (;;) {
        sum = 0u; cnt = 0u; mine = 0u;
#pragma unroll
        for (unsigned j = 0; j < 16; ++j) { const unsigned c = xb_ld(&bar[XB_XCNT(j)]); sum += c; cnt += (c > 0u) ? 1u : 0u; mine = (j == x) ? c : mine; }
        if (sum == G) break;
        __builtin_amdgcn_s_sleep(1);
        if ((++sp & 255u) == 0u) { if (xb_ld(&bar[XB_TMO])) break; if (sp > XB_SPIN_CAP) { atomicAdd(&bar[XB_TMO], 1u); break; } }
    }
    nloc = mine > 0u ? mine : 1u; nx = cnt > 0u ? cnt : 1u;
}

__device__ __forceinline__ void xcd_barrier(const XcdBarrier& b) {
    asm volatile("s_waitcnt vmcnt(0)" ::: "memory");
    __syncthreads();
    if (threadIdx.x == 0) {
        unsigned* bar = b.bar;
        __builtin_amdgcn_s_waitcnt(0);
        unsigned nloc = b.st[0], nx = b.st[1];
        if (nloc == 0u) { xcd_barrier_complete(bar, b.x, nloc, nx); b.st[0] = nloc; b.st[1] = nx; }
        const unsigned old = xb_add(&bar[XB_XSUB(b.x)], 1u);
        const unsigned gen = old / nloc;
        if (old + 1u == (gen + 1u) * nloc) {
            __builtin_amdgcn_fence(__ATOMIC_RELEASE, "agent");
            asm volatile("s_waitcnt vmcnt(0)" ::: "memory");
            const unsigned og = xb_add(&bar[XB_TOP], 1u);
            const unsigned tg = og / nx;
            if (og + 1u == (tg + 1u) * nx) xb_add(&bar[XB_TOPGEN], 1u);
            else XB_SPIN(xb_ld(&bar[XB_TOPGEN]) == tg, bar);
            __builtin_amdgcn_fence(__ATOMIC_ACQUIRE, "agent");
            xb_add(&bar[XB_XGEN(b.x)], 1u);
            asm volatile("s_waitcnt vmcnt(0)" ::: "memory");
        } else {
            XB_SPIN(xb_ld(&bar[XB_XGEN(b.x)]) == gen, bar);
            __builtin_amdgcn_fence(__ATOMIC_ACQUIRE, "agent");
            asm volatile("s_waitcnt vmcnt(0)" ::: "memory");
        }
    }
    __syncthreads();
}

constexpr int NWAVES = 8;
constexpr int NB = 4, T = 8192, D = 1024, M = NB * T;
constexpr int MEML = 256, MROWS = NB * MEML;
constexpr int FF = 2816;
constexpr int NPA = 2304;
constexpr int PA_Q = 0, PA_K = 256, PA_V = 512, PA_R = 1024, PA_MQ = 1536, PA_ALR = 2048;
constexpr int NPB = 1280;
constexpr int PB_Q = 0, PB_MQ = 512, PB_GL = 1024;
constexpr int NG5 = 2048;
constexpr float MEM_QSCALE = 0.08838834764831845f * 1.4426950408889634f;
constexpr int NCMP = 511, NCMPP = 512;
constexpr size_t MiB = 1u << 20;
constexpr size_t WS_CTL = 0, CTL_ZERO_BYTES = 1 * MiB;
constexpr size_t WS_SS = 1 * MiB;
constexpr size_t WS_SSM = 3 * MiB;
constexpr size_t WS_BIAS1 = 3 * MiB + 256 * 1024;
constexpr size_t WS_BPART = 3 * MiB + 512 * 1024;
constexpr size_t WS_WA = 4 * MiB;
constexpr size_t WS_WM = 9 * MiB;
constexpr size_t WS_WOA = 13 * MiB, WS_WOB = 15 * MiB;
constexpr size_t WS_WU = 17 * MiB;
constexpr size_t WS_WD = 39 * MiB;
constexpr size_t WS_WB = 50 * MiB;
constexpr size_t WS_WC1 = 54 * MiB;
constexpr size_t WS_WC2 = 56 * MiB;
constexpr size_t WS_XB = 64 * MiB;
constexpr size_t WS_CAT = 128 * MiB;
constexpr size_t WS_R1 = 192 * MiB;
constexpr size_t WS_R2 = 368 * MiB;
constexpr size_t WS_OG = WS_R2;
constexpr size_t WS_LA = WS_R2 + 64 * MiB;
constexpr size_t WS_KVC = WS_R2;
constexpr size_t WS_CH = WS_R2 + 50 * MiB;
constexpr size_t WS_KCMP = WS_R2 + 54 * MiB;
constexpr size_t WS_BND = WS_R2 + 102 * MiB;
constexpr size_t BND_ONE = (size_t)512 * 2 * FF * 4;
constexpr size_t WS_MKV = WS_R2 + 138 * MiB;
constexpr size_t WS_MEMB = WS_R2 + 142 * MiB;
constexpr size_t WS_END = 512 * MiB;
static_assert(WS_BND + 3 * BND_ONE <= WS_MKV && WS_LA + 32 * MiB <= WS_BND && WS_R1 + (size_t)M * FF * 2 <= WS_R2, "ws map");
constexpr size_t KVSTRIDE = (size_t)8 * 8192 * 64;
constexpr int CW_BAR = 4096, CW_PANEL = 1024;
constexpr int RING_BYTES = 131072;
constexpr int WSCR_BYTES = 17408;
constexpr int BLIST_OFF = 8 * WSCR_BYTES;
constexpr int LDSCTL_OFF = BLIST_OFF + 512, MISC_OFF = LDSCTL_OFF + 320;
constexpr int LDS_BYTES = 147456;
static_assert(MISC_OFF + 128 <= LDS_BYTES, "LDS map");

#define GAS __attribute__((address_space(1)))
#define LAS __attribute__((address_space(3)))
typedef unsigned short bf16;
typedef unsigned v4u __attribute__((ext_vector_type(4)));
typedef unsigned v2u __attribute__((ext_vector_type(2)));
typedef float f32x4 __attribute__((ext_vector_type(4)));
typedef GAS unsigned gu32;
#define LDS_WAIT() asm volatile("s_waitcnt lgkmcnt(0)" ::: "memory")
#define VM_WAIT() asm volatile("s_waitcnt vmcnt(0)" ::: "memory")
__device__ __forceinline__ unsigned f2bf(float f) { unsigned u = __builtin_bit_cast(unsigned, f); return (u + 0x7fffu + ((u >> 16) & 1u)) >> 16; }
__device__ __forceinline__ unsigned pk2(float lo, float hi) { return f2bf(lo) | (f2bf(hi) << 16); }
__device__ __forceinline__ float bf2f(unsigned short b) { return __uint_as_float((unsigned)b << 16); }
__device__ __forceinline__ float bflo(unsigned w) { return __uint_as_float(w << 16); }
__device__ __forceinline__ float bfhi(unsigned w) { return __uint_as_float(w & 0xffff0000u); }

struct Frame {
    LAS unsigned char* lds;
    volatile LAS unsigned* MISC;
    gu32* ctl;
    int tid, lane, wave, G;
    float* out; unsigned char* ws;
};
__device__ __forceinline__ const float* in_ptr(int i) { return ((const float* const __attribute__((address_space(4)))*)__builtin_amdgcn_kernarg_segment_ptr())[i]; }
enum { I_X = 0, I_MEM, I_GMIX, I_GFFN, I_GMEM, I_WMEMKV, I_WUP, I_CONVW, I_CONVB, I_WDOWN, I_AWIN, I_AWALPHA, I_ABALPHA, I_AGHEAD, I_AWOUT, I_GKV, I_WKV, I_PEK, I_PEV,
       I_WCK1, I_WCK2, I_WCV1, I_WCV2, I_BWIN, I_BWOUT, I_GFINAL };
#define WSP(T_, off) ((T_*)(F.ws + (off)))

__device__ __forceinline__ float wave_sum(float v) {
#pragma unroll
    for (int o = 1; o < 64; o <<= 1) v += __shfl_xor(v, o);
    return v;
}
__device__ __forceinline__ float wave_max(float v) {
#pragma unroll
    for (int o = 1; o < 64; o <<= 1) v = fmaxf(v, __shfl_xor(v, o));
    return v;
}

template <int MAP> __device__ __forceinline__ int map_row(int n) {
    if (MAP == 1) { return n < 1536 ? n : (n < 1552 ? n + 512 : n - 16); }
    if (MAP == 2) { return 768 + (n < 512 ? n : (n < 536 ? n + 512 : n - 24)); }
    if (MAP == 3) { const int half = n >= FF ? 1 : 0, f = n - half * FF; return 256 * (f >> 7) + 128 * half + (f & 127); }
    return n;
}
struct TrD { const float* W; const float* gain; bf16* WT; int K, N, row_off, map, item; };
__device__ __forceinline__ int map_row_rt(int map, int n) {
    if (map == 1) return map_row<1>(n);
    if (map == 2) return map_row<2>(n);
    if (map == 3) return map_row<3>(n);
    return n;
}
__device__ __forceinline__ void tr_load(float (&vv)[32], f32x4& ga, f32x4& gb, const TrD& d, int lane) {
    const int nblk = (d.N + 31) >> 5, kb = d.item / nblk, nb = d.item - kb * nblk, k0 = 64 * kb, n0 = 32 * nb;
    const int nn = n0 + (lane & 31);
    const float* wp = d.W + (size_t)(k0 + (lane >> 5)) * d.N + (nn < d.N ? nn : 0);
#pragma unroll
    for (int i = 0; i < 32; ++i) vv[i] = wp[(size_t)(2 * i) * d.N];
    ga = (f32x4){1.f, 1.f, 1.f, 1.f}; gb = ga;
    if (d.gain) { const f32x4* gp = (const f32x4*)(d.gain + k0 + 8 * (lane & 7)); ga = gp[0]; gb = gp[1]; }
}
__device__ __forceinline__ void tr_store(const float (&vv)[32], const f32x4 ga, const f32x4 gb, const TrD& d, LAS float* scr, int lane) {
    const int nblk = (d.N + 31) >> 5, kb = d.item / nblk, nb = d.item - kb * nblk, k0 = 64 * kb, n0 = 32 * nb;
#pragma unroll
    for (int i = 0; i < 32; ++i) scr[(2 * i + (lane >> 5)) * 33 + (lane & 31)] = vv[i];
    LDS_WAIT(); asm volatile("" ::: "memory");
    const int c = lane & 7;
#pragma unroll
    for (int j = 0; j < 4; ++j) { const int n = (lane >> 3) + 8 * j; const LAS float* s = scr + (8 * c) * 33 + n;
        v4u o; o.x = pg8::cvt_pk_bf16(s[0 * 33] * ga.x, s[1 * 33] * ga.y); o.y = pg8::cvt_pk_bf16(s[2 * 33] * ga.z, s[3 * 33] * ga.w); o.z = pg8::cvt_pk_bf16(s[4 * 33] * gb.x, s[5 * 33] * gb.y); o.w = pg8::cvt_pk_bf16(s[6 * 33] * gb.z, s[7 * 33] * gb.w);
        if (n0 + n < d.N) *(GAS v4u*)(d.WT + (size_t)(d.row_off + map_row_rt(d.map, n0 + n)) * d.K + k0 + 8 * c) = o; }
    LDS_WAIT(); asm volatile("" ::: "memory");
}
__device__ __forceinline__ void row_to_bf16_ss(const float* xrow, bf16* orow, float* ss, int lane) {
    const GAS f32x4* xr = (const GAS f32x4*)xrow + lane;
    f32x4 v[4]; float s = 0.f;
#pragma unroll
    for (int j = 0; j < 4; ++j) { v[j] = xr[64 * j]; s += (v[j].x * v[j].x + v[j].y * v[j].y) + (v[j].z * v[j].z + v[j].w * v[j].w); }
    s = wave_sum(s);
    GAS unsigned long long* o8 = (GAS unsigned long long*)orow + lane;
#pragma unroll
    for (int j = 0; j < 4; ++j) o8[64 * j] = (unsigned long long)pk2(v[j].x, v[j].y) | ((unsigned long long)pk2(v[j].z, v[j].w) << 32);
    if (lane < 16) ss[lane] = (lane == 0) ? s : 0.f;
}
constexpr int TR_I0 = 16 * 65, TR_I1 = 16 * 32, TR_I4 = 16 * 176, TR_I6 = 44 * 32, TR_I8 = 16 * 24, TR_I9 = 16 * 33, TR_I11 = 32 * 8, TR_I13 = 4 * 2;
constexpr int TR_NP0 = TR_I0 + 4 * TR_I1 + TR_I4 + TR_I6 + TR_I8 + TR_I9 + 2 * TR_I11 + 2 * TR_I13, TR_NITEMS = TR_NP0 + TR_I4 + TR_I6;
__device__ __forceinline__ TrD tr_decode(Frame& F, int r) {
    if (r < TR_I0) return TrD{in_ptr(I_AWIN), in_ptr(I_GMIX), WSP(bf16, WS_WA), 1024, 2064, 0, 1, r}; r -= TR_I0;
    if (r < TR_I1) return TrD{in_ptr(I_WMEMKV), in_ptr(I_GMEM), WSP(bf16, WS_WM), 1024, 1024, 0, 0, r}; r -= TR_I1;
    if (r < TR_I1) return TrD{in_ptr(I_WMEMKV) + 1024 * 1024, in_ptr(I_GMEM) + 1024, WSP(bf16, WS_WM), 1024, 1024, 1024, 0, r}; r -= TR_I1;
    if (r < TR_I1) return TrD{in_ptr(I_AWOUT), nullptr, WSP(bf16, WS_WOA), 1024, 1024, 0, 0, r}; r -= TR_I1;
    if (r < TR_I4) return TrD{in_ptr(I_WUP), in_ptr(I_GFFN), WSP(bf16, WS_WU), 1024, 2 * FF, 0, 3, r}; r -= TR_I4;
    if (r < TR_I6) return TrD{in_ptr(I_WDOWN), nullptr, WSP(bf16, WS_WD), FF, 1024, 0, 0, r}; r -= TR_I6;
    if (r < TR_I8) return TrD{in_ptr(I_WKV), in_ptr(I_GKV), WSP(bf16, WS_WB), 1024, 768, 0, 0, r}; r -= TR_I8;
    if (r < TR_I9) return TrD{in_ptr(I_BWIN), in_ptr(I_GMIX) + 1024, WSP(bf16, WS_WB), 1024, 1048, 0, 2, r}; r -= TR_I9;
    if (r < TR_I11) return TrD{in_ptr(I_WCK1), nullptr, WSP(bf16, WS_WC1), 2048, 256, 0, 0, r}; r -= TR_I11;
    if (r < TR_I11) return TrD{in_ptr(I_WCV1), nullptr, WSP(bf16, WS_WC1) + (size_t)256 * 2048, 2048, 256, 0, 0, r}; r -= TR_I11;
    if (r < TR_I13) return TrD{in_ptr(I_WCK2), nullptr, WSP(bf16, WS_WC2), 256, 64, 0, 0, r}; r -= TR_I13;
    if (r < TR_I13) return TrD{in_ptr(I_WCV2), nullptr, WSP(bf16, WS_WC2) + 64 * 256, 256, 64, 0, 0, r}; r -= TR_I13;
    if (r < TR_I1) return TrD{in_ptr(I_BWOUT), nullptr, WSP(bf16, WS_WOB), 1024, 1024, 0, 0, r}; r -= TR_I1;
    if (r < TR_I4) return TrD{in_ptr(I_WUP) + (size_t)1024 * 2 * FF, in_ptr(I_GFFN) + 1024, WSP(bf16, WS_WU) + (size_t)2 * FF * 1024, 1024, 2 * FF, 0, 3, r}; r -= TR_I4;
    return TrD{in_ptr(I_WDOWN) + (size_t)FF * 1024, nullptr, WSP(bf16, WS_WD) + (size_t)1024 * FF, FF, 1024, 0, 0, r};
}
__device__ __forceinline__ void tr_items(Frame& F, LAS float* scr, int w, int nw, int lo, int hi, int lane) {
    int it = lo + w;
    if (it >= hi) return;
    TrD d0 = tr_decode(F, it); float v0[32]; f32x4 g0a, g0b; tr_load(v0, g0a, g0b, d0, lane);
    TrD d1 = tr_decode(F, (it + nw < hi) ? it + nw : it); float v1[32]; f32x4 g1a, g1b; tr_load(v1, g1a, g1b, d1, lane);
#pragma unroll 1
    for (;;) {
        const int it2 = it + 2 * nw;
        const TrD d2 = tr_decode(F, (it2 < hi) ? it2 : it); float v2[32]; f32x4 g2a, g2b; tr_load(v2, g2a, g2b, d2, lane);
        tr_store(v0, g0a, g0b, d0, scr, lane);
        if (it + nw >= hi) break;
        it += nw; d0 = d1; g0a = g1a; g0b = g1b; d1 = d2; g1a = g2a; g1b = g2b;
#pragma unroll
        for (int i = 0; i < 32; ++i) { v0[i] = v1[i]; v1[i] = v2[i]; }
    }
}
__device__ __forceinline__ void p0_prologue(Frame& F) {
    LAS float* scr = (LAS float*)(F.lds + F.wave * 16384);
    const int gw = blockIdx.x * NWAVES + F.wave, NGW = F.G * NWAVES, lane = F.lane;
    for (int m = (gw + NGW / 2) % NGW; m < MROWS; m += NGW) row_to_bf16_ss(in_ptr(I_MEM) + (size_t)m * D, WSP(bf16, WS_MEMB) + (size_t)m * D, WSP(float, WS_SSM) + (size_t)m * 16, lane);
    for (int o = (gw + NGW - NGW / 4) % NGW; o < 512; o += NGW) { const int task = o >> 2, mlp = task >> 6, gi = task & 63, j = (o & 3) * 64 + lane; const float* pe = in_ptr(mlp ? I_PEV : I_PEK) + 32 * gi; const float* w1 = in_ptr(mlp ? I_WCV1 : I_WCK1) + (size_t)(32 * gi) * 256 + j;
        float wv[32];
#pragma unroll
        for (int kk = 0; kk < 32; ++kk) wv[kk] = w1[kk * 256];
        float s_ = 0.f;
#pragma unroll
        for (int kk = 0; kk < 32; ++kk) s_ += pe[kk] * wv[kk];
        WSP(float, WS_BPART)[(size_t)task * 256 + j] = s_; }
    tr_items(F, scr, gw, NGW, 0, (F.G == 256) ? TR_NP0 : TR_NITEMS, lane);
    { const int gt = blockIdx.x * 512 + F.tid, NT = F.G * 512; const v4u z = {0u, 0u, 0u, 0u};
      for (int i = gt; i < 240 * 128; i += NT) *(GAS v4u*)(WSP(bf16, WS_WA) + (size_t)2064 * 1024 + (size_t)i * 8) = z;
      for (int i = gt; i < 232 * 128; i += NT) *(GAS v4u*)(WSP(bf16, WS_WB) + (size_t)1816 * 1024 + (size_t)i * 8) = z; }
    { const float* xin = in_ptr(I_X); bf16* xbp = WSP(bf16, WS_XB); float* ssp = WSP(float, WS_SS);
      f32x4 v[8][4];
#pragma unroll
      for (int q = 0; q < 8; ++q) { const int mq = gw + q * NGW;
#pragma unroll
          for (int j = 0; j < 4; ++j) v[q][j] = ((const GAS f32x4*)(xin + (size_t)(mq < M ? mq : (M - 1)) * D) + lane)[64 * j]; }
#pragma unroll 1
      for (int m = gw; m < M; m += 8 * NGW) {
#pragma unroll
          for (int q = 0; q < 8; ++q) { const int mm = m + q * NGW; if (mm >= M) break;
              float s_ = 0.f;
#pragma unroll
              for (int j = 0; j < 4; ++j) s_ += (v[q][j].x * v[q][j].x + v[q][j].y * v[q][j].y) + (v[q][j].z * v[q][j].z + v[q][j].w * v[q][j].w);
              s_ += __int_as_float(__builtin_amdgcn_mov_dpp(__float_as_int(s_), 0xB1, 0xf, 0xf, true)); s_ += __int_as_float(__builtin_amdgcn_mov_dpp(__float_as_int(s_), 0x4E, 0xf, 0xf, true));
              GAS v2u* o8 = (GAS v2u*)(xbp + (size_t)mm * D) + lane;
#pragma unroll
              for (int j = 0; j < 4; ++j) { v2u w; w.x = pg8::cvt_pk_bf16(v[q][j].x, v[q][j].y); w.y = pg8::cvt_pk_bf16(v[q][j].z, v[q][j].w); o8[64 * j] = w; }
              if ((lane & 3) == 0) ssp[(size_t)mm * 16 + (lane >> 2)] = s_;
              const int mn = mm + 8 * NGW;
              if (mn < M) {
#pragma unroll
                  for (int j = 0; j < 4; ++j) v[q][j] = ((const GAS f32x4*)(xin + (size_t)mn * D) + lane)[64 * j]; } } } }
}
__device__ __forceinline__ void bias1_reduce(Frame& F) {
    const float* bp = WSP(float, WS_BPART) + (size_t)(F.tid >> 8) * 64 * 256 + (F.tid & 255);
    float v[64];
#pragma unroll
    for (int gi = 0; gi < 64; ++gi) v[gi] = bp[gi * 256];
    float s_ = 0.f;
#pragma unroll
    for (int gi = 0; gi < 64; ++gi) s_ += v[gi];
    WSP(float, WS_BIAS1)[F.tid] = s_;
}


typedef short bf16x8 __attribute__((ext_vector_type(8)));
typedef short s16x4 __attribute__((ext_vector_type(4)));
typedef float f32x16 __attribute__((ext_vector_type(16)));
__device__ __forceinline__ int crow(int r, int hi) { return (r & 3) + 8 * (r >> 2) + 4 * hi; }
typedef float f32x2_t __attribute__((ext_vector_type(2))); typedef __bf16 bf16x2_t __attribute__((ext_vector_type(2)));
__device__ __forceinline__ unsigned cvtpk(float lo, float hi) { const f32x2_t v = {lo, hi}; return __builtin_bit_cast(unsigned, __builtin_convertvector(v, bf16x2_t)); }
__device__ __forceinline__ void st_pair16(bf16* p0, int hi, v2u a, v2u b) {
    const auto r0 = __builtin_amdgcn_permlane32_swap(a.x, b.x, false, false); const auto r1 = __builtin_amdgcn_permlane32_swap(a.y, b.y, false, false);
    v4u w; w.x = r0[0]; w.y = r1[0]; w.z = r0[1]; w.w = r1[1];
    *(v4u*)(p0 + 8 * hi) = w;
}
__device__ __forceinline__ void dma16(const void* gsrc, LAS unsigned char* ldst) { __builtin_amdgcn_global_load_lds((const unsigned*)gsrc, (LAS unsigned*)ldst, 16, 0, 0); }
template <int NK16> __device__ __forceinline__ void qkt(f32x16& p0, f32x16& p1, const LAS unsigned char* Kt, const bf16x8* qr, int r32, int hi) {
    const LAS unsigned char* kb = Kt + hi * 1024 + r32 * 16;
    bf16x8 kf[2 * NK16];
#pragma unroll
    for (int d0 = 0; d0 < NK16; ++d0) { kf[2 * d0] = *(const LAS bf16x8*)(kb + d0 * 2048); kf[2 * d0 + 1] = *(const LAS bf16x8*)(kb + d0 * 2048 + 512); }
    __builtin_amdgcn_sched_barrier(0);
#pragma unroll
    for (int d0 = 0; d0 < NK16; ++d0) { p0 = __builtin_amdgcn_mfma_f32_32x32x16_bf16(kf[2 * d0], qr[d0], p0, 0, 0, 0); p1 = __builtin_amdgcn_mfma_f32_32x32x16_bf16(kf[2 * d0 + 1], qr[d0], p1, 0, 0, 0); }
    __builtin_amdgcn_sched_barrier(0);
}
__device__ __forceinline__ s16x4 vtr(const LAS unsigned char* p) { typedef short v4i16_t __attribute__((ext_vector_type(4))); return __builtin_bit_cast(s16x4, __builtin_amdgcn_ds_read_tr16_b64_v4i16((LAS v4i16_t*)p)); }
__device__ __forceinline__ void pack_p(bf16x8 (&pa)[4], const f32x16& p0, const f32x16& p1) {
    typedef unsigned u32x4_t __attribute__((ext_vector_type(4)));
    const u32x4_t w0 = {cvtpk(p0[0], p0[1]), cvtpk(p0[2], p0[3]), cvtpk(p0[4], p0[5]), cvtpk(p0[6], p0[7])}, w1 = {cvtpk(p0[8], p0[9]), cvtpk(p0[10], p0[11]), cvtpk(p0[12], p0[13]), cvtpk(p0[14], p0[15])};
    const u32x4_t w2 = {cvtpk(p1[0], p1[1]), cvtpk(p1[2], p1[3]), cvtpk(p1[4], p1[5]), cvtpk(p1[6], p1[7])}, w3 = {cvtpk(p1[8], p1[9]), cvtpk(p1[10], p1[11]), cvtpk(p1[12], p1[13]), cvtpk(p1[14], p1[15])};
    pa[0] = __builtin_bit_cast(bf16x8, w0); pa[1] = __builtin_bit_cast(bf16x8, w1); pa[2] = __builtin_bit_cast(bf16x8, w2); pa[3] = __builtin_bit_cast(bf16x8, w3);
}
template <int NDB> __device__ __forceinline__ void vfrag_issue(s16x4 (&vl)[NDB][4], s16x4 (&vh)[NDB][4], const LAS unsigned char* Vt, int lane) {
    const unsigned vb = (unsigned)(uintptr_t)(Vt + ((lane >> 4) & 1) * 32 + (lane & 3) * 8 + (4 * (lane >> 5) + ((lane & 15) >> 2)) * 64);
    asm volatile("s_waitcnt lgkmcnt(0)" ::: "memory");
#pragma unroll
    for (int db = 0; db < NDB; ++db)
#pragma unroll
        for (int ks = 0; ks < 4; ++ks) {
            asm volatile("ds_read_b64_tr_b16 %0, %1 offset:%c2" : "=&v"(vl[db][ks]) : "v"(vb), "i"(db * 4096 + ks * 1024) : "memory");
            asm volatile("ds_read_b64_tr_b16 %0, %1 offset:%c2" : "=&v"(vh[db][ks]) : "v"(vb), "i"(db * 4096 + ks * 1024 + 512) : "memory"); }
}
template <int NDB> __device__ __forceinline__ void pv_frag(f32x16* o, s16x4 (&vl)[NDB][4], s16x4 (&vh)[NDB][4], const bf16x8 (&pa)[4]) {
    asm volatile("s_waitcnt lgkmcnt(0)" ::: "memory");
#pragma unroll
    for (int db = 0; db < NDB; ++db)
#pragma unroll
        for (int ks = 0; ks < 4; ++ks) { asm volatile("" : "+v"(vl[db][ks]), "+v"(vh[db][ks]));
            const bf16x8 vf = {vl[db][ks][0], vl[db][ks][1], vl[db][ks][2], vl[db][ks][3], vh[db][ks][0], vh[db][ks][1], vh[db][ks][2], vh[db][ks][3]};
            o[db] = __builtin_amdgcn_mfma_f32_32x32x16_bf16(vf, pa[ks], o[db], 0, 0, 0); }
}
__device__ __forceinline__ float max3f(float a, float b, float c) { return __builtin_fmaxf(__builtin_fmaxf(a, b), c); }
__device__ __forceinline__ float max32(const f32x16& p0, const f32x16& p1) {
    float a = max3f(p0[0], p0[1], p1[0]), b = max3f(p0[2], p0[3], p1[1]); a = max3f(a, p1[2], p1[3]);
#pragma unroll
    for (int r = 4; r < 16; r += 4) { a = max3f(a, p0[r], p0[r + 1]); b = max3f(b, p0[r + 2], p0[r + 3]); a = max3f(a, p1[r], p1[r + 1]); b = max3f(b, p1[r + 2], p1[r + 3]); }
    const float m = fmaxf(a, b);
    const auto rr = __builtin_amdgcn_permlane32_swap(__float_as_uint(m), __float_as_uint(m), false, false);
    return fmaxf(__uint_as_float(rr[0]), __uint_as_float(rr[1]));
}
template <int NDB> __device__ __forceinline__ void softmax_step(f32x16& p0, f32x16& p1, float& m, float& l, f32x16* o) {
    const float mn = fmaxf(m, max32(p0, p1)); const float mu = (mn == -INFINITY) ? 0.f : mn; const float alpha = __builtin_amdgcn_exp2f(m - mu);
    float s = 0.f;
#pragma unroll
    for (int r = 0; r < 16; ++r) { p0[r] = __builtin_amdgcn_exp2f(p0[r] - mu); p1[r] = __builtin_amdgcn_exp2f(p1[r] - mu); s += p0[r] + p1[r]; }
    l = l * alpha + s; m = mn;
#pragma unroll
    for (int db = 0; db < NDB; ++db)
#pragma unroll
        for (int r = 0; r < 16; ++r) o[db][r] *= alpha;
}

__device__ __forceinline__ void ph_memattn_mfma(Frame& F, const bf16* Qb, int ldq, int qcol0, int layer, int vb, int VG) {
    const bf16* MKV = WSP(bf16, WS_MKV); bf16* CAT = WSP(bf16, WS_CAT);
    const int lane = F.lane, wave = F.wave, r32 = lane & 31, hi = lane >> 5;
    LAS unsigned char* Kl = F.lds; LAS unsigned char* Vl = F.lds + 65536;
    const int vlo = (vb * 512) / VG, vhi = ((vb + 1) * 512) / VG;
    int cur_bh = -1;
#pragma unroll 1
    for (int v = vlo; v < vhi; ++v) {
        const int bh = v >> 5, b = bh >> 2, h = bh & 3, q0 = (v & 31) * 256 + wave * 32;
        const size_t row = (size_t)b * T + q0 + r32;
        bf16x8 qr[8];
#pragma unroll
        for (int d0 = 0; d0 < 8; ++d0) qr[d0] = *(const bf16x8*)(Qb + row * ldq + qcol0 + h * 128 + d0 * 16 + hi * 8);
        if (bh != cur_bh) {
            __syncthreads();
            const char* kg = (const char*)(MKV + (size_t)(b * 256) * 2048 + layer * 1024 + h * 128); const char* vg = kg + 1024;
#pragma unroll
            for (int j = 0; j < 8; ++j) { const int pc = wave * 8 + j;
                dma16(kg + (size_t)((pc >> 4) * 64 + lane) * 4096 + (pc & 15) * 16, Kl + (pc >> 4) * 16384 + (pc & 15) * 1024);
                dma16(vg + (size_t)((pc >> 4) * 64 + (pc & 3) * 16 + (lane >> 2)) * 4096 + ((pc >> 2) & 3) * 64 + (lane & 3) * 16, Vl + (pc >> 4) * 16384 + ((pc >> 2) & 3) * 4096 + (pc & 3) * 1024); }
            cur_bh = bh;
            asm volatile("s_waitcnt vmcnt(0)" ::: "memory");
            __syncthreads();
            if (wave >= 4) __builtin_amdgcn_s_sleep(56);
        }
        f32x16 o[4]; o[0] = (f32x16){}; o[1] = (f32x16){}; o[2] = (f32x16){}; o[3] = (f32x16){};
        float m = -INFINITY, l = 0.f;
#pragma unroll 1
        for (int kt = 0; kt < 4; ++kt) {
            f32x16 p0 = (f32x16){}, p1 = (f32x16){}; qkt<8>(p0, p1, Kl + kt * 16384, qr, r32, hi);
            s16x4 vl[2][4], vh[2][4]; vfrag_issue<2>(vl, vh, Vl + kt * 16384, lane);
            softmax_step<4>(p0, p1, m, l, o);
            bf16x8 pa[4]; pack_p(pa, p0, p1);
            pv_frag<2>(o, vl, vh, pa);
            s16x4 vl2[2][4], vh2[2][4]; vfrag_issue<2>(vl2, vh2, Vl + kt * 16384 + 8192, lane);
            pv_frag<2>(o + 2, vl2, vh2, pa);
        }
        l += __shfl_xor(l, 32); const float inv = 1.0f / l;
        bf16* op = CAT + row * 1024 + 512 + h * 128;
#pragma unroll
        for (int db = 0; db < 4; ++db)
#pragma unroll
            for (int rg = 0; rg < 4; rg += 2) { v2u w, w2; w.x = cvtpk(o[db][4 * rg] * inv, o[db][4 * rg + 1] * inv); w.y = cvtpk(o[db][4 * rg + 2] * inv, o[db][4 * rg + 3] * inv);
                w2.x = cvtpk(o[db][4 * rg + 4] * inv, o[db][4 * rg + 5] * inv); w2.y = cvtpk(o[db][4 * rg + 6] * inv, o[db][4 * rg + 7] * inv);
                st_pair16(op + 32 * db + 8 * rg, hi, w, w2); }
    }
    __syncthreads();
}

constexpr int NS_K = 0, NS_V = 32768, NS_MAIN = 65536, NS_PITCH = 129, NS_SPILL = NS_MAIN + 64 * NS_PITCH * 4, NS_MASK = NS_SPILL + 64 * NS_PITCH * 4, NS_UNION = NS_MASK + 1024, NS_BLIST = NS_UNION + 16, NS_END = NS_BLIST + 512;
static_assert(NS_END <= LDSCTL_OFF, "NSA LDS map");
__device__ __forceinline__ void nsa_dma(const bf16* Kb, const bf16* Vb, int row0, LAS unsigned char* lds, int buf, int wave, int lane) {
    dma16((const char*)Kb + (size_t)(row0 + lane) * 128 + wave * 16, lds + NS_K + buf * 8192 + wave * 1024);
    if (Vb) dma16((const char*)Vb + (size_t)(row0 + (wave & 3) * 16 + (lane >> 2)) * 128 + (wave >> 2) * 64 + (lane & 3) * 16, lds + NS_V + buf * 8192 + (wave >> 2) * 4096 + (wave & 3) * 1024);
}
#define NSA_STAGE_BAR() asm volatile("s_waitcnt vmcnt(0) lgkmcnt(0)\n\ts_barrier" ::: "memory")
template <int KSTEP> __device__ __forceinline__ void nsa_bias(f32x16& p0, f32x16& p1, int base, float sl, float mref, bool lanevalid = true) {
    const float A = lanevalid ? (-sl * (float)base - mref) : -INFINITY, slk = sl * (float)KSTEP, C = slk * 32.0f;
#pragma unroll
    for (int r = 0; r < 16; ++r) { const float tr = fmaf(slk, (float)((r & 3) + 8 * (r >> 2)), A); p0[r] = tr; p1[r] = tr + C; }
}
template <int KSTEP, bool WINDOW> __device__ __forceinline__ void nsa_mask(f32x16& p0, f32x16& p1, int base) {
#pragma unroll
    for (int r = 0; r < 16; ++r) { const int d0 = base - KSTEP * ((r & 3) + 8 * (r >> 2)), d1 = d0 - 32 * KSTEP;
        const bool v0 = WINDOW ? (d0 >= 0 && d0 < 512) : (d0 >= 0), v1 = WINDOW ? (d1 >= 0 && d1 < 512) : (d1 >= 0);
        p0[r] = v0 ? p0[r] : -INFINITY; p1[r] = v1 ? p1[r] : -INFINITY; }
}
template <int NDB> __device__ __forceinline__ void nsa_softmax(f32x16& p0, f32x16& p1, float& m, float& l, f32x16* o) {
    const float mx = max32(p0, p1);
    if (__any(mx > 8.0f)) { const float dl = (mx > 8.0f) ? mx : 0.f; m += dl; const float ef = __builtin_amdgcn_exp2f(-dl); l *= ef;
#pragma unroll
        for (int r = 0; r < 16; ++r) { p0[r] -= dl; p1[r] -= dl; }
#pragma unroll
        for (int db = 0; db < NDB; ++db)
#pragma unroll
            for (int r = 0; r < 16; ++r) o[db][r] *= ef; }
    float s = 0.f;
#pragma unroll
    for (int r = 0; r < 16; ++r) { p0[r] = __builtin_amdgcn_exp2f(p0[r]); p1[r] = __builtin_amdgcn_exp2f(p1[r]); s += p0[r] + p1[r]; }
    l += s;
}
__device__ __forceinline__ float dpp_xor1(float v) { return __int_as_float(__builtin_amdgcn_mov_dpp(__float_as_int(v), 0xB1, 0xf, 0xf, true)); }
__device__ __forceinline__ float dpp_xor2(float v) { return __int_as_float(__builtin_amdgcn_mov_dpp(__float_as_int(v), 0x4E, 0xf, 0xf, true)); }
__device__ __forceinline__ void ph_nsa_mfma(Frame& F) {
    const bf16* PB = WSP(bf16, WS_R1); const bf16* KVC = WSP(bf16, WS_KVC); const bf16* KCMP = WSP(bf16, WS_KCMP); bf16* CAT = WSP(bf16, WS_CAT);
    const int lane = F.lane, wave = F.wave, tid = F.tid, r32 = lane & 31, hi = lane >> 5, hp = r32 & 3, q8 = r32 >> 2, ql = 8 * wave + q8;
    LAS unsigned char* lds = F.lds;
    LAS float* Lmain = (LAS float*)(lds + NS_MAIN); LAS float* Lspill = (LAS float*)(lds + NS_SPILL); LAS unsigned* Lmask = (LAS unsigned*)(lds + NS_MASK); LAS unsigned* Lunion = (LAS unsigned*)(lds + NS_UNION); LAS int* Lblist = (LAS int*)(lds + NS_BLIST);
    const int nunits = 1024, per = (nunits + F.G - 1) / F.G;
#define NSA_UNIT(ui_, bg_, qt_, ok_) do { if (F.G == 256) { const int s_ = blockIdx.x & 31; bg_ = blockIdx.x >> 5; qt_ = ((ui_) == 0) ? s_ : ((ui_) == 1) ? 63 - s_ : ((ui_) == 2) ? 64 + s_ : 127 - s_; ok_ = (ui_) < 4; } \
        else { const int u_ = blockIdx.x + (ui_) * F.G; ok_ = (ui_) < per && u_ < nunits; bg_ = u_ >> 7; qt_ = u_ & 127; } } while (0)
    int sp = 0;
    if (wave >= 4) __builtin_amdgcn_s_setprio(1);
    { int bg0, qt0; bool ok0; NSA_UNIT(0, bg0, qt0, ok0);
      if (ok0) { const int nt0 = (4 * qt0 + 3 + 63) >> 6; const bf16* kc0 = KCMP + (size_t)(bg0 * NCMPP) * 64; nsa_dma(kc0, nullptr, (nt0 - 1) * 64, lds, 0, wave, lane); if (nt0 > 1) nsa_dma(kc0, nullptr, (nt0 - 2) * 64, lds, 1, wave, lane); } }
    bf16x8 qnx[4]; unsigned short gnx[3];
    { int bg0, qt0; bool ok0; NSA_UNIT(0, bg0, qt0, ok0); if (!ok0) { bg0 = 0; qt0 = 0; }
      const size_t row0_ = (size_t)(bg0 >> 1) * T + qt0 * 64 + ql; const int head0_ = (bg0 & 1) * 4 + hp;
#pragma unroll
      for (int d0 = 0; d0 < 4; ++d0) qnx[d0] = *(const bf16x8*)(PB + row0_ * NPB + PB_Q + head0_ * 64 + d0 * 16 + hi * 8);
#pragma unroll
      for (int i = 0; i < 3; ++i) gnx[i] = PB[row0_ * NPB + PB_GL + head0_ * 3 + i]; }
#pragma unroll 1
    for (int ui = 0; ui < per; ++ui) {
        int bg, qt; bool ok_u; NSA_UNIT(ui, bg, qt, ok_u); if (!ok_u) break;
        int bgn, qtn; bool ok_n; NSA_UNIT(ui + 1, bgn, qtn, ok_n);
        const int b = bg >> 1, g = bg & 1, t0 = qt * 64, t = t0 + ql, cur = qt, tmin = t0 + 8 * wave;
        const size_t row = (size_t)b * T + t; const int head = g * 4 + hp;
        const float slope2 = exp2f(-(float)(head + 1)) * 1.4426950408889634f;
        bf16x8 qr[4];
#pragma unroll
        for (int d0 = 0; d0 < 4; ++d0) qr[d0] = qnx[d0];
        float gate[3];
#pragma unroll
        for (int i = 0; i < 3; ++i) gate[i] = pg8::sigmoid_f(bf2f(gnx[i]));
        if (tid < 4) Lunion[tid] = 0u;
        LAS float* Ltot = (LAS float*)(lds + NS_MAIN) + tid;
        const bf16* kcb = KCMP + (size_t)(bg * NCMPP) * 64; const bf16* vcb = KCMP + (size_t)(4096 + bg * NCMPP) * 64;
        const int nt = (4 * qt + 3 + 63) >> 6;
        float m = 0.f, l = 0.f;
#pragma unroll 1
        for (int st = 0; 2 * st < nt; ++st) {
            NSA_STAGE_BAR();
            { const int i2 = 2 * st + 2, sb = ((sp + st + 1) & 1) * 2; if (i2 < nt) { nsa_dma(kcb, nullptr, (nt - 1 - i2) * 64, lds, sb, wave, lane); if (i2 + 1 < nt) nsa_dma(kcb, nullptr, (nt - 2 - i2) * 64, lds, sb + 1, wave, lane); }
              else { nsa_dma(kcb, vcb, (nt - 1) * 64, lds, sb, wave, lane); if (nt > 1) nsa_dma(kcb, vcb, (nt - 2) * 64, lds, sb + 1, wave, lane); } }
#pragma unroll 1
            for (int h2 = 0; h2 < 2; ++h2) { const int it = 2 * st + h2; if (it >= nt) break; const int kt = nt - 1 - it, buf = ((sp + st) & 1) * 2 + h2;
                const int base = t - 31 - 16 * (64 * kt + 4 * hi);
                f32x16 p0, p1; nsa_bias<16>(p0, p1, base, slope2, m); qkt<4>(p0, p1, lds + NS_K + buf * 8192, qr, r32, hi);
                if (1024 * kt + 1039 > tmin) nsa_mask<16, false>(p0, p1, base);
                nsa_softmax<0>(p0, p1, m, l, nullptr); }
        }
        sp = (sp + ((nt + 1) >> 1)) & 1;
        l += __shfl_xor(l, 32);
        const float invl = 1.0f / fmaxf(l, 1e-30f);
        f32x16 o[2]; o[0] = (f32x16){}; o[1] = (f32x16){};
        const bf16* ksb = KVC + 2 * KVSTRIDE + (size_t)bg * 8192 * 64; const bf16* vsb = KVC + 3 * KVSTRIDE + (size_t)bg * 8192 * 64;
#pragma unroll 1
        for (int st = 0; 2 * st < nt; ++st) {
            NSA_STAGE_BAR();
            { const int i2 = 2 * st + 2, sb = ((sp + st + 1) & 1) * 2; if (i2 < nt) { nsa_dma(kcb, vcb, (nt - 1 - i2) * 64, lds, sb, wave, lane); if (i2 + 1 < nt) nsa_dma(kcb, vcb, (nt - 2 - i2) * 64, lds, sb + 1, wave, lane); }
              else { nsa_dma(ksb, vsb, cur * 64, lds, sb, wave, lane); if (cur > 0) nsa_dma(ksb, vsb, (cur - 1) * 64, lds, sb + 1, wave, lane); } }
#pragma unroll 1
            for (int h2 = 0; h2 < 2; ++h2) { const int it = 2 * st + h2; if (it >= nt) break; const int kt = nt - 1 - it, buf = ((sp + st) & 1) * 2 + h2;
                const int base = t - 31 - 16 * (64 * kt + 4 * hi);
                f32x16 p0, p1; nsa_bias<16>(p0, p1, base, slope2, m); qkt<4>(p0, p1, lds + NS_K + buf * 8192, qr, r32, hi);
                s16x4 vl[2][4], vh[2][4]; vfrag_issue<2>(vl, vh, lds + NS_V + buf * 8192, lane);
                if (1024 * kt + 1039 > tmin) nsa_mask<16, false>(p0, p1, base);
#pragma unroll
                for (int r = 0; r < 16; ++r) { p0[r] = __builtin_amdgcn_exp2f(p0[r]) * invl; p1[r] = __builtin_amdgcn_exp2f(p1[r]) * invl; }
#pragma unroll
                for (int pi = 0; pi < 2; ++pi)
#pragma unroll
                    for (int rg = 0; rg < 4; ++rg) { const f32x16& pp = pi ? p1 : p0; float v3 = 0.5f * pp[4 * rg + 3]; float vm = (pp[4 * rg] + pp[4 * rg + 1]) + (pp[4 * rg + 2] + v3);
                        vm += dpp_xor1(vm); vm += dpp_xor2(vm); v3 += dpp_xor1(v3); v3 += dpp_xor2(v3);
                        const int a = 16 * kt + 8 * pi + 2 * rg + hi;
                        if (hp == 0) { Lmain[ql * NS_PITCH + a] = vm; Lspill[ql * NS_PITCH + a] = v3; } }
                bf16x8 pa[4]; pack_p(pa, p0, p1);
                pv_frag<2>(o, vl, vh, pa); }
        }
        sp = (sp + ((nt + 1) >> 1)) & 1;
        __syncthreads();
#pragma unroll
        for (int db = 0; db < 2; ++db)
#pragma unroll
            for (int r = 0; r < 16; ++r) o[db][r] *= gate[0];
        {
            int q = tid >> 3, s8 = tid & 7; asm volatile("" : "+v"(q), "+v"(s8));
            unsigned mw0 = 0u, mw1 = 0u, mw2 = 0u, mw3 = 0u;
            if (cur < 16) { mw0 = (1u << (cur + 1)) - 1u; }
            else {
                float val[16];
#pragma unroll
                for (int k = 0; k < 16; ++k) { const int j = s8 + 8 * k;
                    val[k] = (j > cur || j == 0 || j >= cur - 1) ? -INFINITY : Lmain[q * NS_PITCH + j] + Lspill[q * NS_PITCH + j - 1]; }
                { const int f1 = cur - 1; mw0 = 1u; const unsigned b1 = 1u << (f1 & 31), b2 = 1u << (cur & 31); const int w1 = f1 >> 5, w2 = cur >> 5;
                  mw0 |= (w1 == 0 ? b1 : 0u) | (w2 == 0 ? b2 : 0u); mw1 |= (w1 == 1 ? b1 : 0u) | (w2 == 1 ? b2 : 0u); mw2 |= (w1 == 2 ? b1 : 0u) | (w2 == 2 ? b2 : 0u); mw3 |= (w1 == 3 ? b1 : 0u) | (w2 == 3 ? b2 : 0u); }
#pragma unroll 1
                for (int round = 0; round < 13; ++round) {
                    float bv = val[0]; int bj = s8;
#pragma unroll
                    for (int k = 1; k < 16; ++k) { const bool gt = val[k] > bv; bv = gt ? val[k] : bv; bj = gt ? (s8 + 8 * k) : bj; }
#pragma unroll
                    for (int stp = 0; stp < 3; ++stp) {
                        const float ov = __int_as_float(stp == 0 ? __builtin_amdgcn_mov_dpp(__float_as_int(bv), 0xB1, 0xf, 0xf, true) : stp == 1 ? __builtin_amdgcn_mov_dpp(__float_as_int(bv), 0x4E, 0xf, 0xf, true) : __builtin_amdgcn_mov_dpp(__float_as_int(bv), 0x141, 0xf, 0xf, true));
                        const int oj = stp == 0 ? __builtin_amdgcn_mov_dpp(bj, 0xB1, 0xf, 0xf, true) : stp == 1 ? __builtin_amdgcn_mov_dpp(bj, 0x4E, 0xf, 0xf, true) : __builtin_amdgcn_mov_dpp(bj, 0x141, 0xf, 0xf, true);
                        const bool tk = (ov > bv) || (ov == bv && oj < bj); bv = tk ? ov : bv; bj = tk ? oj : bj; }
#pragma unroll
                    for (int k = 0; k < 16; ++k) val[k] = (bj == s8 + 8 * k) ? -INFINITY : val[k];
                    const unsigned bit = 1u << (bj & 31); const int wsel = bj >> 5;
                    mw0 |= (wsel == 0) ? bit : 0u; mw1 |= (wsel == 1) ? bit : 0u; mw2 |= (wsel == 2) ? bit : 0u; mw3 |= (wsel == 3) ? bit : 0u;
                }
            }
            if (s8 == 0) { Lmask[q * 4 + 0] = mw0; Lmask[q * 4 + 1] = mw1; Lmask[q * 4 + 2] = mw2; Lmask[q * 4 + 3] = mw3;
                atomicOr((unsigned*)&Lunion[0], mw0); atomicOr((unsigned*)&Lunion[1], mw1); atomicOr((unsigned*)&Lunion[2], mw2); atomicOr((unsigned*)&Lunion[3], mw3); }
        }
        __syncthreads();
        int nsel;
        { const unsigned u0 = Lunion[0], u1 = Lunion[1], u2 = Lunion[2], u3 = Lunion[3];
          nsel = __builtin_amdgcn_readfirstlane(__popc(u0) + __popc(u1) + __popc(u2) + __popc(u3));
          if (tid < 128) { const unsigned uw = (tid < 32) ? u0 : (tid < 64) ? u1 : (tid < 96) ? u2 : u3; const int bp = tid & 31;
              if ((uw >> bp) & 1u) { int pos = __popc(uw & ((1u << bp) - 1u)); if (tid >= 32) pos += __popc(u0); if (tid >= 64) pos += __popc(u1); if (tid >= 96) pos += __popc(u2); Lblist[pos] = tid; } } }
        const unsigned mq0 = Lmask[ql * 4 + 0], mq1 = Lmask[ql * 4 + 1], mq2 = Lmask[ql * 4 + 2], mq3 = Lmask[ql * 4 + 3];
        __syncthreads();
#pragma unroll
        for (int db = 0; db < 2; ++db)
#pragma unroll
            for (int r = 0; r < 16; ++r) Ltot[(db * 16 + r) * 512] = o[db][r];
        const bf16* kwb = KVC + 4 * KVSTRIDE + (size_t)bg * 8192 * 64; const bf16* vwb = KVC + 5 * KVSTRIDE + (size_t)bg * 8192 * 64;
        o[0] = (f32x16){}; o[1] = (f32x16){}; m = 0.f; l = 0.f;
#pragma unroll 1
        for (int st = 0; 2 * st < nsel; ++st) {
            NSA_STAGE_BAR();
            { const int i2 = 2 * st + 2, sb = ((sp + st + 1) & 1) * 2; if (i2 < nsel) { nsa_dma(ksb, vsb, __builtin_amdgcn_readfirstlane(Lblist[nsel - 1 - i2]) * 64, lds, sb, wave, lane); if (i2 + 1 < nsel) nsa_dma(ksb, vsb, __builtin_amdgcn_readfirstlane(Lblist[nsel - 2 - i2]) * 64, lds, sb + 1, wave, lane); }
              else { nsa_dma(kwb, vwb, qt * 64, lds, sb, wave, lane); if (qt > 0) nsa_dma(kwb, vwb, (qt - 1) * 64, lds, sb + 1, wave, lane); } }
#pragma unroll 1
            for (int h2 = 0; h2 < 2; ++h2) { const int i = 2 * st + h2; if (i >= nsel) break; const int j = __builtin_amdgcn_readfirstlane(Lblist[nsel - 1 - i]), buf = ((sp + st) & 1) * 2 + h2;
                const unsigned wj = (j < 32) ? mq0 : (j < 64) ? mq1 : (j < 96) ? mq2 : mq3; const bool selq = (wj >> (j & 31)) & 1u;
                const int base = t - (64 * j + 4 * hi);
                f32x16 p0, p1; nsa_bias<1>(p0, p1, base, slope2, m, selq);
                qkt<4>(p0, p1, lds + NS_K + buf * 8192, qr, r32, hi);
                s16x4 vl[2][4], vh[2][4]; vfrag_issue<2>(vl, vh, lds + NS_V + buf * 8192, lane);
                if (j == cur) nsa_mask<1, false>(p0, p1, base);
                nsa_softmax<2>(p0, p1, m, l, o);
                bf16x8 pa[4]; pack_p(pa, p0, p1);
                pv_frag<2>(o, vl, vh, pa); }
        }
        sp = (sp + ((nsel + 1) >> 1)) & 1;
        { l += __shfl_xor(l, 32); const float sc = gate[1] / fmaxf(l, 1e-30f);
#pragma unroll
          for (int db = 0; db < 2; ++db)
#pragma unroll
            for (int r = 0; r < 16; ++r) Ltot[(db * 16 + r) * 512] += sc * o[db][r]; }
        o[0] = (f32x16){}; o[1] = (f32x16){}; m = 0.f; l = 0.f;
        const int j0 = qt >= 8 ? qt - 8 : 0, nw = qt - j0 + 1;
#pragma unroll 1
        for (int st = 0; 2 * st < nw; ++st) {
            NSA_STAGE_BAR();
            if (st == 0 && ok_n) { const size_t rown_ = (size_t)(bgn >> 1) * T + qtn * 64 + ql; const int headn_ = (bgn & 1) * 4 + hp;
#pragma unroll
                for (int d0 = 0; d0 < 4; ++d0) qnx[d0] = *(const bf16x8*)(PB + rown_ * NPB + PB_Q + headn_ * 64 + d0 * 16 + hi * 8);
#pragma unroll
                for (int i = 0; i < 3; ++i) gnx[i] = PB[rown_ * NPB + PB_GL + headn_ * 3 + i]; }
            { const int i2 = 2 * st + 2, sb = ((sp + st + 1) & 1) * 2; if (i2 < nw) { nsa_dma(kwb, vwb, (qt - i2) * 64, lds, sb, wave, lane); if (i2 + 1 < nw) nsa_dma(kwb, vwb, (qt - i2 - 1) * 64, lds, sb + 1, wave, lane); }
              else if (ok_n) { const int ntn = (4 * qtn + 3 + 63) >> 6; const bf16* kcn = KCMP + (size_t)(bgn * NCMPP) * 64; nsa_dma(kcn, nullptr, (ntn - 1) * 64, lds, sb, wave, lane); if (ntn > 1) nsa_dma(kcn, nullptr, (ntn - 2) * 64, lds, sb + 1, wave, lane); } }
#pragma unroll 1
            for (int h2 = 0; h2 < 2; ++h2) { const int i = 2 * st + h2; if (i >= nw) break; const int j = qt - i, buf = ((sp + st) & 1) * 2 + h2;
                const int base = t - (64 * j + 4 * hi);
                f32x16 p0, p1; nsa_bias<1>(p0, p1, base, slope2, m); qkt<4>(p0, p1, lds + NS_K + buf * 8192, qr, r32, hi);
                s16x4 vl[2][4], vh[2][4]; vfrag_issue<2>(vl, vh, lds + NS_V + buf * 8192, lane);
                if (j == qt || j + 8 == qt) nsa_mask<1, true>(p0, p1, base);
                nsa_softmax<2>(p0, p1, m, l, o);
                bf16x8 pa[4]; pack_p(pa, p0, p1);
                pv_frag<2>(o, vl, vh, pa); }
        }
        sp = (sp + ((nw + 1) >> 1)) & 1;
        { l += __shfl_xor(l, 32); const float sc = gate[2] / fmaxf(l, 1e-30f);
          bf16* op = CAT + row * 1024 + head * 64;
#pragma unroll
          for (int db = 0; db < 2; ++db)
#pragma unroll
            for (int rg = 0; rg < 4; rg += 2) { v2u wp[2];
#pragma unroll
                for (int k = 0; k < 2; ++k) { const int r_ = 4 * (rg + k); const float v0 = Ltot[(db * 16 + r_) * 512] + sc * o[db][r_], v1 = Ltot[(db * 16 + r_ + 1) * 512] + sc * o[db][r_ + 1], v2 = Ltot[(db * 16 + r_ + 2) * 512] + sc * o[db][r_ + 2], v3 = Ltot[(db * 16 + r_ + 3) * 512] + sc * o[db][r_ + 3];
                    wp[k].x = cvtpk(v0, v1); wp[k].y = cvtpk(v2, v3); }
                st_pair16(op + 32 * db + 8 * rg, hi, wp[0], wp[1]); } }
    }
#undef NSA_UNIT
    __builtin_amdgcn_s_setprio(0);
    asm volatile("s_waitcnt vmcnt(0)" ::: "memory"); __syncthreads();
}
constexpr size_t WS_DS = WS_OG, WS_SP = WS_LA, WS_DEC = WS_R2 + 96 * MiB;
constexpr int GL_ALR = 0, GL_TOT = 4096  , GL_KE = 8192, GL_V = 40960;
static_assert(GL_V + 65536 <= LDSCTL_OFF, "GLA LDS map");
__device__ __forceinline__ void gla_dma_v(const bf16* PA, int row0, LAS unsigned char* lds, int wave, int lane) {
#pragma unroll
    for (int j = 0; j < 8; ++j) { const int pc = wave * 8 + j, h = pc >> 4, db = (pc >> 2) & 3, kg4 = pc & 3;
        dma16((const char*)(PA + (size_t)(row0 + kg4 * 16 + (lane >> 2)) * NPA + PA_V + h * 128 + db * 32) + (lane & 3) * 16, lds + GL_V + h * 16384 + db * 4096 + kg4 * 1024); }
}
__device__ __forceinline__ void ph_gla_local(Frame& F) {
    bf16* PA = WSP(bf16, WS_R1); bf16* DS = WSP(bf16, WS_DS); float* DEC = WSP(float, WS_DEC);
    const float* wa = in_ptr(I_AWALPHA); const float* ba = in_ptr(I_ABALPHA);
    const int lane = F.lane, wave = F.wave, tid = F.tid, r32 = lane & 31, hi = lane >> 5;
    LAS unsigned char* lds = F.lds; LAS float* Lalr = (LAS float*)(lds + GL_ALR); LAS float* Ltot = (LAS float*)(lds + GL_TOT);
    typedef float f32x2_ __attribute__((ext_vector_type(2)));
    const int cp = tid & 127, qtr = tid >> 7, ch = 2 * cp, h = ch >> 6, d = ch & 63;
    float w0[16], w1[16];
#pragma unroll
    for (int j = 0; j < 16; ++j) { const f32x2_ t_ = *(const f32x2_*)(wa + j * 256 + ch); w0[j] = t_.x; w1[j] = t_.y; }
    const f32x2_ bias2 = *(const f32x2_*)(ba + ch);
#pragma unroll 1
    for (int u = blockIdx.x; u < 512; u += F.G) {
        const int b = u >> 7, c = u & 127, row0 = b * T + c * 64;
        gla_dma_v(PA, row0, lds, wave, lane);
#pragma unroll
        for (int k = 0; k < 2; ++k) { const int idx = tid + 512 * k; Lalr[idx] = bf2f(PA[(size_t)(row0 + (idx >> 4)) * NPA + PA_ALR + (idx & 15)]); }
        unsigned kraw[16];
#pragma unroll
        for (int i = 0; i < 16; ++i) kraw[i] = *(const unsigned*)(PA + (size_t)(row0 + qtr * 16 + i) * NPA + PA_K + ch);
        unsigned qraw[16];
#pragma unroll
        for (int i = 0; i < 16; ++i) qraw[i] = *(const unsigned*)(PA + (size_t)(row0 + qtr * 16 + i) * NPA + PA_Q + ch);
        LDS_WAIT(); __syncthreads();
        float b0[16], b1[16]; float run0 = 0.f, run1 = 0.f;
#pragma unroll
        for (int i = 0; i < 16; ++i) { const LAS f32x4* ap = (const LAS f32x4*)(Lalr + (qtr * 16 + i) * 16); const f32x4 a0 = ap[0], a1 = ap[1], a2 = ap[2], a3 = ap[3];
            const float z0 = bias2.x + a0.x * w0[0] + a0.y * w0[1] + a0.z * w0[2] + a0.w * w0[3] + a1.x * w0[4] + a1.y * w0[5] + a1.z * w0[6] + a1.w * w0[7] + a2.x * w0[8] + a2.y * w0[9] + a2.z * w0[10] + a2.w * w0[11] + a3.x * w0[12] + a3.y * w0[13] + a3.z * w0[14] + a3.w * w0[15];
            const float z1 = bias2.y + a0.x * w1[0] + a0.y * w1[1] + a0.z * w1[2] + a0.w * w1[3] + a1.x * w1[4] + a1.y * w1[5] + a1.z * w1[6] + a1.w * w1[7] + a2.x * w1[8] + a2.y * w1[9] + a2.z * w1[10] + a2.w * w1[11] + a3.x * w1[12] + a3.y * w1[13] + a3.z * w1[14] + a3.w * w1[15];
            const float ls0 = fminf(z0, 0.f) - __logf(1.0f + __expf(-fabsf(z0))), ls1 = fminf(z1, 0.f) - __logf(1.0f + __expf(-fabsf(z1)));
            run0 += ls0 * (1.0f / 16.0f); b0[i] = run0; run1 += ls1 * (1.0f / 16.0f); b1[i] = run1; }
        { f32x2_ t_; t_.x = run0; t_.y = run1; ((LAS f32x2_*)Ltot)[qtr * 128 + cp] = t_; }
        LDS_WAIT(); __syncthreads();
        float bl0, bl1;
        { const f32x2_ t0 = ((const LAS f32x2_*)Ltot)[cp], t1 = ((const LAS f32x2_*)Ltot)[128 + cp], t2 = ((const LAS f32x2_*)Ltot)[256 + cp], t3 = ((const LAS f32x2_*)Ltot)[384 + cp];
          const float o1x = t0.x, o2x = t0.x + t1.x, o3x = o2x + t2.x, o1y = t0.y, o2y = t0.y + t1.y, o3y = o2y + t2.y;
          bl0 = o3x + t3.x; bl1 = o3y + t3.y;
          const float off0 = qtr == 0 ? 0.f : qtr == 1 ? o1x : qtr == 2 ? o2x : o3x, off1 = qtr == 0 ? 0.f : qtr == 1 ? o1y : qtr == 2 ? o2y : o3y;
#pragma unroll
          for (int i = 0; i < 16; ++i) { b0[i] = off0 + b0[i]; b1[i] = off1 + b1[i]; } }
        LAS unsigned* ke = (LAS unsigned*)(lds + GL_KE + h * 8192 + (d >> 5) * 4096 + (d & 31) * 2);
        {
#pragma unroll
          for (int i = 0; i < 16; ++i) { const int t = qtr * 16 + i; ke[t * 16] = pk2(bflo(kraw[i]) * __expf(bl0 - b0[i]), bfhi(kraw[i]) * __expf(bl1 - b1[i])); }
#pragma unroll
          for (int i = 0; i < 16; ++i) { bf16* rowp = PA + (size_t)(row0 + qtr * 16 + i) * NPA + ch;
              *(unsigned*)(rowp + PA_K) = pg8::cvt_pk_bf16(bflo(kraw[i]) * __expf(-b0[i]), bfhi(kraw[i]) * __expf(-b1[i]));
              *(unsigned*)(rowp + PA_Q) = pg8::cvt_pk_bf16(bflo(qraw[i]) * 0.125f * __expf(b0[i]), bfhi(qraw[i]) * 0.125f * __expf(b1[i])); } }
        if (qtr == 3) { f32x2_ t_; t_.x = __expf(bl0); t_.y = __expf(bl1); *(f32x2_*)(DEC + ((size_t)(b * 4 + h) * 128 + c) * 64 + d) = t_; }
        asm volatile("s_waitcnt vmcnt(0)" ::: "memory"); LDS_WAIT(); __syncthreads();
        { const int hw = wave >> 1, nb = wave & 1;
          const unsigned lo_ = ((lane >> 4) & 1) * 32 + (lane & 3) * 8 + (8 * hi + ((lane & 15) >> 2)) * 64;
          const LAS unsigned char* kb = lds + GL_KE + hw * 8192 + nb * 4096 + lo_; const LAS unsigned char* vb = lds + GL_V + hw * 16384 + lo_;
          bf16x8 kf[4];
#pragma unroll
          for (int ks = 0; ks < 4; ++ks) { const s16x4 a = vtr(kb + ks * 1024), bq = vtr(kb + ks * 1024 + 256); kf[ks] = (bf16x8){a[0], a[1], a[2], a[3], bq[0], bq[1], bq[2], bq[3]}; }
          bf16* dsb = DS + ((size_t)(b * 4 + hw) * 128 + c) * 8192 + (size_t)r32 * 64 + nb * 32;
#pragma unroll
          for (int mb = 0; mb < 4; ++mb) { f32x16 acc = (f32x16){};
#pragma unroll
              for (int ks = 0; ks < 4; ++ks) { const s16x4 a = vtr(vb + mb * 4096 + ks * 1024), bq = vtr(vb + mb * 4096 + ks * 1024 + 256); const bf16x8 vf = {a[0], a[1], a[2], a[3], bq[0], bq[1], bq[2], bq[3]};
                  acc = __builtin_amdgcn_mfma_f32_32x32x16_bf16(kf[ks], vf, acc, 0, 0, 0); }
#pragma unroll
              for (int rg = 0; rg < 4; rg += 2) { v2u w, w2; w.x = cvtpk(acc[4 * rg], acc[4 * rg + 1]); w.y = cvtpk(acc[4 * rg + 2], acc[4 * rg + 3]); w2.x = cvtpk(acc[4 * rg + 4], acc[4 * rg + 5]); w2.y = cvtpk(acc[4 * rg + 6], acc[4 * rg + 7]);
                  st_pair16(dsb + (size_t)mb * 32 * 64 + 8 * rg, hi, w, w2); } } }
        __syncthreads();
    }
}
__device__ __forceinline__ void ph_gla_scan(Frame& F) {
    const bf16* __restrict__ DS = WSP(bf16, WS_DS); const float* __restrict__ DEC = WSP(float, WS_DEC); bf16* __restrict__ SP = WSP(bf16, WS_SP);
    typedef float f32x2_ __attribute__((ext_vector_type(2)));
    constexpr int NB_ = 32;
    if (F.tid >= 256) return;
#pragma unroll 1
    for (int i = blockIdx.x * 256 + F.tid; i < 16 * 128 * 32; i += F.G * 256) { const int dp = i & 31, e = (i >> 5) & 127, bh = i >> 12;
        const bf16* dsp = DS + (size_t)bh * 128 * 8192 + e * 64 + 2 * dp; const float* dcp = DEC + (size_t)bh * 128 * 64 + 2 * dp; bf16* spp = SP + (size_t)bh * 128 * 8192 + e * 64 + 2 * dp;
        float S0 = 0.f, S1 = 0.f; unsigned ds[NB_]; f32x2_ dc[NB_];
#pragma unroll
        for (int k = 0; k < NB_; ++k) { ds[k] = *(const unsigned*)(dsp + (size_t)k * 8192); dc[k] = *(const f32x2_*)(dcp + k * 64); }
#pragma unroll 1
        for (int c0 = 0; c0 < 128; c0 += NB_) { unsigned dn[NB_]; f32x2_ cn[NB_]; const int cn0 = c0 + NB_ < 128 ? c0 + NB_ : c0;
#pragma unroll
            for (int k = 0; k < NB_; ++k) { dn[k] = *(const unsigned*)(dsp + (size_t)(cn0 + k) * 8192); cn[k] = *(const f32x2_*)(dcp + (cn0 + k) * 64); }
#pragma unroll
            for (int k = 0; k < NB_; ++k) { *(unsigned*)(spp + (size_t)(c0 + k) * 8192) = pg8::cvt_pk_bf16(S0, S1); S0 = dc[k].x * S0 + bflo(ds[k]); S1 = dc[k].y * S1 + bfhi(ds[k]); }
#pragma unroll
            for (int k = 0; k < NB_; ++k) { ds[k] = dn[k]; dc[k] = cn[k]; } } }
}
__device__ __forceinline__ void ph_gla_out(Frame& F) {
    const bf16* __restrict__ PA = WSP(bf16, WS_R1); const bf16* __restrict__ SP = WSP(bf16, WS_SP); bf16* __restrict__ CAT = WSP(bf16, WS_CAT); const float* __restrict__ gh = in_ptr(I_AGHEAD);
    const int lane = F.lane, wave = F.wave, r32 = lane & 31, hi = lane >> 5;
    LAS unsigned char* lds = F.lds;
    typedef unsigned u32x4_t __attribute__((ext_vector_type(4)));
    if (wave >= 4) __builtin_amdgcn_s_setprio(1);
#pragma unroll 1
    for (int u = blockIdx.x; u < 512; u += F.G) {
        const int b = u >> 7, c = u & 127, row0 = b * T + c * 64, h = wave >> 1, tb = wave & 1, t = 32 * tb + r32;
        gla_dma_v(PA, row0, lds, wave, lane);
        bf16x8 qr[4], kf0[4];
#pragma unroll
        for (int ks = 0; ks < 4; ++ks) { qr[ks] = *(const bf16x8*)(PA + (size_t)(row0 + t) * NPA + PA_Q + h * 64 + 16 * ks + 8 * hi); kf0[ks] = *(const bf16x8*)(PA + (size_t)(row0 + r32) * NPA + PA_K + h * 64 + 16 * ks + 8 * hi); }
        f32x16 pT[2]; pT[0] = (f32x16){}; pT[1] = (f32x16){};
        if (tb == 1) { bf16x8 kf1[4];
#pragma unroll
            for (int ks = 0; ks < 4; ++ks) kf1[ks] = *(const bf16x8*)(PA + (size_t)(row0 + 32 + r32) * NPA + PA_K + h * 64 + 16 * ks + 8 * hi);
#pragma unroll
            for (int ks = 0; ks < 4; ++ks) pT[0] = __builtin_amdgcn_mfma_f32_32x32x16_bf16(kf0[ks], qr[ks], pT[0], 0, 0, 0);
#pragma unroll
            for (int ks = 0; ks < 4; ++ks) pT[1] = __builtin_amdgcn_mfma_f32_32x32x16_bf16(kf1[ks], qr[ks], pT[1], 0, 0, 0);
#pragma unroll
            for (int r = 0; r < 16; ++r) pT[1][r] = (crow(r, hi) <= r32) ? pT[1][r] : 0.f;
        } else {
#pragma unroll
            for (int ks = 0; ks < 4; ++ks) pT[0] = __builtin_amdgcn_mfma_f32_32x32x16_bf16(kf0[ks], qr[ks], pT[0], 0, 0, 0);
#pragma unroll
            for (int r = 0; r < 16; ++r) pT[0][r] = (crow(r, hi) <= r32) ? pT[0][r] : 0.f; }
        bf16x8 pa[4]; pack_p(pa, pT[0], pT[1]);
        f32x16 o[4];
        const bf16* spb = SP + ((size_t)(b * 4 + h) * 128 + c) * 8192 + (size_t)r32 * 64 + 8 * hi;
        { bf16x8 sf[4][4];
#pragma unroll
          for (int eb = 0; eb < 4; ++eb)
#pragma unroll
            for (int ks = 0; ks < 4; ++ks) sf[eb][ks] = *(const bf16x8*)(spb + (size_t)eb * 32 * 64 + 16 * ks);
#pragma unroll
          for (int eb = 0; eb < 4; ++eb) { o[eb] = (f32x16){};
#pragma unroll
            for (int ks = 0; ks < 4; ++ks) o[eb] = __builtin_amdgcn_mfma_f32_32x32x16_bf16(sf[eb][ks], qr[ks], o[eb], 0, 0, 0); } }
        const bf16* rp = PA + (size_t)(row0 + t) * NPA + PA_R + h * 128;
        v4u rw4[4][2];
#pragma unroll
        for (int eb = 0; eb < 4; ++eb)
#pragma unroll
            for (int rp2 = 0; rp2 < 2; ++rp2) rw4[eb][rp2] = *(const v4u*)(rp + 32 * eb + 16 * rp2 + 8 * hi);
        f32x4 gv[4][4];
#pragma unroll
        for (int eb = 0; eb < 4; ++eb)
#pragma unroll
            for (int rg = 0; rg < 4; ++rg) gv[eb][rg] = *(const f32x4*)(gh + 32 * eb + 8 * rg + 4 * hi);
        asm volatile("s_waitcnt vmcnt(0)" ::: "memory"); __syncthreads();
        { s16x4 vl[2][4], vh[2][4]; vfrag_issue<2>(vl, vh, lds + GL_V + h * 16384, lane); pv_frag<2>(o, vl, vh, pa);
          s16x4 vl2[2][4], vh2[2][4]; vfrag_issue<2>(vl2, vh2, lds + GL_V + h * 16384 + 8192, lane); pv_frag<2>(o + 2, vl2, vh2, pa); }
        float ss = 0.f;
#pragma unroll
        for (int eb = 0; eb < 4; ++eb)
#pragma unroll
            for (int r = 0; r < 16; ++r) ss += o[eb][r] * o[eb][r];
        ss += __shfl_xor(ss, 32);
        const float rs = __builtin_amdgcn_rsqf(ss * (1.0f / 128.0f) + 1e-6f);
        bf16* op = CAT + (size_t)(row0 + t) * 1024 + h * 128;
        v2u rw[4][4];
#pragma unroll
        for (int eb = 0; eb < 4; ++eb)
#pragma unroll
            for (int rp2 = 0; rp2 < 2; ++rp2) { const v4u w4 = rw4[eb][rp2];
                const auto r0 = __builtin_amdgcn_permlane32_swap(w4.x, w4.z, false, false); const auto r1 = __builtin_amdgcn_permlane32_swap(w4.y, w4.w, false, false);
                rw[eb][2 * rp2].x = r0[0]; rw[eb][2 * rp2].y = r1[0]; rw[eb][2 * rp2 + 1].x = r0[1]; rw[eb][2 * rp2 + 1].y = r1[1]; }
#pragma unroll
        for (int eb = 0; eb < 4; ++eb)
#pragma unroll
            for (int rg = 0; rg < 4; rg += 2) { v2u wp[2];
#pragma unroll
                for (int k = 0; k < 2; ++k) { const v2u w_ = rw[eb][rg + k]; const f32x4 g_ = gv[eb][rg + k]; const int r_ = 4 * (rg + k);
                    const float r0 = bflo(w_.x), r1 = bfhi(w_.x), r2 = bflo(w_.y), r3 = bfhi(w_.y);
                    const float y0 = o[eb][r_] * rs * g_.x * (r0 * pg8::sigmoid_f(r0)), y1 = o[eb][r_ + 1] * rs * g_.y * (r1 * pg8::sigmoid_f(r1)), y2 = o[eb][r_ + 2] * rs * g_.z * (r2 * pg8::sigmoid_f(r2)), y3 = o[eb][r_ + 3] * rs * g_.w * (r3 * pg8::sigmoid_f(r3));
                    wp[k].x = cvtpk(y0, y1); wp[k].y = cvtpk(y2, y3); }
                st_pair16(op + 32 * eb + 8 * rg, hi, wp[0], wp[1]); }
        __syncthreads();
    }
    __builtin_amdgcn_s_setprio(0);
}
__device__ __forceinline__ void ph_ffn_fix(Frame& F, int layer) {
    typedef float f32x2_ __attribute__((ext_vector_type(2)));
    const float* __restrict__ bndA = WSP(float, WS_BND); const float* __restrict__ bndHA = WSP(float, WS_BND + BND_ONE); const float* __restrict__ bndHB = WSP(float, WS_BND + 2 * BND_ONE); bf16* __restrict__ H = WSP(bf16, WS_R1);
    const float* __restrict__ cw = in_ptr(I_CONVW) + (size_t)layer * 3 * FF; const float* __restrict__ cb = in_ptr(I_CONVB) + (size_t)layer * FF;
    const int gt = blockIdx.x * 512 + F.tid, NT = F.G * 512; constexpr int FP = FF / 2, NE = 512 * 2 * FP;
#pragma unroll 1
    for (int i0 = gt; i0 < NE; i0 += 8 * NT) {
        f32x2_ a0[8], pm1[8], pm2[8], h0[8], hb[8], w0[8], w1[8], w2[8], c0[8]; int fr_[8], G_[8], f_[8]; bool ok[8], first[8];
#pragma unroll
        for (int j = 0; j < 8; ++j) { const int idx = i0 + j * NT; ok[j] = idx < NE; const int id = ok[j] ? idx : 0; const int f = 2 * (id % FP), gr = id / FP, G = gr >> 1, fr = gr & 1; f_[j] = f; G_[j] = G; fr_[j] = fr; first[j] = (G & 127) == 0;
            const int Gp = first[j] ? G : G - 1; const size_t e = (size_t)gr * FF + f;
            a0[j] = *(const f32x2_*)(bndHA + e); hb[j] = *(const f32x2_*)(bndHB + e); pm1[j] = *(const f32x2_*)(bndA + ((size_t)Gp * 2 + 1) * FF + f); pm2[j] = *(const f32x2_*)(bndA + ((size_t)Gp * 2 + 0) * FF + f); h0[j] = *(const f32x2_*)(bndHA + ((size_t)G * 2) * FF + f);
            w0[j] = *(const f32x2_*)(cw + f); w1[j] = *(const f32x2_*)(cw + FF + f); w2[j] = *(const f32x2_*)(cw + 2 * FF + f); c0[j] = *(const f32x2_*)(cb + f); }
#pragma unroll
        for (int j = 0; j < 8; ++j) { if (!ok[j]) continue; float hv[2];
#pragma unroll
            for (int e = 0; e < 2; ++e) { const float p1 = first[j] ? 0.f : pm1[j][e], p2 = first[j] ? 0.f : pm2[j][e];
                const float a1 = fr_[j] ? h0[j][e] : p1, a2 = fr_[j] ? p1 : p2;
                const float cv = w0[j][e] * a2 + w1[j][e] * a1 + w2[j][e] * a0[j][e] + c0[j][e];
                hv[e] = cv / (1.0f + __expf(-cv)) * hb[j][e]; }
            *(unsigned*)(H + (size_t)(G_[j] * 64 + fr_[j]) * FF + f_[j]) = pk2(hv[0], hv[1]); }
    }
}
__device__ __forceinline__ void ph_cmp2(Frame& F, int mlp, int rb_lo, int n_rb, int gw, int NGW) {
    const bf16* CH = WSP(bf16, WS_CH); bf16* KC = WSP(bf16, WS_KCMP); const bf16* W2 = WSP(bf16, WS_WC2);
    const int lane = F.lane, r32 = lane & 31, hi = lane >> 5;
#pragma unroll 1
    for (int u = gw; u < 2 * n_rb; u += NGW) { const int cb = u & 1, rb = rb_lo + (u >> 1);
        const bf16* ap = W2 + (size_t)(mlp * 64 + 32 * cb + r32) * 256 + 8 * hi; const bf16* bp = CH + ((size_t)mlp * 4096 + 32 * rb + r32) * 256 + 8 * hi;
        f32x16 acc = (f32x16){};
#pragma unroll
        for (int ks = 0; ks < 16; ++ks) acc = __builtin_amdgcn_mfma_f32_32x32x16_bf16(*(const bf16x8*)(ap + 16 * ks), *(const bf16x8*)(bp + 16 * ks), acc, 0, 0, 0);
        bf16* op = KC + ((size_t)mlp * 4096 + 32 * rb + r32) * 64 + 32 * cb;
#pragma unroll
        for (int rg = 0; rg < 4; rg += 2) { v2u w, w2; w.x = cvtpk(acc[4 * rg], acc[4 * rg + 1]); w.y = cvtpk(acc[4 * rg + 2], acc[4 * rg + 3]); w2.x = cvtpk(acc[4 * rg + 4], acc[4 * rg + 5]); w2.y = cvtpk(acc[4 * rg + 6], acc[4 * rg + 7]);
            st_pair16(op + 8 * rg, hi, w, w2); } }
}
__device__ __forceinline__ void cmp2_rowblock(Frame& F, int mlp, int rb) {
    const bf16* CH = WSP(bf16, WS_CH); bf16* KC = WSP(bf16, WS_KCMP); const bf16* W2 = WSP(bf16, WS_WC2);
    const int lane = F.lane, r32 = lane & 31, hi = lane >> 5;
    const bf16* bp = CH + ((size_t)mlp * 4096 + 32 * rb + r32) * 256 + 8 * hi; const bf16* ap = W2 + (size_t)(mlp * 64 + r32) * 256 + 8 * hi;
    bf16x8 bq[16], a0[16], a1[16];
#pragma unroll
    for (int ks = 0; ks < 16; ++ks) { bq[ks] = *(const bf16x8*)(bp + 16 * ks); a0[ks] = *(const bf16x8*)(ap + 16 * ks); a1[ks] = *(const bf16x8*)(ap + 32 * 256 + 16 * ks); }
    f32x16 acc0 = (f32x16){}, acc1 = (f32x16){};
#pragma unroll
    for (int ks = 0; ks < 16; ++ks) { acc0 = __builtin_amdgcn_mfma_f32_32x32x16_bf16(a0[ks], bq[ks], acc0, 0, 0, 0); acc1 = __builtin_amdgcn_mfma_f32_32x32x16_bf16(a1[ks], bq[ks], acc1, 0, 0, 0); }
    bf16* op = KC + ((size_t)mlp * 4096 + 32 * rb + r32) * 64;
#pragma unroll
    for (int cb = 0; cb < 2; ++cb)
#pragma unroll
        for (int rg = 0; rg < 4; rg += 2) { const f32x16& acc = cb ? acc1 : acc0; v2u w, w2; w.x = cvtpk(acc[4 * rg], acc[4 * rg + 1]); w.y = cvtpk(acc[4 * rg + 2], acc[4 * rg + 3]); w2.x = cvtpk(acc[4 * rg + 4], acc[4 * rg + 5]); w2.y = cvtpk(acc[4 * rg + 6], acc[4 * rg + 7]);
            st_pair16(op + 32 * cb + 8 * rg, hi, w, w2); }
}
__device__ __forceinline__ void ph_final(Frame& F, float* dst) {
    const float* __restrict__ SS = WSP(float, WS_SS); const float* gf = in_ptr(I_GFINAL);
    const int gw = blockIdx.x * NWAVES + F.wave, NGW = F.G * NWAVES, lane = F.lane;
    const bf16* __restrict__ XBp = WSP(bf16, WS_XB);
    f32x4 g[4];
#pragma unroll
    for (int j = 0; j < 4; ++j) g[j] = *((const f32x4*)gf + lane + 64 * j);
#pragma unroll 1
    for (int m0 = gw; m0 < M; m0 += 4 * NGW) {
        v2u xw[4][4]; f32x4 sv[4];
#pragma unroll
        for (int q = 0; q < 4; ++q) { const int m = (m0 + q * NGW) < M ? (m0 + q * NGW) : (M - 1); sv[q] = *(const f32x4*)(SS + (size_t)m * 16 + 4 * (lane & 3));
#pragma unroll
            for (int j = 0; j < 4; ++j) xw[q][j] = *((const GAS v2u*)(XBp + (size_t)m * D) + lane + 64 * j); }
#pragma unroll
        for (int q = 0; q < 4; ++q) { const int m = m0 + q * NGW; if (m >= M) break;
            float ssum = (sv[q].x + sv[q].y) + (sv[q].z + sv[q].w); ssum += __shfl_xor(ssum, 1); ssum += __shfl_xor(ssum, 2);
            const float rs = __builtin_amdgcn_rsqf(ssum * (1.0f / 1024.0f) + pg8::RMS_EPS);
#pragma unroll
            for (int j = 0; j < 4; ++j) { f32x4 o; o.x = bflo(xw[q][j].x) * rs * g[j].x; o.y = bfhi(xw[q][j].x) * rs * g[j].y; o.z = bflo(xw[q][j].y) * rs * g[j].z; o.w = bfhi(xw[q][j].y) * rs * g[j].w;
                ((GAS f32x4*)(dst + (size_t)m * D) + lane)[64 * j] = o; } }
    }
}

#ifndef MK_PHASE_LAUNCHES
#define MK_PHASE_LAUNCHES 0
#endif
constexpr int N_PHASES = 18;
#ifndef PH_MASK
#define PH_MASK 0x3ffff
#endif
#define PH_ON(k) (((PH_MASK) >> (k)) & 1)
struct Args { const float* in[26]; float* out; unsigned char* ws; int ph_lo, ph_hi; };
__global__ void __launch_bounds__(NWAVES * 64, 2) yoco_fwd(Args args) {
    extern __shared__ __attribute__((aligned(16))) unsigned char lds[];
    Frame F;
    F.lds = (LAS unsigned char*)lds;
    F.MISC = (volatile LAS unsigned*)(F.lds + MISC_OFF);
    F.tid = threadIdx.x; F.lane = F.tid & 63; F.wave = __builtin_amdgcn_readfirstlane(F.tid >> 6);
    F.G = gridDim.x;
    F.out = args.out; F.ws = args.ws; F.ctl = (gu32*)(args.ws + WS_CTL);
    for (int u = F.tid; u < (LDS_BYTES - LDSCTL_OFF) / 4; u += NWAVES * 64) ((LAS unsigned*)(F.lds + LDSCTL_OFF))[u] = 0u;
    __syncthreads();
    XcdBarrier bar; bar.bar = (unsigned*)(F.ctl + CW_BAR); bar.x = 0; bar.st = nullptr;
    if (!MK_PHASE_LAUNCHES) bar = xcd_barrier_post((unsigned*)(F.ctl + CW_BAR), F.MISC + 8);
    using pg8::Gemm; using pg8::StaticOrder;
    const int bx = (int)blockIdx.x;
#pragma unroll 1
    for (int p = args.ph_lo; p < args.ph_hi; ++p) {
        { int t_ = threadIdx.x; asm volatile("" : "+v"(t_)); F.tid = t_; F.lane = t_ & 63; F.wave = __builtin_amdgcn_readfirstlane(t_ >> 6); }
        { GAS unsigned char* w_ = (GAS unsigned char*)args.ws; int g_ = gridDim.x; asm volatile("" : "+s"(w_), "+s"(g_)); F.ws = (unsigned char*)w_; F.G = g_; }
        bf16* const XB = WSP(bf16, WS_XB); bf16* const CAT = WSP(bf16, WS_CAT); float* const SS = WSP(float, WS_SS); bf16* const R1 = WSP(bf16, WS_R1);
        switch (p) {
        case 0: if (PH_ON(0)) p0_prologue(F); break;
        case 1:
#pragma unroll 1
            for (int s = 0; s < 2 * PH_ON(1); ++s) {
                Gemm g = s ? Gemm{WSP(bf16, WS_MEMB), WSP(bf16, WS_WM), MROWS, 2048, D, D} : Gemm{XB, WSP(bf16, WS_WA), M, NPA, D, D};
                StaticOrder S; S.init(g.M, g.N, F.G, s ? (bx + 128) % F.G : bx);
                pg8::EpiScaleBf16 E = s ? pg8::EpiScaleBf16{WSP(bf16, WS_MKV), 2048, WSP(float, WS_SSM), 0, 0, 1.0f, -1, 0} : pg8::EpiScaleBf16{R1, NPA, SS, PA_MQ / 256, PA_MQ / 256 + 2, MEM_QSCALE, PA_ALR / 256, 16};
                pg8::gemm_phase<pg8::EpiScaleBf16, StaticOrder, true, true>(F.lds, g, S, E);
            }
            if (PH_ON(1) && F.G == 256 && bx >= 160) tr_items(F, (LAS float*)(F.lds + F.wave * 16384), (bx - 160) * NWAVES + F.wave, 96 * NWAVES, TR_NP0, TR_NITEMS, F.lane);
            if (PH_ON(1) && bx == F.G - 1) bias1_reduce(F);
            break;
        case 2: if (PH_ON(2)) { ph_gla_local(F); ph_memattn_mfma(F, R1, NPA, PA_MQ, 0, bx, F.G); } break;
        case 3: if (PH_ON(3)) ph_gla_scan(F); break;
        case 4: if (PH_ON(4)) ph_gla_out(F); break;
        case 5: case 8: case 13: case 16: if (PH_ON(5)) {
            const bool ffn = (p == 8 || p == 16); const int layer = p > 8 ? 1 : 0;
            Gemm g = ffn ? Gemm{R1, WSP(bf16, WS_WD) + (size_t)layer * D * FF, M, D, FF, FF} : Gemm{CAT, WSP(bf16, layer ? WS_WOB : WS_WOA), M, D, D, D};
            StaticOrder S; S.init(M, D, F.G, bx);
            if (p == 16 && F.G == 256) {
                pg8::EpiFinal E{XB, SS, F.out, in_ptr(I_GFINAL), (unsigned*)(F.ctl + CW_PANEL)};
                pg8::gemm_phase<pg8::EpiFinal, StaticOrder, true, true>(F.lds, g, S, E);
                break; }
            pg8::EpiResid E{XB, SS};
            pg8::gemm_phase<pg8::EpiResid, StaticOrder, true, true>(F.lds, g, S, E);
            break; }
        case 6: case 14: if (PH_ON(6)) {
            const int layer = p == 14 ? 1 : 0;
            Gemm g{XB, WSP(bf16, WS_WU) + (size_t)layer * 2 * FF * D, M, 2 * FF, D, D}; StaticOrder S; S.init(M, 2 * FF, F.G, bx);
            pg8::EpiUp E{R1, SS, in_ptr(I_CONVW) + (size_t)layer * 3 * FF, in_ptr(I_CONVB) + (size_t)layer * FF, WSP(float, WS_BND), WSP(float, WS_BND + BND_ONE), WSP(float, WS_BND + 2 * BND_ONE)};
            pg8::gemm_phase<pg8::EpiUp, StaticOrder, true, true>(F.lds, g, S, E);
            break; }
        case 7: case 15: if (PH_ON(7)) ph_ffn_fix(F, p == 15 ? 1 : 0); break;
        case 9: if (PH_ON(9)) {
            Gemm g{XB, WSP(bf16, WS_WB), M, NG5, D, D}; StaticOrder S; S.init(M, NG5, F.G, bx); pg8::EpiProjB E{WSP(bf16, WS_KVC), R1, SS};
            pg8::gemm_phase<pg8::EpiProjB, StaticOrder, true, true>(F.lds, g, S, E);
            break; }
        case 10:
#pragma unroll 1
            for (int s = 0; s < 2 * PH_ON(10); ++s) {
                Gemm g{WSP(bf16, WS_KVC) + (size_t)s * KVSTRIDE, WSP(bf16, WS_WC1) + (size_t)s * 256 * 2048, 4096, 256, 2048, 1024};
                StaticOrder S; S.init(4096, 256, F.G, s ? (bx + 240) % F.G : bx);
                pg8::EpiGelu E{WSP(bf16, WS_CH) + (size_t)s * 4096 * 256, WSP(float, WS_BIAS1) + s * 256};
                pg8::gemm_phase<pg8::EpiGelu, StaticOrder, true, true>(F.lds, g, S, E);
                asm volatile("s_waitcnt vmcnt(0)" ::: "memory"); __syncthreads();
#pragma unroll 1
                for (int i = 0; ; ++i) { pg8::Unit u; if (!S.next(i, u)) break; cmp2_rowblock(F, s, 8 * u.pm + F.wave); }
            }
            __syncthreads();
            if (PH_ON(10)) { if (F.G > 64) { if (bx >= 32) ph_memattn_mfma(F, R1, NPB, PB_MQ, 1, bx - 32, F.G - 32); }
                             else ph_memattn_mfma(F, R1, NPB, PB_MQ, 1, bx, F.G); }
            break;
        case 11: break;
        case 12: if (PH_ON(12)) ph_nsa_mfma(F); break;
        case 17: if (PH_ON(17) && F.G != 256) ph_final(F, F.out); break;
        default: break;
        }
        if (p + 1 < args.ph_hi && !(p == 16 && F.G == 256) && p != 11) xcd_barrier(bar);
    }
}

extern "C" void kernel_launch(void* const* d_in, const int* in_sizes, int n_in, void* d_out, int out_size, void* d_ws, size_t ws_size, hipStream_t stream) {
    static int grid = 0;
    if (grid == 0) {
        if (n_in != 26 || in_sizes[0] != M * D || out_size != M * D || ws_size < WS_END) { fprintf(stderr, "kernel_launch: unexpected shapes (n_in %d, in0 %d, out %d, ws %zu); nothing launched\n", n_in, n_in > 0 ? in_sizes[0] : -1, out_size, ws_size); grid = -1; return; }
        int dev = 0, cus = 0, per_cu = 0;
        if (hipGetDevice(&dev) != hipSuccess || hipDeviceGetAttribute(&cus, hipDeviceAttributeMultiprocessorCount, dev) != hipSuccess) { grid = -1; return; }
        if (hipFuncSetAttribute((const void*)yoco_fwd, hipFuncAttributeMaxDynamicSharedMemorySize, LDS_BYTES) != hipSuccess) { fprintf(stderr, "kernel_launch: hipFuncSetAttribute failed\n"); grid = -1; return; }
        if (hipOccupancyMaxActiveBlocksPerMultiprocessor(&per_cu, (const void*)yoco_fwd, NWAVES * 64, LDS_BYTES) != hipSuccess || per_cu < 1) { fprintf(stderr, "kernel_launch: occupancy query reports %d blocks per CU\n", per_cu); (void)hipGetLastError(); grid = -1; return; }
        grid = cus;
        if (grid > 256) grid = 256;
    }
    if (grid < 0) return;
    (void)hipMemsetAsync((char*)d_ws + WS_CTL, 0, CTL_ZERO_BYTES, stream);
    Args a{};
    for (int i = 0; i < 26; ++i) a.in[i] = (const float*)d_in[i];
    a.out = (float*)d_out; a.ws = (unsigned char*)d_ws;
#if MK_PHASE_LAUNCHES
    for (int p = 0; p < N_PHASES; ++p) { a.ph_lo = p; a.ph_hi = p + 1; hipLaunchKernelGGL(yoco_fwd, dim3(grid), dim3(NWAVES * 64), LDS_BYTES, stream, a); }
#else
    a.ph_lo = 0; a.ph_hi = N_PHASES;
    hipLaunchKernelGGL(yoco_fwd, dim3(grid), dim3(NWAVES * 64), LDS_BYTES, stream, a);
#endif
    const hipError_t le = hipPeekAtLastError();
    if (le != hipSuccess) fprintf(stderr, "kernel_launch: launch failed: %s\n", hipGetErrorName(le));
}
```
